# Optimizing an MI355X kernel written in HIP

```python
import math
import jax, jax.numpy as jnp
from jax import lax
import numpy as np

D_MODEL = 1024
BATCH = 8
SEQ = 4096
DEPTH = 2

N_META = 16
S5_GROUP = 16
S5_GROUPS = D_MODEL // S5_GROUP
S5_STATE = 64
N_HEADS = 16
HEAD_DIM = D_MODEL // N_HEADS
D_FF = ((8 * D_MODEL + 3 * 256 - 1) // (3 * 256)) * 256
Q_BLOCK = 128
N_A_LAYERS = DEPTH // 2
N_B_LAYERS = DEPTH - N_A_LAYERS
RMS_EPS = 1e-6
DT_MIN = 1e-3
DT_MAX = 1e-1

kernel_name = "s5_yoco_stickbreaking_hybrid"


def rmsnorm(x, gain):
    x32 = x.astype(jnp.float32)
    y = x32 * lax.rsqrt(jnp.mean(x32 * x32, axis=-1, keepdims=True) + RMS_EPS)
    return (y * gain.astype(jnp.float32)).astype(x.dtype)


def s5_mixer(u, a_re, a_im, log_dt, b_re, b_im, c_re, c_im, d_skip, w_glu):
    bsz, L, _ = u.shape
    f32 = jnp.float32
    u32 = u.astype(f32).reshape(bsz, L, S5_GROUPS, S5_GROUP)
    a_re = a_re.astype(f32)
    a_im = a_im.astype(f32)
    dt = jnp.exp(log_dt.astype(f32))[:, None]
    mag = jnp.exp(dt * a_re)
    ang = dt * a_im
    abar_re = mag * jnp.cos(ang)
    abar_im = mag * jnp.sin(ang)
    den = a_re * a_re + a_im * a_im
    coef_re = ((abar_re - 1.0) * a_re + abar_im * a_im) / den
    coef_im = (abar_im * a_re - (abar_re - 1.0) * a_im) / den
    b_re = b_re.astype(f32)
    b_im = b_im.astype(f32)
    bbar_re = coef_re[..., None] * b_re - coef_im[..., None] * b_im
    bbar_im = coef_re[..., None] * b_im + coef_im[..., None] * b_re
    bu_re = jnp.einsum('blgc,gpc->blgp', u32, bbar_re)
    bu_im = jnp.einsum('blgc,gpc->blgp', u32, bbar_im)
    a_seq_re = jnp.broadcast_to(abar_re, (1, L, S5_GROUPS, S5_STATE))
    a_seq_im = jnp.broadcast_to(abar_im, (1, L, S5_GROUPS, S5_STATE))

    def combine(e1, e2):
        a1r, a1i, b1r, b1i = e1
        a2r, a2i, b2r, b2i = e2
        return (a2r * a1r - a2i * a1i,
                a2r * a1i + a2i * a1r,
                a2r * b1r - a2i * b1i + b2r,
                a2r * b1i + a2i * b1r + b2i)

    _, _, x_re, x_im = lax.associative_scan(combine, (a_seq_re, a_seq_im, bu_re, bu_im), axis=1)
    y = (jnp.einsum('blgp,gcp->blgc', x_re, c_re.astype(f32))
         - jnp.einsum('blgp,gcp->blgc', x_im, c_im.astype(f32)))
    y = (y + d_skip.astype(f32).reshape(S5_GROUPS, S5_GROUP) * u32).reshape(bsz, L, D_MODEL)
    z = jax.nn.gelu(y)
    vg = jnp.einsum('bld,de->ble', z, w_glu.astype(f32))
    val, gate = jnp.split(vg, 2, axis=-1)
    return (val * jax.nn.sigmoid(gate)).astype(u.dtype)


def stick_breaking_attention(q, k, v):
    f32 = jnp.float32
    q = q.astype(f32)
    k = k.astype(f32)
    v = v.astype(f32)
    L = q.shape[1]
    scale = 1.0 / math.sqrt(HEAD_DIM)
    n_real_blocks = (L - N_META) // Q_BLOCK
    bounds = [(0, N_META)] + [(N_META + i * Q_BLOCK, N_META + (i + 1) * Q_BLOCK) for i in range(n_real_blocks)]
    outs = []
    for q0, q1 in bounds:
        qb = q[:, q0:q1]
        kb = k[:, :q1]
        vb = v[:, :q1]
        z = jnp.einsum('bqhd,bkhd->bhqk', qb, kb) * scale
        t_idx = jnp.arange(q0, q1)[:, None]
        s_idx = jnp.arange(q1)[None, :]
        strict = s_idx < t_idx
        log_beta = jax.nn.log_sigmoid(z)
        log_1m = jnp.where(strict, jax.nn.log_sigmoid(-z), 0.0)
        log_remain = lax.cumsum(log_1m, axis=3, reverse=True) - log_1m
        w = jnp.where(strict, jnp.exp(log_beta + log_remain), 0.0)
        outs.append(jnp.einsum('bhqk,bkhd->bqhd', w, vb))
    return jnp.concatenate(outs, axis=1)


def swiglu_ffn(h, w_in, w_out):
    gu = jnp.einsum('bld,df->blf', h, w_in)
    g, u = jnp.split(gu, 2, axis=-1)
    return jnp.einsum('blf,fd->bld', jax.nn.silu(g) * u, w_out)


def setup_inputs(seed: int = 0) -> dict:
    key = jax.random.key(seed)
    ks = jax.random.split(key, 24)
    f32 = jnp.float32
    G, P, C = S5_GROUPS, S5_STATE, S5_GROUP
    HD = N_HEADS * HEAD_DIM
    x = jax.random.normal(ks[0], (BATCH, SEQ, D_MODEL), f32)
    meta_tokens = jax.random.normal(ks[1], (N_META, D_MODEL), f32)
    norm_mix = 1.0 + 0.02 * jax.random.normal(ks[2], (DEPTH, D_MODEL), f32)
    norm_ffn = 1.0 + 0.02 * jax.random.normal(ks[3], (DEPTH, D_MODEL), f32)
    n_idx = jnp.arange(P, dtype=f32)
    s5_a_re = -0.5 + 0.01 * jax.random.normal(ks[4], (N_A_LAYERS, G, P), f32)
    s5_a_im = math.pi * n_idx + 0.01 * jax.random.normal(ks[5], (N_A_LAYERS, G, P), f32)
    s5_log_dt = jax.random.uniform(ks[6], (N_A_LAYERS, G), f32, math.log(DT_MIN), math.log(DT_MAX))
    s5_b_re = jax.random.normal(ks[7], (N_A_LAYERS, G, P, C), f32) * (2 * C) ** -0.5
    s5_b_im = jax.random.normal(ks[8], (N_A_LAYERS, G, P, C), f32) * (2 * C) ** -0.5
    s5_c_re = jax.random.normal(ks[9], (N_A_LAYERS, G, C, P), f32) * P ** -0.5
    s5_c_im = jax.random.normal(ks[10], (N_A_LAYERS, G, C, P), f32) * P ** -0.5
    s5_d = jax.random.normal(ks[11], (N_A_LAYERS, D_MODEL), f32)
    s5_w_glu = jax.random.normal(ks[12], (N_A_LAYERS, D_MODEL, 2 * D_MODEL), f32) * D_MODEL ** -0.5
    norm_kv = 1.0 + 0.02 * jax.random.normal(ks[13], (D_MODEL,), f32)
    w_kv = jax.random.normal(ks[14], (D_MODEL, 2 * HD), f32) * D_MODEL ** -0.5
    w_q = jax.random.normal(ks[15], (N_B_LAYERS, D_MODEL, HD), f32) * D_MODEL ** -0.5
    w_o = jax.random.normal(ks[16], (N_B_LAYERS, HD, D_MODEL), f32) * HD ** -0.5
    w_ffn_in = jax.random.normal(ks[17], (DEPTH, D_MODEL, 2 * D_FF), f32) * D_MODEL ** -0.5
    w_ffn_out = jax.random.normal(ks[18], (DEPTH, D_FF, D_MODEL), f32) * D_FF ** -0.5
    norm_final = 1.0 + 0.02 * jax.random.normal(ks[19], (D_MODEL,), f32)
    return {"x": x, "meta_tokens": meta_tokens, "norm_mix": norm_mix, "norm_ffn": norm_ffn,
            "s5_a_re": s5_a_re, "s5_a_im": s5_a_im, "s5_log_dt": s5_log_dt,
            "s5_b_re": s5_b_re, "s5_b_im": s5_b_im, "s5_c_re": s5_c_re, "s5_c_im": s5_c_im,
            "s5_d": s5_d, "s5_w_glu": s5_w_glu, "norm_kv": norm_kv, "w_kv": w_kv,
            "w_q": w_q, "w_o": w_o, "w_ffn_in": w_ffn_in, "w_ffn_out": w_ffn_out,
            "norm_final": norm_final}


def reference(x, meta_tokens, norm_mix, norm_ffn, s5_a_re, s5_a_im, s5_log_dt,
              s5_b_re, s5_b_im, s5_c_re, s5_c_im, s5_d, s5_w_glu, norm_kv, w_kv,
              w_q, w_o, w_ffn_in, w_ffn_out, norm_final):
    bsz = x.shape[0]
    meta = jnp.broadcast_to(meta_tokens.astype(x.dtype)[None], (bsz, N_META, D_MODEL))
    h = jnp.concatenate([meta, x], axis=1)
    L = h.shape[1]
    k_shared = None
    v_shared = None
    for i in range(DEPTH):
        if i < N_A_LAYERS:
            a = i
            h = h + s5_mixer(rmsnorm(h, norm_mix[i]), s5_a_re[a], s5_a_im[a], s5_log_dt[a],
                             s5_b_re[a], s5_b_im[a], s5_c_re[a], s5_c_im[a], s5_d[a], s5_w_glu[a])
        else:
            j = i - N_A_LAYERS
            q = jnp.einsum('bld,de->ble', rmsnorm(h, norm_mix[i]), w_q[j]).reshape(bsz, L, N_HEADS, HEAD_DIM)
            o = stick_breaking_attention(q, k_shared, v_shared).astype(h.dtype)
            h = h + jnp.einsum('ble,ed->bld', o.reshape(bsz, L, N_HEADS * HEAD_DIM), w_o[j])
        h = h + swiglu_ffn(rmsnorm(h, norm_ffn[i]), w_ffn_in[i], w_ffn_out[i])
        if i == N_A_LAYERS - 1:
            kv = jnp.einsum('bld,de->ble', rmsnorm(h, norm_kv), w_kv).reshape(bsz, L, 2, N_HEADS, HEAD_DIM)
            k_shared = kv[:, :, 0]
            v_shared = kv[:, :, 1]
    out = rmsnorm(h, norm_final)
    return out[:, N_META:]
```

```cpp
#include <hip/hip_runtime.h>
#include <hip/hip_cooperative_groups.h>
#include <cstdio>
#include <cstdint>
namespace cg = cooperative_groups;
namespace pg8 {
#define PG8_LAS __attribute__((address_space(3)))
typedef unsigned short bf16_t;
typedef short bf16x8 __attribute__((ext_vector_type(8)));
typedef float f32x4 __attribute__((ext_vector_type(4)));
typedef unsigned u32x4 __attribute__((ext_vector_type(4)));
constexpr int BM = 256, BK = 64, HALF = 128, HTB = HALF * BK * 2  , STAGE_BYTES = 8 * HTB, NXCD = 8, WGM = 8;

__host__ __device__ __forceinline__ int lds_byte(int r, int c) { const int st = (r >> 4) * 2 + (c >> 5), rr = r & 15, cc = c & 31, ob = rr * 64 + cc * 2; return st * 1024 + (ob ^ (((ob >> 9) & 1) << 5)); }
__host__ __device__ __forceinline__ void stage_rc(int b, int& R, int& C) { const int st = b / 1024, sb = b % 1024, swz = sb ^ (((sb >> 9) & 1) << 5); R = (st >> 1) * 16 + swz / 64; C = (st & 1) * 32 + (swz % 64) / 2; }
__host__ __device__ __forceinline__ int perm32(int rho) { const int n = rho >> 4, i = rho & 15; return 8 * (i >> 2) + 4 * n + (i & 3); }

struct Unit { int pm, pn; };
struct Gemm { const bf16_t* A; const bf16_t* Bt; int M, N, K; };

struct StaticOrder {
    int nM, nN, nwg, G, c;
    __host__ __device__ void init(int M, int N, int G_, int c_) { nM = M / BM; nN = N / BM; nwg = nM * nN; G = G_; c = c_; }
    __host__ __device__ bool next(int i, Unit& u) const {
        const long L = (long)i * G + c; if (L >= nwg) return false;
        int wgid = (int)L; { const int q = nwg / NXCD, r = nwg % NXCD, xcd = wgid % NXCD, off = wgid / NXCD; wgid = (xcd < r ? xcd * (q + 1) : r * (q + 1) + (xcd - r) * q) + off; }
        const int nig = WGM * nN, gid = wgid / nig, fm = gid * WGM, gsz = (nM - fm) < WGM ? (nM - fm) : WGM;
        u.pm = fm + ((wgid % nig) % gsz); u.pn = (wgid % nig) / gsz; return true;
    }
    __device__ __forceinline__ void a_ready(const Unit&) const {}
    __device__ __forceinline__ void done(const Unit&) const {}
};
typedef float f32x2 __attribute__((ext_vector_type(2)));

template <class Epi, class Sched, bool ALIGN_EPI = false, bool SP2 = false>
__device__ __forceinline__ void gemm_phase(PG8_LAS unsigned char* lds, const Gemm g, const Sched& S, const Epi& E) {
    const int tid = threadIdx.x, wid = __builtin_amdgcn_readfirstlane(tid >> 6), lane = tid & 63, wr = wid >> 2, wc = wid & 3, fr = lane & 15, fq = lane >> 4;
    const int K = g.K, nt = K / BK;
    unsigned voffA[2], voffB[2];
#pragma unroll
    for (int i = 0; i < 2; ++i) { int R, C; stage_rc(tid * 16 + i * 8192, R, C); const int Rb = Epi::PERM ? ((R & ~31) + perm32(R & 31)) : R;
        voffA[i] = (unsigned)(R * K + C) * 2u; voffB[i] = (unsigned)(Rb * K + C) * 2u; }
    const size_t kstep = (size_t)(BK * 2);
    const size_t hstep = (size_t)HALF * K * 2;
    const size_t tstep = 2 * hstep;
    const unsigned ldsw = (unsigned)wid * 1024u;
    const int aoff = lds_byte(wr * 64 + fr, fq * 8), boff = lds_byte(wc * 32 + fr, fq * 8);
#define PG8_SA(b, h) (((b) * 2 + (h)) * HTB)
#define PG8_SB(b, h) ((4 + (b) * 2 + (h)) * HTB)
#define PG8_STAGE(bufoff, gbase, voff) do { _Pragma("unroll") for (int _i = 0; _i < 2; ++_i) \
        __builtin_amdgcn_global_load_lds((const unsigned*)((const char*)(gbase) + (voff)[_i]), (PG8_LAS unsigned*)(lds + (bufoff) + ldsw + _i * 8192), 16, 0, 0); } while (0)
#define PG8_LDA(dst, b, h) do { _Pragma("unroll") for (int m = 0; m < 4; ++m) _Pragma("unroll") for (int k = 0; k < 2; ++k) dst[m][k] = *(const PG8_LAS bf16x8*)(lds + PG8_SA(b, h) + aoff + m * 2048 + k * 1024); } while (0)
#define PG8_LDB(dst, b, h) do { _Pragma("unroll") for (int n = 0; n < 2; ++n) _Pragma("unroll") for (int k = 0; k < 2; ++k) dst[n][k] = *(const PG8_LAS bf16x8*)(lds + PG8_SB(b, h) + boff + n * 2048 + k * 1024); } while (0)
#define PG8_MMA(ai, bj, At, Bt) do { __builtin_amdgcn_s_setprio(1); _Pragma("unroll") for (int m = 0; m < 4; ++m) _Pragma("unroll") for (int n = 0; n < 2; ++n) _Pragma("unroll") for (int k = 0; k < 2; ++k) \
        acc[ai][bj][m][n] = __builtin_amdgcn_mfma_f32_16x16x32_bf16(Bt[n][k], At[m][k], acc[ai][bj][m][n], 0, 0, 0); __builtin_amdgcn_s_setprio(0); } while (0)
#define PG8_WAIT_V(n) asm volatile("s_waitcnt vmcnt(" #n ")" ::: "memory")
#define PG8_WAIT_L(n) asm volatile("s_waitcnt lgkmcnt(" #n ")" ::: "memory")
#define PG8_BAR __builtin_amdgcn_s_barrier()
#define PG8_SCHED __builtin_amdgcn_sched_barrier(0)
    Unit cur, nxt; int ui = 0;
    if (!S.next(0, cur)) return;
    f32x4 acc[2][2][4][2];
#pragma unroll
    for (int a = 0; a < 2; ++a)
#pragma unroll
        for (int b = 0; b < 2; ++b)
#pragma unroll
            for (int m = 0; m < 4; ++m)
#pragma unroll
                for (int n = 0; n < 2; ++n) acc[a][b][m][n] = (f32x4){0.f, 0.f, 0.f, 0.f};
    bf16x8 At[4][2], B0[2][2], B1[2][2];
    const char* cA = (const char*)g.A + (size_t)cur.pm * tstep; const char* cB = (const char*)g.Bt + (size_t)cur.pn * tstep;
    S.a_ready(cur);
    if constexpr (SP2) {
        PG8_STAGE(PG8_SB(0, 0), cB, voffB); PG8_STAGE(PG8_SB(0, 1), cB + hstep, voffB); PG8_STAGE(PG8_SA(0, 0), cA, voffA); PG8_STAGE(PG8_SA(0, 1), cA + hstep, voffA);
        if (wr == 1) PG8_BAR;
        PG8_WAIT_V(2); PG8_BAR;
        PG8_STAGE(PG8_SB(1, 0), cB + kstep, voffB); PG8_STAGE(PG8_SA(1, 0), cA + kstep, voffA); PG8_STAGE(PG8_SB(1, 1), cB + hstep + kstep, voffB);
        PG8_WAIT_V(6); PG8_BAR;
    } else {
        PG8_STAGE(PG8_SB(0, 0), cB, voffB); PG8_STAGE(PG8_SA(0, 0), cA, voffA); PG8_STAGE(PG8_SB(0, 1), cB + hstep, voffB); PG8_STAGE(PG8_SA(0, 1), cA + hstep, voffA);
        if (wr == 1) PG8_BAR;
        PG8_WAIT_V(4); PG8_BAR;
        PG8_STAGE(PG8_SB(1, 0), cB + kstep, voffB); PG8_STAGE(PG8_SA(1, 0), cA + kstep, voffA); PG8_STAGE(PG8_SB(1, 1), cB + hstep + kstep, voffB);
        PG8_WAIT_V(6); PG8_BAR;
    }
    for (;;) {
        const bool has_next = S.next(ui + 1, nxt);
        const char* nA = has_next ? (const char*)g.A + (size_t)nxt.pm * tstep : cA; const char* nB = has_next ? (const char*)g.Bt + (size_t)nxt.pn * tstep : cB;
        for (int t = 0; t < nt; t += 2) {
            const bool last = (t == nt - 2);
            const char* a1 = cA + (size_t)(t + 1) * kstep;
            const char* a2 = last ? nA : cA + (size_t)(t + 2) * kstep; const char* b2 = last ? nB : cB + (size_t)(t + 2) * kstep;
            const char* a3 = a2 + kstep; const char* b3 = b2 + kstep;
            if (last && has_next) S.a_ready(nxt);
            if constexpr (SP2) {
            PG8_LDB(B0, 0, 0); PG8_LDB(B1, 0, 1); PG8_SCHED; PG8_LDA(At, 0, 0); PG8_STAGE(PG8_SA(1, 1), a1 + hstep, voffA);
            PG8_WAIT_V(8); PG8_WAIT_L(0); PG8_BAR; PG8_MMA(0, 0, At, B0); PG8_MMA(0, 1, At, B1); PG8_BAR; PG8_SCHED;
            PG8_LDA(At, 0, 1); PG8_STAGE(PG8_SB(0, 0), b2, voffB); PG8_STAGE(PG8_SB(0, 1), b2 + hstep, voffB); PG8_STAGE(PG8_SA(0, 0), a2, voffA);
            PG8_WAIT_V(8); PG8_WAIT_L(0); PG8_BAR; PG8_MMA(1, 0, At, B0); PG8_MMA(1, 1, At, B1); PG8_BAR; PG8_SCHED;
            PG8_LDB(B0, 1, 0); PG8_LDB(B1, 1, 1); PG8_SCHED; PG8_LDA(At, 1, 0); PG8_STAGE(PG8_SA(0, 1), a2 + hstep, voffA);
            PG8_WAIT_V(8); PG8_WAIT_L(0); PG8_BAR; PG8_MMA(0, 0, At, B0); PG8_MMA(0, 1, At, B1); PG8_BAR; PG8_SCHED;
            PG8_LDA(At, 1, 1); PG8_STAGE(PG8_SB(1, 0), b3, voffB); PG8_STAGE(PG8_SB(1, 1), b3 + hstep, voffB); PG8_STAGE(PG8_SA(1, 0), a3, voffA);
            PG8_WAIT_V(8); PG8_WAIT_L(0); PG8_BAR; PG8_MMA(1, 0, At, B0); PG8_MMA(1, 1, At, B1); PG8_BAR; PG8_SCHED;
            } else {
            PG8_LDB(B0, 0, 0); PG8_SCHED; PG8_LDA(At, 0, 0); PG8_STAGE(PG8_SA(1, 1), a1 + hstep, voffA);
            PG8_WAIT_L(8); PG8_BAR; PG8_WAIT_L(0); PG8_MMA(0, 0, At, B0); PG8_BAR; PG8_SCHED;
            PG8_LDB(B1, 0, 1); PG8_STAGE(PG8_SB(0, 0), b2, voffB);
            PG8_BAR; PG8_WAIT_L(0); PG8_MMA(0, 1, At, B1); PG8_BAR;
            PG8_LDA(At, 0, 1); PG8_STAGE(PG8_SA(0, 0), a2, voffA);
            PG8_BAR; PG8_WAIT_L(0); PG8_MMA(1, 0, At, B0); PG8_BAR; PG8_SCHED;
            PG8_STAGE(PG8_SB(0, 1), b2 + hstep, voffB);
            PG8_WAIT_V(6); PG8_BAR; PG8_MMA(1, 1, At, B1); PG8_BAR;
            PG8_LDB(B0, 1, 0); PG8_SCHED; PG8_LDA(At, 1, 0); PG8_STAGE(PG8_SA(0, 1), a2 + hstep, voffA);
            PG8_WAIT_L(8); PG8_BAR; PG8_WAIT_L(0); PG8_MMA(0, 0, At, B0); PG8_BAR; PG8_SCHED;
            PG8_LDB(B1, 1, 1); PG8_STAGE(PG8_SB(1, 0), b3, voffB);
            PG8_BAR; PG8_WAIT_L(0); PG8_MMA(0, 1, At, B1); PG8_BAR;
            PG8_LDA(At, 1, 1); PG8_STAGE(PG8_SA(1, 0), a3, voffA);
            PG8_BAR; PG8_WAIT_L(0); PG8_MMA(1, 0, At, B0); PG8_BAR; PG8_SCHED;
            PG8_STAGE(PG8_SB(1, 1), b3 + hstep, voffB);
            PG8_WAIT_V(6); PG8_BAR; PG8_MMA(1, 1, At, B1); PG8_BAR;
            }
        }
        if constexpr (ALIGN_EPI) { if (wr == 0) PG8_BAR; }
        if constexpr (!Epi::AFTER_DRAIN) { E(acc, cur, wr, wc, fr, fq); S.done(cur); }
        if (!has_next) break;
#pragma unroll
        for (int a = 0; a < 2; ++a)
#pragma unroll
            for (int b = 0; b < 2; ++b)
#pragma unroll
                for (int m = 0; m < 4; ++m)
#pragma unroll
                    for (int n = 0; n < 2; ++n) acc[a][b][m][n] = (f32x4){0.f, 0.f, 0.f, 0.f};
        cur = nxt; cA = nA; cB = nB; ++ui;
        if constexpr (ALIGN_EPI) { if (wr == 1) PG8_BAR; }
    }
    PG8_WAIT_V(0);
    if constexpr (!ALIGN_EPI) { if (wr == 0) PG8_BAR; }
    PG8_BAR;
    if constexpr (Epi::AFTER_DRAIN) { E.fused(acc, cur, wr, wc, fr, fq, lds, wid, lane); S.done(cur); }
#undef PG8_SA
#undef PG8_SB
#undef PG8_STAGE
#undef PG8_LDA
#undef PG8_LDB
#undef PG8_MMA
#undef PG8_WAIT_V
#undef PG8_WAIT_L
#undef PG8_BAR
#undef PG8_SCHED
}
}

using pg8::bf16_t; using pg8::bf16x8; using pg8::f32x4; using pg8::Unit; using pg8::Gemm; using pg8::StaticOrder;
#define LAS __attribute__((address_space(3)))
typedef float f32x16 __attribute__((ext_vector_type(16)));
typedef short s16x4 __attribute__((ext_vector_type(4)));
typedef unsigned u32x2 __attribute__((ext_vector_type(2)));
typedef unsigned u32x4 __attribute__((ext_vector_type(4)));
typedef float f32x2_t __attribute__((ext_vector_type(2)));
typedef __bf16 bf16x2_t __attribute__((ext_vector_type(2)));
typedef unsigned long long u64;

constexpr int NB = 8, SEQ = 4096, NMETA = 16, DM = 1024, DFF = 2816, NHEAD = 16;
constexpr int MR = NB * SEQ;
constexpr int MROWS = MR + NMETA;
constexpr int MP = 33024;
constexpr float SS_SCALE = 1048576.0f;

constexpr size_t OFF_SS = 0;
constexpr size_t OFF_S5 = 0x110000;
constexpr size_t S5_ABAR = OFF_S5;
constexpr size_t S5_BB = OFF_S5 + 0x8000;
constexpr size_t S5_CB = S5_BB + 0x40000;
constexpr size_t S5_DG = S5_CB + 0x40000;
constexpr size_t OFF_W = 0x210000;
constexpr size_t W_GLU = OFF_W;
constexpr size_t W_FI0 = W_GLU + 2048ull * 1024 * 2;
constexpr size_t W_FI1 = W_FI0 + 5632ull * 1024 * 2;
constexpr size_t W_FO0 = W_FI1 + 5632ull * 1024 * 2;
constexpr size_t W_FO1 = W_FO0 + 1024ull * 2816 * 2;
constexpr size_t W_KQ = W_FO1 + 1024ull * 2816 * 2;
constexpr size_t W_V = W_KQ + 2048ull * 1024 * 2;
constexpr size_t W_O = W_V + 1024ull * 1024 * 2;
constexpr size_t OFF_XB = W_O + 1024ull * 1024 * 2;
constexpr size_t OFF_H = OFF_XB + (size_t)MP * 1024 * 2;
constexpr size_t OFF_ZQ = OFF_H + (size_t)MP * 1024 * 4;
constexpr size_t OFF_KB = OFF_ZQ + (size_t)MP * 1024 * 2;
constexpr size_t OFF_VT = OFF_KB + (size_t)MP * 1024 * 2;
constexpr size_t OFF_ACT = OFF_ZQ;
constexpr size_t WS_END = OFF_VT + (size_t)MP * 1024 * 2;
static_assert((size_t)MP * DFF * 2 <= WS_END - OFF_ACT, "ACT overlay fits");
static_assert(S5_DG + 4096 <= OFF_W, "s5 params fit");

__device__ __forceinline__ unsigned cvtpk(float lo, float hi) { f32x2_t v = {lo, hi}; bf16x2_t b = __builtin_convertvector(v, bf16x2_t); return __builtin_bit_cast(unsigned, b); }
__device__ __forceinline__ float frcp(float x) { return __builtin_amdgcn_rcpf(x); }
__device__ __forceinline__ float rstd_of(u64 v) { return rsqrtf((float)v * (1.0f / (SS_SCALE * 1024.0f)) + 1e-6f); }
__device__ __forceinline__ void ss_add(u64* p, float s) { __hip_atomic_fetch_add(p, (u64)(s * SS_SCALE), __ATOMIC_RELAXED, __HIP_MEMORY_SCOPE_AGENT); }
__device__ __forceinline__ float bf2f(unsigned short b) { return __uint_as_float((unsigned)b << 16); }


struct EpiGLU {
    static constexpr bool PERM = true, AFTER_DRAIN = false;
    const float* x; const float* meta; float* H; bf16_t* XB; u64* ss;
    __device__ __forceinline__ void operator()(const f32x4 (&acc)[2][2][4][2], const Unit& u, int wr, int wc, int fr, int fq) const {
        const int col0 = u.pn * 128 + wc * 32 + 8 * fq;
#pragma unroll
        for (int ai = 0; ai < 2; ++ai) {
            float s[4];
#pragma unroll
            for (int m = 0; m < 4; ++m) {
                const int row = u.pm * 256 + ai * 128 + wr * 64 + m * 16 + fr;
                f32x4 h0 = {0.f, 0.f, 0.f, 0.f}, h1 = {0.f, 0.f, 0.f, 0.f};
                if (row < MROWS) { const float* hp = (row < MR ? x + (size_t)row * DM : meta + (size_t)(row - MR) * DM) + col0; h0 = *(const f32x4*)hp; h1 = *(const f32x4*)(hp + 4); }
                const f32x4 v0 = acc[ai][0][m][0], v1 = acc[ai][0][m][1], g0 = acc[ai][1][m][0], g1 = acc[ai][1][m][1];
#pragma unroll
                for (int j = 0; j < 4; ++j) { h0[j] += v0[j] * frcp(1.f + __expf(-g0[j])); h1[j] += v1[j] * frcp(1.f + __expf(-g1[j])); }
                float* hw = H + (size_t)row * DM + col0; *(f32x4*)hw = h0; *(f32x4*)(hw + 4) = h1;
                u32x4 w; w.x = cvtpk(h0[0], h0[1]); w.y = cvtpk(h0[2], h0[3]); w.z = cvtpk(h1[0], h1[1]); w.w = cvtpk(h1[2], h1[3]);
                *(u32x4*)(XB + (size_t)row * DM + col0) = w;
                s[m] = (h0[0] * h0[0] + h0[1] * h0[1]) + (h0[2] * h0[2] + h0[3] * h0[3]) + (h1[0] * h1[0] + h1[1] * h1[1]) + (h1[2] * h1[2] + h1[3] * h1[3]);
            }
#pragma unroll
            for (int m = 0; m < 4; ++m) { s[m] += __shfl_xor(s[m], 16); s[m] += __shfl_xor(s[m], 32); }
            const float mine = fq == 0 ? s[0] : (fq == 1 ? s[1] : (fq == 2 ? s[2] : s[3]));
            ss_add(ss + (u.pm * 256 + ai * 128 + wr * 64 + fq * 16 + fr), mine);
        }
    }
};

struct EpiSwiGLU {
    static constexpr bool PERM = true, AFTER_DRAIN = false;
    const u64* ss; bf16_t* ACT;
    __device__ __forceinline__ void operator()(const f32x4 (&acc)[2][2][4][2], const Unit& u, int wr, int wc, int fr, int fq) const {
        const int col0 = u.pn * 128 + wc * 32 + 8 * fq;
#pragma unroll
        for (int ai = 0; ai < 2; ++ai)
#pragma unroll
            for (int m = 0; m < 4; ++m) {
                const int row = u.pm * 256 + ai * 128 + wr * 64 + m * 16 + fr;
                const float rs = rstd_of(ss[row]);
                float o[8];
#pragma unroll
                for (int n = 0; n < 2; ++n)
#pragma unroll
                    for (int j = 0; j < 4; ++j) { const float g = acc[ai][0][m][n][j] * rs, uu = acc[ai][1][m][n][j] * rs; o[4 * n + j] = g * uu * frcp(1.f + __expf(-g)); }
                u32x4 w; w.x = cvtpk(o[0], o[1]); w.y = cvtpk(o[2], o[3]); w.z = cvtpk(o[4], o[5]); w.w = cvtpk(o[6], o[7]);
                *(u32x4*)(ACT + (size_t)row * DFF + col0) = w;
            }
    }
};

template <bool WRITE_XB> struct EpiResid {
    static constexpr bool PERM = true, AFTER_DRAIN = false;
    float* H; bf16_t* XB; u64* ss;
    __device__ __forceinline__ void operator()(const f32x4 (&acc)[2][2][4][2], const Unit& u, int wr, int wc, int fr, int fq) const {
        const int col0 = u.pn * 256 + wc * 32 + 8 * fq;
#pragma unroll
        for (int ai = 0; ai < 2; ++ai) {
            float s[4];
#pragma unroll
            for (int m = 0; m < 4; ++m) {
                const int row = u.pm * 256 + ai * 128 + wr * 64 + m * 16 + fr;
                float sq = 0.f;
#pragma unroll
                for (int bj = 0; bj < 2; ++bj) {
                    float* hp = H + (size_t)row * DM + col0 + bj * 128;
                    f32x4 h0 = *(const f32x4*)hp, h1 = *(const f32x4*)(hp + 4);
                    h0 += acc[ai][bj][m][0]; h1 += acc[ai][bj][m][1];
                    *(f32x4*)hp = h0; *(f32x4*)(hp + 4) = h1;
                    if (WRITE_XB) { u32x4 w; w.x = cvtpk(h0[0], h0[1]); w.y = cvtpk(h0[2], h0[3]); w.z = cvtpk(h1[0], h1[1]); w.w = cvtpk(h1[2], h1[3]);
                        *(u32x4*)(XB + (size_t)row * DM + col0 + bj * 128) = w; }
                    sq += (h0[0] * h0[0] + h0[1] * h0[1]) + (h0[2] * h0[2] + h0[3] * h0[3]) + (h1[0] * h1[0] + h1[1] * h1[1]) + (h1[2] * h1[2] + h1[3] * h1[3]);
                }
                s[m] = sq;
            }
#pragma unroll
            for (int m = 0; m < 4; ++m) { s[m] += __shfl_xor(s[m], 16); s[m] += __shfl_xor(s[m], 32); }
            const float mine = fq == 0 ? s[0] : (fq == 1 ? s[1] : (fq == 2 ? s[2] : s[3]));
            ss_add(ss + (u.pm * 256 + ai * 128 + wr * 64 + fq * 16 + fr), mine);
        }
    }
};

struct EpiKQ {
    static constexpr bool PERM = true, AFTER_DRAIN = false;
    const u64* ss; bf16_t* KB; bf16_t* QB;
    __device__ __forceinline__ void operator()(const f32x4 (&acc)[2][2][4][2], const Unit& u, int wr, int wc, int fr, int fq) const {
        const bool isq = u.pn >= 4;
        bf16_t* base = isq ? QB : KB; const float sc = isq ? 0.125f : 1.0f;
        const int col0 = (u.pn & 3) * 256 + wc * 32 + 8 * fq;
#pragma unroll
        for (int ai = 0; ai < 2; ++ai)
#pragma unroll
            for (int m = 0; m < 4; ++m) {
                const int row = u.pm * 256 + ai * 128 + wr * 64 + m * 16 + fr;
                const float rs = rstd_of(ss[row]) * sc;
#pragma unroll
                for (int bj = 0; bj < 2; ++bj) { const f32x4 v0 = acc[ai][bj][m][0] * rs, v1 = acc[ai][bj][m][1] * rs;
                    u32x4 w; w.x = cvtpk(v0[0], v0[1]); w.y = cvtpk(v0[2], v0[3]); w.z = cvtpk(v1[0], v1[1]); w.w = cvtpk(v1[2], v1[3]);
                    *(u32x4*)(base + (size_t)row * DM + col0 + bj * 128) = w; }
            }
    }
};

struct EpiVt {
    static constexpr bool PERM = true, AFTER_DRAIN = false;
    const u64* ss; bf16_t* VT;
    __device__ __forceinline__ void operator()(const f32x4 (&acc)[2][2][4][2], const Unit& u, int wr, int wc, int fr, int fq) const {
        const int col0 = u.pn * 256 + wc * 32 + 8 * fq;
#pragma unroll
        for (int bj = 0; bj < 2; ++bj) {
            float rs[8];
#pragma unroll
            for (int j = 0; j < 8; ++j) rs[j] = rstd_of(ss[col0 + bj * 128 + j]);
#pragma unroll
            for (int ai = 0; ai < 2; ++ai)
#pragma unroll
                for (int m = 0; m < 4; ++m) {
                    const int ch = u.pm * 256 + ai * 128 + wr * 64 + m * 16 + fr;
                    const f32x4 v0 = acc[ai][bj][m][0], v1 = acc[ai][bj][m][1];
                    u32x4 w; w.x = cvtpk(v0[0] * rs[0], v0[1] * rs[1]); w.y = cvtpk(v0[2] * rs[2], v0[3] * rs[3]); w.z = cvtpk(v1[0] * rs[4], v1[1] * rs[5]); w.w = cvtpk(v1[2] * rs[6], v1[3] * rs[7]);
                    *(u32x4*)(VT + (size_t)ch * MP + col0 + bj * 128) = w;
                }
        }
    }
};

__device__ __forceinline__ void transpose_item(const float* src, int ldn, const float* gain, bf16_t* dst, int K, int n0d, int c0s, int k0, LAS float* scr, int tid) {
    const int c = tid & 63, kk0 = tid >> 6;
#pragma unroll
    for (int i = 0; i < 8; ++i) { const int kk = kk0 + 8 * i; const float gmul = gain ? gain[k0 + kk] : 1.0f; scr[kk * 65 + c] = src[(size_t)(k0 + kk) * ldn + c0s + c] * gmul; }
    __syncthreads();
    const int kp = tid & 31, nn0 = tid >> 5;
#pragma unroll
    for (int i = 0; i < 4; ++i) { const int n = nn0 + 16 * i; *(unsigned*)(dst + (size_t)(n0d + n) * K + k0 + 2 * kp) = cvtpk(scr[(2 * kp) * 65 + n], scr[(2 * kp + 1) * 65 + n]); }
    __syncthreads();
}

struct Ptrs {
    const float* in[20]; float* out; unsigned char* ws;
};

__device__ __forceinline__ void p0_prologue(const Ptrs& P, LAS unsigned char* lds) {
    const int tid = threadIdx.x, lane = tid & 63, wid = tid >> 6;
    unsigned char* ws = P.ws;
    LAS float* scr = (LAS float*)lds;
    constexpr int I_GLU = 16 * 32, I_FI = 16 * 88, I_FO = 44 * 16, I_KQ = 16 * 32, I_V = 16 * 16, I_O = 16 * 16;
    constexpr int NITEMS = I_GLU + 2 * I_FI + 2 * I_FO + I_KQ + I_V + I_O;
    for (int it = blockIdx.x; it < NITEMS; it += gridDim.x) {
        int r = it;
        if (r < I_GLU) { const int kb = r & 15, nb = r >> 4, n0 = nb * 64; const int c0 = ((n0 >> 7) & 1) * 1024 + (n0 >> 8) * 128 + (n0 & 127);
            transpose_item(P.in[12], 2048, nullptr, (bf16_t*)(ws + W_GLU), 1024, n0, c0, kb * 64, scr, tid); continue; } r -= I_GLU;
        if (r < 2 * I_FI) { const int l = r / I_FI; r -= l * I_FI; const int kb = r & 15, nb = r >> 4, n0 = nb * 64; const int c0 = ((n0 >> 7) & 1) * DFF + (n0 >> 8) * 128 + (n0 & 127);
            transpose_item(P.in[17] + (size_t)l * 1024 * 5632, 5632, P.in[3] + l * 1024, (bf16_t*)(ws + (l ? W_FI1 : W_FI0)), 1024, n0, c0, kb * 64, scr, tid); continue; } r -= 2 * I_FI;
        if (r < 2 * I_FO) { const int l = r / I_FO; r -= l * I_FO; const int kb = r % 44, nb = r / 44;
            transpose_item(P.in[18] + (size_t)l * 2816 * 1024, 1024, nullptr, (bf16_t*)(ws + (l ? W_FO1 : W_FO0)), 2816, nb * 64, nb * 64, kb * 64, scr, tid); continue; } r -= 2 * I_FO;
        if (r < I_KQ) { const int kb = r & 15, nb = r >> 4, n0 = nb * 64;
            if (n0 < 1024) transpose_item(P.in[14], 2048, P.in[13], (bf16_t*)(ws + W_KQ), 1024, n0, n0, kb * 64, scr, tid);
            else transpose_item(P.in[15], 1024, P.in[2] + 1024, (bf16_t*)(ws + W_KQ), 1024, n0, n0 - 1024, kb * 64, scr, tid);
            continue; } r -= I_KQ;
        if (r < I_V) { const int kb = r & 15, nb = r >> 4; transpose_item(P.in[14], 2048, P.in[13], (bf16_t*)(ws + W_V), 1024, nb * 64, 1024 + nb * 64, kb * 64, scr, tid); continue; } r -= I_V;
        { const int kb = r & 15, nb = r >> 4; transpose_item(P.in[16], 1024, nullptr, (bf16_t*)(ws + W_O), 1024, nb * 64, nb * 64, kb * 64, scr, tid); }
    }
    const int gw = blockIdx.x * 8 + wid, NGW = gridDim.x * 8;
    bf16_t* XB = (bf16_t*)(ws + OFF_XB);
    for (int row = gw; row < MROWS; row += NGW) {
        const float* src = row < MR ? P.in[0] + (size_t)row * DM : P.in[1] + (size_t)(row - MR) * DM;
        f32x4 v[4]; float s = 0.f;
#pragma unroll
        for (int j = 0; j < 4; ++j) { v[j] = *(const f32x4*)(src + 4 * lane + 256 * j); s += (v[j][0] * v[j][0] + v[j][1] * v[j][1]) + (v[j][2] * v[j][2] + v[j][3] * v[j][3]); }
#pragma unroll
        for (int o = 1; o < 64; o <<= 1) s += __shfl_xor(s, o);
        const float rs = rsqrtf(s * (1.0f / 1024.0f) + 1e-6f);
#pragma unroll
        for (int j = 0; j < 4; ++j) { u32x2 w; w.x = cvtpk(v[j][0] * rs, v[j][1] * rs); w.y = cvtpk(v[j][2] * rs, v[j][3] * rs); *(u32x2*)(XB + (size_t)row * DM + 4 * lane + 256 * j) = w; }
    }
    const int gt = blockIdx.x * 512 + tid, NGT = gridDim.x * 512;
    u64* ss = (u64*)(ws + OFF_SS);
    for (int i = gt; i < 4 * MP; i += NGT) ss[i] = 0ull;
    const float* gain0 = P.in[2];
    for (int i = gt; i < 64 * 64; i += NGT) {
        const int g = i >> 6;
        const double dt = exp((double)P.in[6][g]);
        const double are = (double)P.in[4][i], aim = (double)P.in[5][i];
        const double mag = exp(dt * are), ang = dt * aim;
        const double kq = rint(ang * 0.15915494309189535), rr = ang - kq * 6.283185307179586;
        const double q = rr * 0.25, q2 = q * q;
        const double sn = q * (1.0 - q2 / 6.0 * (1.0 - q2 / 20.0 * (1.0 - q2 / 42.0 * (1.0 - q2 / 72.0 * (1.0 - q2 / 110.0 * (1.0 - q2 / 156.0 * (1.0 - q2 / 210.0)))))));
        const double cs = 1.0 - q2 / 2.0 * (1.0 - q2 / 12.0 * (1.0 - q2 / 30.0 * (1.0 - q2 / 56.0 * (1.0 - q2 / 90.0 * (1.0 - q2 / 132.0 * (1.0 - q2 / 182.0 * (1.0 - q2 / 240.0)))))));
        const double s2 = 2.0 * sn * cs, c2 = 1.0 - 2.0 * sn * sn;
        const double s4 = 2.0 * s2 * c2, c4 = 1.0 - 2.0 * s2 * s2;
        const double abr = mag * c4, abi = mag * s4;
        float* ab = (float*)(ws + S5_ABAR); ab[2 * i] = (float)abr; ab[2 * i + 1] = (float)abi;
        const double den = are * are + aim * aim;
        const double cr = ((abr - 1.0) * are + abi * aim) / den, ci = (abi * are - (abr - 1.0) * aim) / den;
        bf16_t* bb = (bf16_t*)(ws + S5_BB);
        const int p = i & 63;
#pragma unroll
        for (int c = 0; c < 16; c += 2) {
            const double g0 = gain0[g * 16 + c], g1 = gain0[g * 16 + c + 1];
            const double br0 = P.in[7][(size_t)i * 16 + c], bi0 = P.in[8][(size_t)i * 16 + c], br1 = P.in[7][(size_t)i * 16 + c + 1], bi1 = P.in[8][(size_t)i * 16 + c + 1];
            *(unsigned*)(bb + ((size_t)(g * 2 + 0) * 64 + p) * 16 + c) = cvtpk((float)((cr * br0 - ci * bi0) * g0), (float)((cr * br1 - ci * bi1) * g1));
            *(unsigned*)(bb + ((size_t)(g * 2 + 1) * 64 + p) * 16 + c) = cvtpk((float)((cr * bi0 + ci * br0) * g0), (float)((cr * bi1 + ci * br1) * g1));
        }
    }
    for (int i = gt; i < 64 * 16 * 64 / 2; i += NGT) {
        const int e = 2 * i, g = e >> 10, cp = e & 1023;
        bf16_t* cb = (bf16_t*)(ws + S5_CB);
        *(unsigned*)(cb + (size_t)(g * 2 + 0) * 1024 + cp) = cvtpk(P.in[9][e], P.in[9][e + 1]);
        *(unsigned*)(cb + (size_t)(g * 2 + 1) * 1024 + cp) = cvtpk(-P.in[10][e], -P.in[10][e + 1]);
    }
    for (int i = gt; i < 1024; i += NGT) ((float*)(ws + S5_DG))[i] = P.in[11][i] * gain0[i];
}

#define MFMA32(a, b, c) __builtin_amdgcn_mfma_f32_32x32x16_bf16((a), (b), (c), 0, 0, 0)
__device__ __forceinline__ float gelu_tanh(float y) {
    const float t = 1.5957691216057308f * (y + 0.044715f * y * y * y);
    return y * frcp(1.f + __expf(-t));
}
__device__ __forceinline__ void s5_phase(const Ptrs& P, LAS unsigned char* lds) {
    const int tid = threadIdx.x, lane = tid & 63, wid = __builtin_amdgcn_readfirstlane(tid >> 6), n = lane & 31, hh = lane >> 5;
    unsigned char* ws = P.ws;
    const bf16_t* XB = (const bf16_t*)(ws + OFF_XB);
    bf16_t* Z = (bf16_t*)(ws + OFF_ZQ);
    LAS unsigned char* wl = lds + wid * 9216;
    LAS unsigned char* uimg = wl + 8192;
    LAS f32x4* Ex = (LAS f32x4*)(lds + 8 * 9216);
    const int bs = (n >> 2) & 1, tk = (n & 3) + 4 * (n >> 3);
    for (int unit = blockIdx.x; unit < 256; unit += gridDim.x) {
        const int bp = unit >> 6, g = unit & 63;
        float ar[2], ai[2];
#pragma unroll
        for (int sh = 0; sh < 2; ++sh) { const float* ab = (const float*)(ws + S5_ABAR) + 2 * (g * 64 + 32 * sh + n); ar[sh] = ab[0]; ai[sh] = ab[1]; }
        bf16x8 Bop[2][2], Cop[2][2][2];
#pragma unroll
        for (int ri = 0; ri < 2; ++ri)
#pragma unroll
            for (int sh = 0; sh < 2; ++sh) {
                Bop[ri][sh] = *(const bf16x8*)((const bf16_t*)(ws + S5_BB) + ((size_t)(g * 2 + ri) * 64 + 32 * sh + n) * 16 + 8 * hh);
#pragma unroll
                for (int s = 0; s < 2; ++s) { bf16x8 cv = {0, 0, 0, 0, 0, 0, 0, 0};
                    if (n < 16) cv = *(const bf16x8*)((const bf16_t*)(ws + S5_CB) + ((size_t)(g * 2 + ri) * 16 + n) * 64 + 32 * sh + 16 * s + 8 * hh);
                    Cop[ri][sh][s] = cv; }
            }
        const int c_beg = 32 * wid + (wid > 0 ? 1 : 0), c_end = c_beg + 32 + (wid == 0 ? 1 : 0);
        const size_t arow_real = (size_t)((2 * bp + bs) * SEQ + tk), arow_meta = (size_t)(MR + tk);
        const int acol = g * 16 + 8 * hh;
        f32x16 zero16;
#pragma unroll
        for (int i = 0; i < 16; ++i) zero16[i] = 0.f;
        float xr[2] = {0.f, 0.f}, xi[2] = {0.f, 0.f};
#define S5_LOADA(c) (*(const bf16x8*)(XB + ((c) == 0 ? arow_meta : arow_real + (size_t)16 * ((c) - 1)) * DM + acol))
        {
            bf16x8 a_cur = S5_LOADA(c_beg);
            for (int c = c_beg; c < c_end; ++c) {
                const int cn = (c + 1 < c_end) ? c + 1 : c;
                const bf16x8 a_nxt = S5_LOADA(cn);
                f32x16 bu[2][2];
#pragma unroll
                for (int ri = 0; ri < 2; ++ri)
#pragma unroll
                    for (int sh = 0; sh < 2; ++sh) bu[ri][sh] = MFMA32(a_cur, Bop[ri][sh], zero16);
#pragma unroll
                for (int r = 0; r < 16; ++r)
#pragma unroll
                    for (int sh = 0; sh < 2; ++sh) {
                        const float nr = ar[sh] * xr[sh] - ai[sh] * xi[sh] + bu[0][sh][r];
                        const float ni = ar[sh] * xi[sh] + ai[sh] * xr[sh] + bu[1][sh][r];
                        xr[sh] = nr; xi[sh] = ni;
                    }
                a_cur = a_nxt;
            }
        }
        Ex[wid * 64 + lane] = (f32x4){xr[0], xi[0], xr[1], xi[1]};
        __syncthreads();
        {
            float pr[2], pi[2], p16r[2], p16i[2];
#pragma unroll
            for (int sh = 0; sh < 2; ++sh) {
                float cr = ar[sh], ci = ai[sh];
#pragma unroll
                for (int k = 0; k < 4; ++k) { const float t = cr * cr - ci * ci; ci = 2.f * cr * ci; cr = t; }
                p16r[sh] = cr; p16i[sh] = ci;
#pragma unroll
                for (int k = 0; k < 5; ++k) { const float t = cr * cr - ci * ci; ci = 2.f * cr * ci; cr = t; }
                pr[sh] = cr; pi[sh] = ci;
            }
            xr[0] = xr[1] = xi[0] = xi[1] = 0.f;
            for (int v = 0; v < wid; ++v) {
                const f32x4 e = Ex[v * 64 + lane];
#pragma unroll
                for (int sh = 0; sh < 2; ++sh) {
                    float qr = pr[sh], qi = pi[sh];
                    if (v == 0) { const float t = qr * p16r[sh] - qi * p16i[sh]; qi = qr * p16i[sh] + qi * p16r[sh]; qr = t; }
                    const float nr = qr * xr[sh] - qi * xi[sh] + (sh == 0 ? e[0] : e[2]);
                    const float ni = qr * xi[sh] + qi * xr[sh] + (sh == 0 ? e[1] : e[3]);
                    xr[sh] = nr; xi[sh] = ni;
                }
            }
        }
        {
            const unsigned tr_addr = (unsigned)(size_t)wl + (unsigned)((8 * hh + ((lane & 15) >> 2)) * 64 + 8 * (4 * ((lane >> 4) & 1) + (lane & 3)));
            const float* Dg = (const float*)(ws + S5_DG) + g * 16 + 4 * hh;
            const f32x4 d_lo = *(const f32x4*)Dg, d_hi = *(const f32x4*)(Dg + 8);
            bf16x8 a_cur = S5_LOADA(c_beg);
            for (int c = c_beg; c < c_end; ++c) {
                const int cn = (c + 1 < c_end) ? c + 1 : c;
                const bf16x8 a_nxt = S5_LOADA(cn);
                *(LAS bf16x8*)(uimg + n * 32 + hh * 16) = a_cur;
                f32x16 bu[2][2];
#pragma unroll
                for (int ri = 0; ri < 2; ++ri)
#pragma unroll
                    for (int sh = 0; sh < 2; ++sh) bu[ri][sh] = MFMA32(a_cur, Bop[ri][sh], zero16);
#pragma unroll
                for (int r = 0; r < 16; ++r)
#pragma unroll
                    for (int sh = 0; sh < 2; ++sh) {
                        const float nr = ar[sh] * xr[sh] - ai[sh] * xi[sh] + bu[0][sh][r];
                        const float ni = ar[sh] * xi[sh] + ai[sh] * xr[sh] + bu[1][sh][r];
                        xr[sh] = nr; xi[sh] = ni; bu[0][sh][r] = nr; bu[1][sh][r] = ni;
                    }
#pragma unroll
                for (int ri = 0; ri < 2; ++ri)
#pragma unroll
                    for (int sh = 0; sh < 2; ++sh)
#pragma unroll
                        for (int q4 = 0; q4 < 4; ++q4) { u32x2 w; w.x = cvtpk(bu[ri][sh][4 * q4], bu[ri][sh][4 * q4 + 1]); w.y = cvtpk(bu[ri][sh][4 * q4 + 2], bu[ri][sh][4 * q4 + 3]);
                            *(LAS u32x2*)(wl + (ri * 2 + sh) * 2048 + n * 64 + 8 * (2 * q4 + hh)) = w; }
                s16x4 t0, t1, t2, t3, t4, t5, t6, t7, t8, t9, t10, t11, t12, t13, t14, t15;
#define S5_TR(o, off) "ds_read_b64_tr_b16 %" #o ", %16 offset:" #off "\n\t"
                asm volatile("s_waitcnt lgkmcnt(0)\n\t"
                             S5_TR(0, 0) S5_TR(1, 256) S5_TR(2, 1024) S5_TR(3, 1280) S5_TR(4, 2048) S5_TR(5, 2304) S5_TR(6, 3072) S5_TR(7, 3328)
                             S5_TR(8, 4096) S5_TR(9, 4352) S5_TR(10, 5120) S5_TR(11, 5376) S5_TR(12, 6144) S5_TR(13, 6400) S5_TR(14, 7168) S5_TR(15, 7424)
                             "s_waitcnt lgkmcnt(0)"
                             : "=&v"(t0), "=&v"(t1), "=&v"(t2), "=&v"(t3), "=&v"(t4), "=&v"(t5), "=&v"(t6), "=&v"(t7), "=&v"(t8), "=&v"(t9), "=&v"(t10), "=&v"(t11), "=&v"(t12), "=&v"(t13), "=&v"(t14), "=&v"(t15)
                             : "v"(tr_addr) : "memory");
#undef S5_TR
#define S5_CAT(a, b) __builtin_shufflevector(a, b, 0, 1, 2, 3, 4, 5, 6, 7)
                f32x16 y0 = MFMA32(Cop[0][0][0], S5_CAT(t0, t1), zero16);   y0 = MFMA32(Cop[0][0][1], S5_CAT(t2, t3), y0);
                f32x16 y1 = MFMA32(Cop[0][1][0], S5_CAT(t4, t5), zero16);   y1 = MFMA32(Cop[0][1][1], S5_CAT(t6, t7), y1);
                f32x16 y2 = MFMA32(Cop[1][0][0], S5_CAT(t8, t9), zero16);   y2 = MFMA32(Cop[1][0][1], S5_CAT(t10, t11), y2);
                f32x16 y3 = MFMA32(Cop[1][1][0], S5_CAT(t12, t13), zero16); y3 = MFMA32(Cop[1][1][1], S5_CAT(t14, t15), y3);
#undef S5_CAT
                const u32x2 u_lo = *(const LAS u32x2*)(uimg + n * 32 + 8 * hh), u_hi = *(const LAS u32x2*)(uimg + n * 32 + 16 + 8 * hh);
                float zz[8];
#pragma unroll
                for (int i = 0; i < 8; ++i) {
                    const unsigned uw = (i < 4) ? (i < 2 ? u_lo.x : u_lo.y) : (i < 6 ? u_hi.x : u_hi.y);
                    const float uf = (i & 1) ? __uint_as_float(uw & 0xffff0000u) : __uint_as_float(uw << 16);
                    const float dd = (i < 4) ? d_lo[i & 3] : d_hi[i & 3];
                    const float y = (y0[i] + y1[i]) + (y2[i] + y3[i]) + dd * uf;
                    zz[i] = gelu_tanh(y);
                }
                if (c > 0 || (bp == 0 && bs == 0)) {
                    const size_t orow = (c == 0) ? arow_meta : arow_real + (size_t)16 * (c - 1);
                    bf16_t* zp = Z + orow * DM + g * 16 + 4 * hh;
                    u32x2 w0, w1; w0.x = cvtpk(zz[0], zz[1]); w0.y = cvtpk(zz[2], zz[3]); w1.x = cvtpk(zz[4], zz[5]); w1.y = cvtpk(zz[6], zz[7]);
                    *(u32x2*)zp = w0; *(u32x2*)(zp + 8) = w1;
                }
                a_cur = a_nxt;
            }
        }
        __syncthreads();
    }
#undef S5_LOADA
}

__device__ __forceinline__ void attn_phase(const Ptrs& P) {
    const int tid = threadIdx.x, lane = tid & 63, wid = __builtin_amdgcn_readfirstlane(tid >> 6), n = lane & 31, hh = lane >> 5;
    unsigned char* ws = P.ws;
    const bf16_t* KB = (const bf16_t*)(ws + OFF_KB);
    const bf16_t* VT = (const bf16_t*)(ws + OFF_VT);
    bf16_t* QO = (bf16_t*)(ws + OFF_ZQ);
    const int gw = blockIdx.x * 8 + wid, NGW = gridDim.x * 8;
    constexpr int NREAL = NB * NHEAD * 128;
    for (int u = gw; u < NREAL + NHEAD; u += NGW) {
        const bool metaq = u >= NREAL;
        const int qt = metaq ? -1 : (u & 127), h = metaq ? (u - NREAL) : ((u >> 7) & 15), b = metaq ? 0 : (u >> 11);
        const int qrow0 = metaq ? MR : b * SEQ + 32 * qt;
        bf16x8 qf[4];
#pragma unroll
        for (int s = 0; s < 4; ++s) qf[s] = *(const bf16x8*)(QO + (size_t)(qrow0 + n) * DM + h * 64 + 16 * s + 8 * hh);
        f32x16 o0, o1;
#pragma unroll
        for (int i = 0; i < 16; ++i) { o0[i] = 0.f; o1[i] = 0.f; }
        float R = 0.f;
        const int metalim = metaq ? (n < 16 ? n : 16) : 16;
        bf16x8 kf[4]; u32x2 vf[2][2][2];
#define AT_LOAD(KF, VF, kt_) do { const int krow0_ = (kt_) >= 0 ? b * SEQ + 32 * (kt_) : MR; \
            _Pragma("unroll") for (int s = 0; s < 4; ++s) KF[s] = *(const bf16x8*)(KB + (size_t)(krow0_ + n) * DM + h * 64 + 16 * s + 8 * hh); \
            _Pragma("unroll") for (int mt = 0; mt < 2; ++mt) _Pragma("unroll") for (int s = 0; s < 2; ++s) { const bf16_t* vp_ = VT + (size_t)(h * 64 + 32 * mt + n) * MP + krow0_ + 16 * s + 4 * hh; \
                VF[mt][s][0] = *(const u32x2*)vp_; VF[mt][s][1] = *(const u32x2*)(vp_ + 8); } } while (0)
        int kt = qt;
        AT_LOAD(kf, vf, kt);
        for (;;) {
            const int ktn = kt > 0 ? kt - 1 : -1;
            bf16x8 kf2[4]; u32x2 vf2[2][2][2];
            AT_LOAD(kf2, vf2, ktn);
            f32x16 z;
#pragma unroll
            for (int i = 0; i < 16; ++i) z[i] = 0.f;
#pragma unroll
            for (int s = 0; s < 4; ++s) z = MFMA32(kf[s], qf[s], z);
            const int lim = kt < 0 ? metalim : (kt == qt ? n : 32);
            float ls[16], l1[16];
#pragma unroll
            for (int i = 0; i < 16; ++i) {
                const int j = (i & 3) + 8 * (i >> 2) + 4 * hh;
                const float zz = z[i];
                const float t = __expf(-fabsf(zz));
                const float lsv = fminf(zz, 0.f) - __logf(1.f + t);
                const bool valid = j < lim;
                ls[i] = lsv; l1[i] = valid ? lsv - zz : 0.f;
            }
            float qs[4], th[4];
#pragma unroll
            for (int a = 0; a < 4; ++a) { qs[a] = (l1[4 * a] + l1[4 * a + 1]) + (l1[4 * a + 2] + l1[4 * a + 3]); th[a] = __shfl_xor(qs[a], 32); }
            float G[8];
#pragma unroll
            for (int a = 0; a < 4; ++a) { G[2 * a] = hh ? th[a] : qs[a]; G[2 * a + 1] = hh ? qs[a] : th[a]; }
            const float sf7 = 0.f, sf6 = sf7 + G[7], sf5 = sf6 + G[6], sf4 = sf5 + G[5], sf3 = sf4 + G[4], sf2 = sf3 + G[3], sf1 = sf2 + G[2], sf0 = sf1 + G[1];
            const float total = sf0 + G[0];
            const float sm0 = hh ? sf1 : sf0, sm1 = hh ? sf3 : sf2, sm2 = hh ? sf5 : sf4, sm3 = hh ? sf7 : sf6;
            float w[16];
#define AT_W(a, SM) do { const float base = R + (SM); const float e3 = base, e2 = e3 + l1[4 * (a) + 3], e1 = e2 + l1[4 * (a) + 2], e0 = e1 + l1[4 * (a) + 1]; const int j0 = 8 * (a) + 4 * hh; \
                w[4 * (a) + 0] = (j0 + 0 < lim) ? __expf(ls[4 * (a) + 0] + e0) : 0.f; w[4 * (a) + 1] = (j0 + 1 < lim) ? __expf(ls[4 * (a) + 1] + e1) : 0.f; \
                w[4 * (a) + 2] = (j0 + 2 < lim) ? __expf(ls[4 * (a) + 2] + e2) : 0.f; w[4 * (a) + 3] = (j0 + 3 < lim) ? __expf(ls[4 * (a) + 3] + e3) : 0.f; } while (0)
            AT_W(0, sm0); AT_W(1, sm1); AT_W(2, sm2); AT_W(3, sm3);
#undef AT_W
            R += total;
#pragma unroll
            for (int s = 0; s < 2; ++s) {
                u32x4 pw; pw.x = cvtpk(w[8 * s], w[8 * s + 1]); pw.y = cvtpk(w[8 * s + 2], w[8 * s + 3]); pw.z = cvtpk(w[8 * s + 4], w[8 * s + 5]); pw.w = cvtpk(w[8 * s + 6], w[8 * s + 7]);
                const bf16x8 pf = __builtin_bit_cast(bf16x8, pw);
                u32x4 va; va.x = vf[0][s][0].x; va.y = vf[0][s][0].y; va.z = vf[0][s][1].x; va.w = vf[0][s][1].y;
                u32x4 vb; vb.x = vf[1][s][0].x; vb.y = vf[1][s][0].y; vb.z = vf[1][s][1].x; vb.w = vf[1][s][1].y;
                o0 = MFMA32(__builtin_bit_cast(bf16x8, va), pf, o0);
                o1 = MFMA32(__builtin_bit_cast(bf16x8, vb), pf, o1);
            }
            if (kt < 0) break;
            if (__all(R < -104.0f)) break;
            kt = ktn;
#pragma unroll
            for (int s = 0; s < 4; ++s) kf[s] = kf2[s];
#pragma unroll
            for (int mt = 0; mt < 2; ++mt)
#pragma unroll
                for (int s = 0; s < 2; ++s) { vf[mt][s][0] = vf2[mt][s][0]; vf[mt][s][1] = vf2[mt][s][1]; }
        }
#undef AT_LOAD
        if (!metaq || n < 16) {
            bf16_t* op = QO + (size_t)(qrow0 + n) * DM + h * 64 + 4 * hh;
#pragma unroll
            for (int a = 0; a < 4; ++a) {
                u32x2 w0; w0.x = cvtpk(o0[4 * a], o0[4 * a + 1]); w0.y = cvtpk(o0[4 * a + 2], o0[4 * a + 3]);
                u32x2 w1; w1.x = cvtpk(o1[4 * a], o1[4 * a + 1]); w1.y = cvtpk(o1[4 * a + 2], o1[4 * a + 3]);
                *(u32x2*)(op + 8 * a) = w0; *(u32x2*)(op + 32 + 8 * a) = w1;
            }
        }
    }
}

__device__ __forceinline__ void final_phase(const Ptrs& P) {
    const int tid = threadIdx.x, lane = tid & 63, wid = tid >> 6;
    const float* H = (const float*)(P.ws + OFF_H);
    const u64* ss3 = (const u64*)(P.ws + OFF_SS) + 3 * MP;
    const float* gain = P.in[19];
    f32x4 gv[4];
#pragma unroll
    for (int j = 0; j < 4; ++j) gv[j] = *(const f32x4*)(gain + 4 * lane + 256 * j);
    const int gw = blockIdx.x * 8 + wid, NGW = gridDim.x * 8;
    for (int row = gw; row < MR; row += NGW) {
        const float rs = rstd_of(ss3[row]);
#pragma unroll
        for (int j = 0; j < 4; ++j) { const f32x4 v = *(const f32x4*)(H + (size_t)row * DM + 4 * lane + 256 * j); *(f32x4*)(P.out + (size_t)row * DM + 4 * lane + 256 * j) = v * rs * gv[j]; }
    }
}

constexpr int LDS_BYTES = 131072;
__global__ void __launch_bounds__(512, 2) s5yoco_fwd(Ptrs P) {
    extern __shared__ __attribute__((aligned(16))) unsigned char lds_raw[];
    LAS unsigned char* lds = (LAS unsigned char*)lds_raw;
    cg::grid_group grid = cg::this_grid();
    unsigned char* ws = P.ws;
    u64* ss = (u64*)(ws + OFF_SS);
    bf16_t* XB = (bf16_t*)(ws + OFF_XB); float* H = (float*)(ws + OFF_H); bf16_t* ZQ = (bf16_t*)(ws + OFF_ZQ); bf16_t* ACT = (bf16_t*)(ws + OFF_ACT);
    const int G = gridDim.x, c = blockIdx.x;
    StaticOrder S;

    p0_prologue(P, lds);
    grid.sync();
    s5_phase(P, lds);
    grid.sync();
    {
        S.init(MP, 2048, G, c);
        EpiGLU E{P.in[0], P.in[1], H, XB, ss};
        pg8::gemm_phase<EpiGLU, StaticOrder, true, true>(lds, Gemm{ZQ, (const bf16_t*)(ws + W_GLU), MP, 2048, 1024}, S, E);
    }
    grid.sync();
    {
        S.init(MP, 5632, G, c);
        EpiSwiGLU E{ss, ACT};
        pg8::gemm_phase<EpiSwiGLU, StaticOrder, true, true>(lds, Gemm{XB, (const bf16_t*)(ws + W_FI0), MP, 5632, 1024}, S, E);
    }
    grid.sync();
    {
        S.init(MP, 1024, G, c);
        EpiResid<true> E{H, XB, ss + MP};
        pg8::gemm_phase<EpiResid<true>, StaticOrder, true, true>(lds, Gemm{ACT, (const bf16_t*)(ws + W_FO0), MP, 1024, DFF}, S, E);
    }
    grid.sync();
    {
        S.init(MP, 2048, G, c);
        EpiKQ E{ss + MP, (bf16_t*)(ws + OFF_KB), ZQ};
        pg8::gemm_phase<EpiKQ, StaticOrder, true, true>(lds, Gemm{XB, (const bf16_t*)(ws + W_KQ), MP, 2048, 1024}, S, E);
        S.init(1024, MP, G, c);
        EpiVt E2{ss + MP, (bf16_t*)(ws + OFF_VT)};
        pg8::gemm_phase<EpiVt, StaticOrder, true, true>(lds, Gemm{(const bf16_t*)(ws + W_V), XB, 1024, MP, 1024}, S, E2);
    }
    grid.sync();
    attn_phase(P);
    grid.sync();
    {
        S.init(MP, 1024, G, c);
        EpiResid<true> E{H, XB, ss + 2 * MP};
        pg8::gemm_phase<EpiResid<true>, StaticOrder, true, true>(lds, Gemm{ZQ, (const bf16_t*)(ws + W_O), MP, 1024, 1024}, S, E);
    }
    grid.sync();
    {
        S.init(MP, 5632, G, c);
        EpiSwiGLU E{ss + 2 * MP, ACT};
        pg8::gemm_phase<EpiSwiGLU, StaticOrder, true, true>(lds, Gemm{XB, (const bf16_t*)(ws + W_FI1), MP, 5632, 1024}, S, E);
    }
    grid.sync();
    {
        S.init(MP, 1024, G, c);
        EpiResid<false> E{H, XB, ss + 3 * MP};
        pg8::gemm_phase<EpiResid<false>, StaticOrder, true, true>(lds, Gemm{ACT, (const bf16_t*)(ws + W_FO1), MP, 1024, DFF}, S, E);
    }
    grid.sync();
    final_phase(P);
}

extern "C" void kernel_launch(void* const* d_in, const int* in_sizes, int n_in, void* d_out, int out_size, void* d_ws, size_t ws_size, hipStream_t stream) {
    static int grid = 0;
    if (grid == 0) {
        if (n_in != 20 || ws_size < WS_END) { fprintf(stderr, "kernel_launch: unexpected problem (n_in %d, ws %zu < %zu)\n", n_in, ws_size, (size_t)WS_END); grid = -1; return; }
        int dev = 0, cus = 0, per_cu = 0;
        hipGetDevice(&dev);
        hipDeviceGetAttribute(&cus, hipDeviceAttributeMultiprocessorCount, dev);
        if (hipFuncSetAttribute((const void*)s5yoco_fwd, hipFuncAttributeMaxDynamicSharedMemorySize, LDS_BYTES) != hipSuccess) { fprintf(stderr, "kernel_launch: hipFuncSetAttribute failed\n"); grid = -1; return; }
        if (hipOccupancyMaxActiveBlocksPerMultiprocessor(&per_cu, (const void*)s5yoco_fwd, 512, LDS_BYTES) != hipSuccess || per_cu < 1) { fprintf(stderr, "kernel_launch: occupancy query says %d\n", per_cu); per_cu = 1; }
        (void)hipGetLastError();
        grid = cus;
    }
    if (grid < 0) return;
    Ptrs p{};
    for (int i = 0; i < 20; ++i) p.in[i] = (const float*)d_in[i];
    p.out = (float*)d_out; p.ws = (unsigned char*)d_ws;
    void* args[] = {&p};
    hipError_t e = hipLaunchCooperativeKernel((const void*)s5yoco_fwd, dim3(grid), dim3(512), args, LDS_BYTES, stream);
    if (e != hipSuccess) fprintf(stderr, "cooperative launch failed: %s (grid %d)\n", hipGetErrorString(e), grid);
}
```

```cpp
#include <hip/hip_runtime.h>
#include <hip/hip_cooperative_groups.h>
#include <cstdio>
#include <cstdint>
#include <type_traits>
namespace cg = cooperative_groups;
namespace pg8 {
#define PG8_LAS __attribute__((address_space(3)))
typedef unsigned short bf16_t;
typedef short bf16x8 __attribute__((ext_vector_type(8)));
typedef float f32x4 __attribute__((ext_vector_type(4)));
typedef unsigned u32x4 __attribute__((ext_vector_type(4)));
constexpr int BM = 256, BK = 64, HALF = 128, HTB = HALF * BK * 2  , STAGE_BYTES = 8 * HTB, NXCD = 8, WGM = 8;

__host__ __device__ __forceinline__ int lds_byte(int r, int c) { const int st = (r >> 4) * 2 + (c >> 5), rr = r & 15, cc = c & 31, ob = rr * 64 + cc * 2; return st * 1024 + (ob ^ (((ob >> 9) & 1) << 5)); }
__host__ __device__ __forceinline__ void stage_rc(int b, int& R, int& C) { const int st = b / 1024, sb = b % 1024, swz = sb ^ (((sb >> 9) & 1) << 5); R = (st >> 1) * 16 + swz / 64; C = (st & 1) * 32 + (swz % 64) / 2; }
__host__ __device__ __forceinline__ int perm32(int rho) { const int n = rho >> 4, i = rho & 15; return 8 * (i >> 2) + 4 * n + (i & 3); }

struct Unit { int pm, pn; };
struct Gemm { const bf16_t* A; const bf16_t* Bt; int M, N, K; };

struct StaticOrder {
    int nM, nN, nwg, G, c;
    __host__ __device__ void init(int M, int N, int G_, int c_) { nM = M / BM; nN = N / BM; nwg = nM * nN; G = G_; c = c_; }
    __host__ __device__ bool next(int i, Unit& u) const {
        const long L = (long)i * G + c; if (L >= nwg) return false;
        int wgid = (int)L; { const int q = nwg / NXCD, r = nwg % NXCD, xcd = wgid % NXCD, off = wgid / NXCD; wgid = (xcd < r ? xcd * (q + 1) : r * (q + 1) + (xcd - r) * q) + off; }
        const int nig = WGM * nN, gid = wgid / nig, fm = gid * WGM, gsz = (nM - fm) < WGM ? (nM - fm) : WGM;
        u.pm = fm + ((wgid % nig) % gsz); u.pn = (wgid % nig) / gsz; return true;
    }
    __device__ __forceinline__ void a_ready(const Unit&) const {}
    __device__ __forceinline__ void done(const Unit&) const {}
};
typedef float f32x2 __attribute__((ext_vector_type(2)));

template <class Epi, class Sched, bool ALIGN_EPI = false, bool SP2 = false>
__device__ __forceinline__ void gemm_phase(PG8_LAS unsigned char* lds, const Gemm g, const Sched& S, const Epi& E) {
    const int tid = threadIdx.x, wid = __builtin_amdgcn_readfirstlane(tid >> 6), lane = tid & 63, wr = wid >> 2, wc = wid & 3, fr = lane & 15, fq = lane >> 4;
    const int K = g.K, nt = K / BK;
    unsigned voffA[2], voffB[2];
#pragma unroll
    for (int i = 0; i < 2; ++i) { int R, C; stage_rc(tid * 16 + i * 8192, R, C); const int Rb = Epi::PERM ? ((R & ~31) + perm32(R & 31)) : R;
        voffA[i] = (unsigned)(R * K + C) * 2u; voffB[i] = (unsigned)(Rb * K + C) * 2u; }
    const size_t kstep = (size_t)(BK * 2);
    const size_t hstep = (size_t)HALF * K * 2;
    const size_t tstep = 2 * hstep;
    const unsigned ldsw = (unsigned)wid * 1024u;
    const int aoff = lds_byte(wr * 64 + fr, fq * 8), boff = lds_byte(wc * 32 + fr, fq * 8);
#define PG8_SA(b, h) (((b) * 2 + (h)) * HTB)
#define PG8_SB(b, h) ((4 + (b) * 2 + (h)) * HTB)
#define PG8_STAGE(bufoff, gbase, voff) do { _Pragma("unroll") for (int _i = 0; _i < 2; ++_i) \
        __builtin_amdgcn_global_load_lds((const unsigned*)((const char*)(gbase) + (voff)[_i]), (PG8_LAS unsigned*)(lds + (bufoff) + ldsw + _i * 8192), 16, 0, 0); } while (0)
#define PG8_LDA(dst, b, h) do { _Pragma("unroll") for (int m = 0; m < 4; ++m) _Pragma("unroll") for (int k = 0; k < 2; ++k) dst[m][k] = *(const PG8_LAS bf16x8*)(lds + PG8_SA(b, h) + aoff + m * 2048 + k * 1024); } while (0)
#define PG8_LDB(dst, b, h) do { _Pragma("unroll") for (int n = 0; n < 2; ++n) _Pragma("unroll") for (int k = 0; k < 2; ++k) dst[n][k] = *(const PG8_LAS bf16x8*)(lds + PG8_SB(b, h) + boff + n * 2048 + k * 1024); } while (0)
#define PG8_MMA(ai, bj, At, Bt) do { __builtin_amdgcn_s_setprio(1); _Pragma("unroll") for (int m = 0; m < 4; ++m) _Pragma("unroll") for (int n = 0; n < 2; ++n) _Pragma("unroll") for (int k = 0; k < 2; ++k) \
        acc[ai][bj][m][n] = __builtin_amdgcn_mfma_f32_16x16x32_bf16(Bt[n][k], At[m][k], acc[ai][bj][m][n], 0, 0, 0); __builtin_amdgcn_s_setprio(0); } while (0)
#define PG8_WAIT_V(n) asm volatile("s_waitcnt vmcnt(" #n ")" ::: "memory")
#define PG8_WAIT_L(n) asm volatile("s_waitcnt lgkmcnt(" #n ")" ::: "memory")
#define PG8_BAR __builtin_amdgcn_s_barrier()
#define PG8_SCHED __builtin_amdgcn_sched_barrier(0)
    Unit cur, nxt; int ui = 0;
    if (!S.next(0, cur)) return;
    f32x4 acc[2][2][4][2];
#pragma unroll
    for (int a = 0; a < 2; ++a)
#pragma unroll
        for (int b = 0; b < 2; ++b)
#pragma unroll
            for (int m = 0; m < 4; ++m)
#pragma unroll
                for (int n = 0; n < 2; ++n) acc[a][b][m][n] = (f32x4){0.f, 0.f, 0.f, 0.f};
    bf16x8 At[4][2], B0[2][2], B1[2][2];
    const char* cA = (const char*)g.A + (size_t)cur.pm * tstep; const char* cB = (const char*)g.Bt + (size_t)cur.pn * tstep;
    S.a_ready(cur);
    if constexpr (SP2) {
        PG8_STAGE(PG8_SB(0, 0), cB, voffB); PG8_STAGE(PG8_SB(0, 1), cB + hstep, voffB); PG8_STAGE(PG8_SA(0, 0), cA, voffA); PG8_STAGE(PG8_SA(0, 1), cA + hstep, voffA);
        if (wr == 1) PG8_BAR;
        PG8_WAIT_V(2); PG8_BAR;
        PG8_STAGE(PG8_SB(1, 0), cB + kstep, voffB); PG8_STAGE(PG8_SA(1, 0), cA + kstep, voffA); PG8_STAGE(PG8_SB(1, 1), cB + hstep + kstep, voffB);
        PG8_WAIT_V(6); PG8_BAR;
    } else {
        PG8_STAGE(PG8_SB(0, 0), cB, voffB); PG8_STAGE(PG8_SA(0, 0), cA, voffA); PG8_STAGE(PG8_SB(0, 1), cB + hstep, voffB); PG8_STAGE(PG8_SA(0, 1), cA + hstep, voffA);
        if (wr == 1) PG8_BAR;
        PG8_WAIT_V(4); PG8_BAR;
        PG8_STAGE(PG8_SB(1, 0), cB + kstep, voffB); PG8_STAGE(PG8_SA(1, 0), cA + kstep, voffA); PG8_STAGE(PG8_SB(1, 1), cB + hstep + kstep, voffB);
        PG8_WAIT_V(6); PG8_BAR;
    }
    for (;;) {
        const bool has_next = S.next(ui + 1, nxt);
        const char* nA = has_next ? (const char*)g.A + (size_t)nxt.pm * tstep : cA; const char* nB = has_next ? (const char*)g.Bt + (size_t)nxt.pn * tstep : cB;
        for (int t = 0; t < nt; t += 2) {
            const bool last = (t == nt - 2);
            const char* a1 = cA + (size_t)(t + 1) * kstep;
            const char* a2 = last ? nA : cA + (size_t)(t + 2) * kstep; const char* b2 = last ? nB : cB + (size_t)(t + 2) * kstep;
            const char* a3 = a2 + kstep; const char* b3 = b2 + kstep;
            if (last && has_next) S.a_ready(nxt);
            if constexpr (SP2) {
            PG8_LDB(B0, 0, 0); PG8_LDB(B1, 0, 1); PG8_SCHED; PG8_LDA(At, 0, 0); PG8_STAGE(PG8_SA(1, 1), a1 + hstep, voffA);
            PG8_WAIT_V(8); PG8_WAIT_L(0); PG8_BAR; PG8_MMA(0, 0, At, B0); PG8_MMA(0, 1, At, B1); PG8_BAR; PG8_SCHED;
            PG8_LDA(At, 0, 1); PG8_STAGE(PG8_SB(0, 0), b2, voffB); PG8_STAGE(PG8_SB(0, 1), b2 + hstep, voffB); PG8_STAGE(PG8_SA(0, 0), a2, voffA);
            PG8_WAIT_V(8); PG8_WAIT_L(0); PG8_BAR; PG8_MMA(1, 0, At, B0); PG8_MMA(1, 1, At, B1); PG8_BAR; PG8_SCHED;
            PG8_LDB(B0, 1, 0); PG8_LDB(B1, 1, 1); PG8_SCHED; PG8_LDA(At, 1, 0); PG8_STAGE(PG8_SA(0, 1), a2 + hstep, voffA);
            PG8_WAIT_V(8); PG8_WAIT_L(0); PG8_BAR; PG8_MMA(0, 0, At, B0); PG8_MMA(0, 1, At, B1); PG8_BAR; PG8_SCHED;
            PG8_LDA(At, 1, 1); PG8_STAGE(PG8_SB(1, 0), b3, voffB); PG8_STAGE(PG8_SB(1, 1), b3 + hstep, voffB); PG8_STAGE(PG8_SA(1, 0), a3, voffA);
            PG8_WAIT_V(8); PG8_WAIT_L(0); PG8_BAR; PG8_MMA(1, 0, At, B0); PG8_MMA(1, 1, At, B1); PG8_BAR; PG8_SCHED;
            } else {
            PG8_LDB(B0, 0, 0); PG8_SCHED; PG8_LDA(At, 0, 0); PG8_STAGE(PG8_SA(1, 1), a1 + hstep, voffA);
            PG8_WAIT_L(8); PG8_BAR; PG8_WAIT_L(0); PG8_MMA(0, 0, At, B0); PG8_BAR; PG8_SCHED;
            PG8_LDB(B1, 0, 1); PG8_STAGE(PG8_SB(0, 0), b2, voffB);
            PG8_BAR; PG8_WAIT_L(0); PG8_MMA(0, 1, At, B1); PG8_BAR;
            PG8_LDA(At, 0, 1); PG8_STAGE(PG8_SA(0, 0), a2, voffA);
            PG8_BAR; PG8_WAIT_L(0); PG8_MMA(1, 0, At, B0); PG8_BAR; PG8_SCHED;
            PG8_STAGE(PG8_SB(0, 1), b2 + hstep, voffB);
            PG8_WAIT_V(6); PG8_BAR; PG8_MMA(1, 1, At, B1); PG8_BAR;
            PG8_LDB(B0, 1, 0); PG8_SCHED; PG8_LDA(At, 1, 0); PG8_STAGE(PG8_SA(0, 1), a2 + hstep, voffA);
            PG8_WAIT_L(8); PG8_BAR; PG8_WAIT_L(0); PG8_MMA(0, 0, At, B0); PG8_BAR; PG8_SCHED;
            PG8_LDB(B1, 1, 1); PG8_STAGE(PG8_SB(1, 0), b3, voffB);
            PG8_BAR; PG8_WAIT_L(0); PG8_MMA(0, 1, At, B1); PG8_BAR;
            PG8_LDA(At, 1, 1); PG8_STAGE(PG8_SA(1, 0), a3, voffA);
            PG8_BAR; PG8_WAIT_L(0); PG8_MMA(1, 0, At, B0); PG8_BAR; PG8_SCHED;
            PG8_STAGE(PG8_SB(1, 1), b3 + hstep, voffB);
            PG8_WAIT_V(6); PG8_BAR; PG8_MMA(1, 1, At, B1); PG8_BAR;
            }
        }
        if constexpr (ALIGN_EPI) { if (wr == 0) PG8_BAR; }
        if constexpr (!Epi::AFTER_DRAIN) { E(acc, cur, wr, wc, fr, fq); S.done(cur); }
        if (!has_next) break;
#pragma unroll
        for (int a = 0; a < 2; ++a)
#pragma unroll
            for (int b = 0; b < 2; ++b)
#pragma unroll
                for (int m = 0; m < 4; ++m)
#pragma unroll
                    for (int n = 0; n < 2; ++n) acc[a][b][m][n] = (f32x4){0.f, 0.f, 0.f, 0.f};
        cur = nxt; cA = nA; cB = nB; ++ui;
        if constexpr (ALIGN_EPI) { if (wr == 1) PG8_BAR; }
    }
    PG8_WAIT_V(0);
    if constexpr (!ALIGN_EPI) { if (wr == 0) PG8_BAR; }
    PG8_BAR;
    if constexpr (Epi::AFTER_DRAIN) { E.fused(acc, cur, wr, wc, fr, fq, lds, wid, lane); S.done(cur); }
#undef PG8_SA
#undef PG8_SB
#undef PG8_STAGE
#undef PG8_LDA
#undef PG8_LDB
#undef PG8_MMA
#undef PG8_WAIT_V
#undef PG8_WAIT_L
#undef PG8_BAR
#undef PG8_SCHED
}
}

using pg8::bf16_t; using pg8::bf16x8; using pg8::f32x4; using pg8::Unit; using pg8::Gemm; using pg8::StaticOrder;
#define LAS __attribute__((address_space(3)))
typedef float f32x16 __attribute__((ext_vector_type(16)));
typedef short s16x4 __attribute__((ext_vector_type(4)));
typedef unsigned u32x2 __attribute__((ext_vector_type(2)));
typedef unsigned u32x4 __attribute__((ext_vector_type(4)));
typedef float f32x2_t __attribute__((ext_vector_type(2)));
typedef __bf16 bf16x2_t __attribute__((ext_vector_type(2)));
typedef unsigned long long u64;

constexpr int NB = 8, SEQ = 4096, NMETA = 16, DM = 1024, DFF = 2816, NHEAD = 16;
constexpr int MR = NB * SEQ;
constexpr int MROWS = MR + NMETA;
constexpr int MP = 33024;
constexpr float QSCALE = -0.125f * 1.4426950408889634f;
constexpr float SS_SCALE = 1048576.0f;

constexpr size_t OFF_SS = 0;
constexpr size_t OFF_BAR = 0x108000;
constexpr size_t OFF_S5 = 0x110000;
constexpr size_t S5_ABAR = OFF_S5;
constexpr size_t S5_BB = OFF_S5 + 0x8000;
constexpr size_t S5_CB = S5_BB + 0x40000;
constexpr size_t S5_DG = S5_CB + 0x40000;
constexpr size_t OFF_INV0 = 0x1A0000;
constexpr size_t OFF_W = 0x210000;
constexpr size_t W_GLU = OFF_W;
constexpr size_t W_FI0 = W_GLU + 2048ull * 1024 * 2;
constexpr size_t W_FI1 = W_FI0 + 5632ull * 1024 * 2;
constexpr size_t W_FO0 = W_FI1 + 5632ull * 1024 * 2;
constexpr size_t W_FO1 = W_FO0 + 1024ull * 2816 * 2;
constexpr size_t W_KQ = W_FO1 + 1024ull * 2816 * 2;
constexpr size_t W_V = W_KQ + 2048ull * 1024 * 2;
constexpr size_t W_O = W_V + 1024ull * 1024 * 2;
constexpr size_t OFF_XB = W_O + 1024ull * 1024 * 2;
constexpr size_t OFF_H = OFF_XB + (size_t)MP * 1024 * 2;
constexpr size_t OFF_W1 = OFF_H;
constexpr size_t OFF_ZQ = OFF_H + (size_t)MP * 1024 * 4;
constexpr size_t OFF_KB = OFF_ZQ + (size_t)MP * 1024 * 2;
constexpr size_t OFF_VT = OFF_KB + (size_t)MP * 1024 * 2;
constexpr size_t OFF_ACT = OFF_ZQ;
constexpr size_t WS_END = OFF_VT + (size_t)MP * 1024 * 2;
static_assert((size_t)MP * DFF * 2 <= WS_END - OFF_ACT, "ACT overlay fits");
static_assert(S5_DG + 4096 <= OFF_W, "s5 params fit");
static_assert(OFF_KB == OFF_ZQ + (size_t)MP * 1024 * 2 && OFF_VT == OFF_ZQ + 2 * (size_t)MP * 1024 * 2, "Q | K | V adjacent");

__device__ __forceinline__ unsigned cvtpk(float lo, float hi) { f32x2_t v = {lo, hi}; bf16x2_t b = __builtin_convertvector(v, bf16x2_t); return __builtin_bit_cast(unsigned, b); }
__device__ __forceinline__ float frcp(float x) { return __builtin_amdgcn_rcpf(x); }
__device__ __forceinline__ float rstd_of(u64 v) { return rsqrtf((float)v * (1.0f / (SS_SCALE * 1024.0f)) + 1e-6f); }
__device__ __forceinline__ void ss_add(u64* p, float s) { __hip_atomic_fetch_add(p, (u64)(s * SS_SCALE), __ATOMIC_RELAXED, __HIP_MEMORY_SCOPE_AGENT); }
__device__ __forceinline__ float bf2f(unsigned short b) { return __uint_as_float((unsigned)b << 16); }


struct EpiGLU {
    static constexpr bool PERM = true, AFTER_DRAIN = false;
    const float* inv0; bf16_t* XB; u64* ss;
    __device__ __forceinline__ void operator()(const f32x4 (&acc)[2][2][4][2], const Unit& u, int wr, int wc, int fr, int fq) const {
        const int col0 = u.pn * 128 + wc * 32 + 8 * fq;
        const int row0 = u.pm * 256 + wr * 64 + fr;
        const size_t rbase = (size_t)row0 * DM + col0;
#pragma unroll
        for (int ai = 0; ai < 2; ++ai) {
            u32x4 hv[4]; float iv[4];
#pragma unroll
            for (int m = 0; m < 4; ++m) { hv[m] = *(const u32x4*)(XB + rbase + (size_t)(ai * 128 + m * 16) * DM); iv[m] = inv0[row0 + ai * 128 + m * 16]; }
            float s[4];
#pragma unroll
            for (int m = 0; m < 4; ++m) {
                const u32x4 hb = hv[m];
                f32x4 h0 = {__uint_as_float(hb.x << 16), __uint_as_float(hb.x & 0xffff0000u), __uint_as_float(hb.y << 16), __uint_as_float(hb.y & 0xffff0000u)};
                f32x4 h1 = {__uint_as_float(hb.z << 16), __uint_as_float(hb.z & 0xffff0000u), __uint_as_float(hb.w << 16), __uint_as_float(hb.w & 0xffff0000u)};
                h0 *= iv[m]; h1 *= iv[m];
                const f32x4 v0 = acc[ai][0][m][0], v1 = acc[ai][0][m][1], g0 = acc[ai][1][m][0], g1 = acc[ai][1][m][1];
#pragma unroll
                for (int j = 0; j < 4; ++j) { h0[j] += v0[j] * frcp(1.f + __expf(-g0[j])); h1[j] += v1[j] * frcp(1.f + __expf(-g1[j])); }
                const size_t off = rbase + (size_t)(ai * 128 + m * 16) * DM;
                u32x4 w; w.x = cvtpk(h0[0], h0[1]); w.y = cvtpk(h0[2], h0[3]); w.z = cvtpk(h1[0], h1[1]); w.w = cvtpk(h1[2], h1[3]);
                *(u32x4*)(XB + off) = w;
                s[m] = (h0[0] * h0[0] + h0[1] * h0[1]) + (h0[2] * h0[2] + h0[3] * h0[3]) + (h1[0] * h1[0] + h1[1] * h1[1]) + (h1[2] * h1[2] + h1[3] * h1[3]);
            }
#pragma unroll
            for (int m = 0; m < 4; ++m) { s[m] += __shfl_xor(s[m], 16); s[m] += __shfl_xor(s[m], 32); }
            const float mine = fq == 0 ? s[0] : (fq == 1 ? s[1] : (fq == 2 ? s[2] : s[3]));
            ss_add(ss + (u.pm * 256 + ai * 128 + wr * 64 + fq * 16 + fr), mine);
        }
    }
};

template <bool CHEAP = false> struct EpiSwiGLU {
    static constexpr bool PERM = true, AFTER_DRAIN = false;
    const u64* ss; bf16_t* ACT;
    __device__ __forceinline__ void operator()(const f32x4 (&acc)[2][2][4][2], const Unit& u, int wr, int wc, int fr, int fq) const {
        const int col0 = u.pn * 128 + wc * 32 + 8 * fq;
        const int row0 = u.pm * 256 + wr * 64 + fr;
        u64 sv[2][4];
#pragma unroll
        for (int ai = 0; ai < 2; ++ai)
#pragma unroll
            for (int m = 0; m < 4; ++m) sv[ai][m] = ss[row0 + ai * 128 + m * 16];
#pragma unroll
        for (int ai = 0; ai < 2; ++ai)
#pragma unroll
            for (int m = 0; m < 4; ++m) {
                const int row = row0 + ai * 128 + m * 16;
                const float rs = rstd_of(sv[ai][m]);
                const float c1 = rs * -1.4426950408889634f, rs2 = rs * rs;
                unsigned ow[4];
#pragma unroll
                for (int n = 0; n < 2; ++n)
#pragma unroll
                    for (int jp = 0; jp < 2; ++jp) {
                        const f32x2_t ag = {acc[ai][0][m][n][2 * jp], acc[ai][0][m][n][2 * jp + 1]}, au = {acc[ai][1][m][n][2 * jp], acc[ai][1][m][n][2 * jp + 1]};
                        f32x2_t ov;
                        if (CHEAP) ov = ag * au;
                        else { const f32x2_t t = ag * c1; f32x2_t e; e.x = __builtin_amdgcn_exp2f(t.x); e.y = __builtin_amdgcn_exp2f(t.y);
                            const f32x2_t d = e + 1.0f; f32x2_t r; r.x = frcp(d.x); r.y = frcp(d.y);
                            ov = (ag * au) * (r * rs2); }
                        ow[2 * n + jp] = cvtpk(ov.x, ov.y);
                    }
                u32x4 w; w.x = ow[0]; w.y = ow[1]; w.z = ow[2]; w.w = ow[3];
                *(u32x4*)(ACT + (size_t)row * DFF + col0) = w;
            }
    }
};

template <bool WRITE_XB> struct EpiResid {
    static constexpr bool PERM = true, AFTER_DRAIN = false;
    bf16_t* XB; u64* ss;
    __device__ __forceinline__ void operator()(const f32x4 (&acc)[2][2][4][2], const Unit& u, int wr, int wc, int fr, int fq) const {
        const int col0 = u.pn * 256 + wc * 32 + 8 * fq;
        const size_t rbase = (size_t)(u.pm * 256 + wr * 64 + fr) * DM + col0;
#pragma unroll
        for (int ai = 0; ai < 2; ++ai) {
            u32x4 hv[4][2];
#pragma unroll
            for (int m = 0; m < 4; ++m)
#pragma unroll
                for (int bj = 0; bj < 2; ++bj) hv[m][bj] = *(const u32x4*)(XB + rbase + (size_t)(ai * 128 + m * 16) * DM + bj * 128);
            float s[4];
#pragma unroll
            for (int m = 0; m < 4; ++m) {
                float sq = 0.f;
#pragma unroll
                for (int bj = 0; bj < 2; ++bj) {
                    const size_t off = rbase + (size_t)(ai * 128 + m * 16) * DM + bj * 128;
                    const u32x4 hb = hv[m][bj];
                    f32x4 h0 = {__uint_as_float(hb.x << 16), __uint_as_float(hb.x & 0xffff0000u), __uint_as_float(hb.y << 16), __uint_as_float(hb.y & 0xffff0000u)};
                    f32x4 h1 = {__uint_as_float(hb.z << 16), __uint_as_float(hb.z & 0xffff0000u), __uint_as_float(hb.w << 16), __uint_as_float(hb.w & 0xffff0000u)};
                    h0 += acc[ai][bj][m][0]; h1 += acc[ai][bj][m][1];
                    u32x4 w; w.x = cvtpk(h0[0], h0[1]); w.y = cvtpk(h0[2], h0[3]); w.z = cvtpk(h1[0], h1[1]); w.w = cvtpk(h1[2], h1[3]);
                    *(u32x4*)(XB + off) = w;
                    sq += (h0[0] * h0[0] + h0[1] * h0[1]) + (h0[2] * h0[2] + h0[3] * h0[3]) + (h1[0] * h1[0] + h1[1] * h1[1]) + (h1[2] * h1[2] + h1[3] * h1[3]);
                }
                s[m] = sq;
            }
#pragma unroll
            for (int m = 0; m < 4; ++m) { s[m] += __shfl_xor(s[m], 16); s[m] += __shfl_xor(s[m], 32); }
            const float mine = fq == 0 ? s[0] : (fq == 1 ? s[1] : (fq == 2 ? s[2] : s[3]));
            ss_add(ss + (u.pm * 256 + ai * 128 + wr * 64 + fq * 16 + fr), mine);
        }
    }
};

struct EpiKQ {
    static constexpr bool PERM = true, AFTER_DRAIN = false;
    const u64* ss; bf16_t* QB;
    __device__ __forceinline__ void operator()(const f32x4 (&acc)[2][2][4][2], const Unit& u, int wr, int wc, int fr, int fq) const {
        const int t3 = u.pn >> 2; const bool isq = t3 == 1;
        const int sel = t3 == 2 ? 2 : 1 - t3;
        bf16_t* base = QB + (size_t)sel * ((size_t)MP * DM); const float sc = isq ? QSCALE : 1.0f;
        const int col0 = (u.pn & 3) * 256 + wc * 32 + 8 * fq;
        const int row0 = u.pm * 256 + wr * 64 + fr;
        u64 sv[2][4];
#pragma unroll
        for (int ai = 0; ai < 2; ++ai)
#pragma unroll
            for (int m = 0; m < 4; ++m) sv[ai][m] = ss[row0 + ai * 128 + m * 16];
#pragma unroll
        for (int ai = 0; ai < 2; ++ai)
#pragma unroll
            for (int m = 0; m < 4; ++m) {
                const int row = row0 + ai * 128 + m * 16;
                const float rs = rstd_of(sv[ai][m]) * sc;
#pragma unroll
                for (int bj = 0; bj < 2; ++bj) { const f32x4 v0 = acc[ai][bj][m][0] * rs, v1 = acc[ai][bj][m][1] * rs;
                    u32x4 w; w.x = cvtpk(v0[0], v0[1]); w.y = cvtpk(v0[2], v0[3]); w.z = cvtpk(v1[0], v1[1]); w.w = cvtpk(v1[2], v1[3]);
                    *(u32x4*)(base + (size_t)row * DM + col0 + bj * 128) = w; }
            }
    }
};

struct EpiVt {
    static constexpr bool PERM = true, AFTER_DRAIN = false;
    const u64* ss; bf16_t* VT;
    __device__ __forceinline__ void operator()(const f32x4 (&acc)[2][2][4][2], const Unit& u, int wr, int wc, int fr, int fq) const {
        const int col0 = u.pn * 256 + wc * 32 + 8 * fq;
#pragma unroll
        for (int bj = 0; bj < 2; ++bj) {
            float rs[8];
#pragma unroll
            for (int j = 0; j < 8; ++j) rs[j] = rstd_of(ss[col0 + bj * 128 + j]);
#pragma unroll
            for (int ai = 0; ai < 2; ++ai)
#pragma unroll
                for (int m = 0; m < 4; ++m) {
                    const int ch = u.pm * 256 + ai * 128 + wr * 64 + m * 16 + fr;
                    const f32x4 v0 = acc[ai][bj][m][0], v1 = acc[ai][bj][m][1];
                    u32x4 w; w.x = cvtpk(v0[0] * rs[0], v0[1] * rs[1]); w.y = cvtpk(v0[2] * rs[2], v0[3] * rs[3]); w.z = cvtpk(v1[0] * rs[4], v1[1] * rs[5]); w.w = cvtpk(v1[2] * rs[6], v1[3] * rs[7]);
                    *(u32x4*)(VT + (size_t)ch * MP + col0 + bj * 128) = w;
                }
        }
    }
};

template <int MODE, bool WXB, int K>
__device__ __forceinline__ void meta_gemm(LAS unsigned char* lds, const bf16_t* A, const bf16_t* Bt, int nitems, const float* meta, float* H, bf16_t* XB, bf16_t* O1, bf16_t* O2, bf16_t* O3, u64* ss_out, const u64* ss_in) {
    constexpr bool GATED = (MODE == 0 || MODE == 1);
    int tid = threadIdx.x; asm volatile("" : "+v"(tid));
    const int lane = tid & 63, wid = __builtin_amdgcn_readfirstlane(tid >> 6);
    LAS f32x4* red = (LAS f32x4*)lds;
    for (int it = blockIdx.x; it < nitems; it += gridDim.x) {
        const int c0 = it * 16;
        const int brow0 = GATED ? 256 * (c0 >> 7) + (c0 & 127) : c0;
        const int kw = K >> 3, k0 = wid * kw;
        f32x4 acc0 = {0.f, 0.f, 0.f, 0.f}, acc1 = {0.f, 0.f, 0.f, 0.f};
        const bf16_t* ap = A + (size_t)(lane & 15) * K + k0 + 8 * (lane >> 4);
        const bf16_t* bp = Bt + (size_t)(brow0 + (lane & 15)) * K + k0 + 8 * (lane >> 4);
        constexpr int NKS = K / 8 / 32;
        bf16x8 av[NKS], bv0[NKS], bv1[GATED ? NKS : 1];
#pragma unroll
        for (int i = 0; i < NKS; ++i) { av[i] = *(const bf16x8*)(ap + 32 * i); bv0[i] = *(const bf16x8*)(bp + 32 * i); if (GATED) bv1[i] = *(const bf16x8*)(bp + (size_t)128 * K + 32 * i); }
#pragma unroll
        for (int i = 0; i < NKS; ++i) {
            acc0 = __builtin_amdgcn_mfma_f32_16x16x32_bf16(av[i], bv0[i], acc0, 0, 0, 0);
            if (GATED) acc1 = __builtin_amdgcn_mfma_f32_16x16x32_bf16(av[i], bv1[i], acc1, 0, 0, 0);
        }
        red[wid * 64 + lane] = acc0; if (GATED) red[512 + wid * 64 + lane] = acc1;
        __syncthreads();
        if (wid == 0) {
            f32x4 s0 = red[lane], s1 = {0.f, 0.f, 0.f, 0.f};
#pragma unroll
            for (int w = 1; w < 8; ++w) s0 += red[w * 64 + lane];
            if (GATED) { s1 = red[512 + lane];
#pragma unroll
                for (int w = 1; w < 8; ++w) s1 += red[512 + w * 64 + lane]; }
            const int c = c0 + (lane & 15);
#pragma unroll
            for (int j = 0; j < 4; ++j) {
                const int r = 4 * (lane >> 4) + j;
                if (MODE == 0 || MODE == 2) {
                    float hn;
                    if (MODE == 0) hn = meta[r * DM + c] + s0[j] * frcp(1.f + __expf(-s1[j]));
                    else hn = bf2f(XB[(size_t)(MR + r) * DM + c]) + s0[j];
                    XB[(size_t)(MR + r) * DM + c] = (bf16_t)(cvtpk(hn, 0.f) & 0xffffu);
                    float sq = hn * hn;
                    sq += __shfl_xor(sq, 1); sq += __shfl_xor(sq, 2); sq += __shfl_xor(sq, 4); sq += __shfl_xor(sq, 8);
                    if ((lane & 15) == 0) ss_add(ss_out + MR + r, sq);
                } else {
                    const float rs = rstd_of(ss_in[MR + r]);
                    if (MODE == 1) { const float g = s0[j] * rs, uu = s1[j] * rs; O1[(size_t)(MR + r) * DFF + c] = (bf16_t)(cvtpk(g * uu * frcp(1.f + __expf(-g)), 0.f) & 0xffffu); }
                    if (MODE == 3) { if (c < 1024) O1[(size_t)(MR + r) * DM + c] = (bf16_t)(cvtpk(s0[j] * rs, 0.f) & 0xffffu);
                        else if (c < 2048) O2[(size_t)(MR + r) * DM + c - 1024] = (bf16_t)(cvtpk(s0[j] * rs * QSCALE, 0.f) & 0xffffu);
                        else { O3[(size_t)(MR + r) * DM + c - 2048] = (bf16_t)(cvtpk(s0[j] * rs, 0.f) & 0xffffu); O3[(size_t)(MR + 16 + r) * DM + c - 2048] = 0; } }
                    if (MODE == 4) { O1[(size_t)c * MP + MR + r] = (bf16_t)(cvtpk(s0[j] * rs, 0.f) & 0xffffu); O1[(size_t)c * MP + MR + 16 + r] = 0; }
                }
            }
        }
        __syncthreads();
    }
}

__device__ __forceinline__ void transpose_item(const float* src, int ldn, const float* gain, bf16_t* dst, int K, int n0d, int c0s, int k0, int lane) {
    const float* sp = src + (size_t)k0 * ldn + c0s + lane;
    float v[32];
#pragma unroll
    for (int k = 0; k < 32; ++k) v[k] = sp[(size_t)k * ldn];
    if (gain) {
#pragma unroll
        for (int k = 0; k < 32; ++k) v[k] *= gain[k0 + k];
    }
    bf16_t* dp = dst + (size_t)(n0d + lane) * K + k0;
#pragma unroll
    for (int q = 0; q < 4; ++q) { u32x4 w; w.x = cvtpk(v[8 * q], v[8 * q + 1]); w.y = cvtpk(v[8 * q + 2], v[8 * q + 3]); w.z = cvtpk(v[8 * q + 4], v[8 * q + 5]); w.w = cvtpk(v[8 * q + 6], v[8 * q + 7]);
        *(u32x4*)(dp + 8 * q) = w; }
}

struct Ptrs {
    const float* in[20]; float* out; unsigned char* ws;
};

__device__ __forceinline__ void p0_prologue(const Ptrs& P, LAS unsigned char* lds) {
    int tid = threadIdx.x; asm volatile("" : "+v"(tid));
    const int lane = tid & 63, wid = tid >> 6;
    unsigned char* ws = P.ws;
    const int gw = blockIdx.x * 8 + wid, NGW = gridDim.x * 8;
    constexpr int I_GLU = 32 * 32, I_FI = 32 * 88, I_FO = 88 * 16, I_KQ = 32 * 32, I_V = 32 * 16, I_O = 32 * 16;
    constexpr int NITEMS = I_GLU + 2 * I_FI + 2 * I_FO + I_KQ + I_V + I_O;
    struct TItem { const float* sp; const float* gp; bf16_t* dp; int ldn; };
    auto decode = [&](const int it) __attribute__((always_inline)) -> TItem {
        int r = it; const float* src; const float* gain; bf16_t* dst; int ldn, K, n0d, c0s, k0;
        if (r < I_GLU) { const int kb = r & 31, nb = r >> 5, n0 = nb * 64; src = P.in[12]; ldn = 2048; gain = nullptr; dst = (bf16_t*)(ws + W_GLU); K = 1024; n0d = n0; c0s = ((n0 >> 7) & 1) * 1024 + (n0 >> 8) * 128 + (n0 & 127); k0 = kb * 32; }
        else if ((r -= I_GLU) < 2 * I_FI) { const int l = r / I_FI; r -= l * I_FI; const int kb = r & 31, nb = r >> 5, n0 = nb * 64; src = P.in[17] + (size_t)l * 1024 * 5632; ldn = 5632; gain = P.in[3] + l * 1024;
            dst = (bf16_t*)(ws + W_FI0) + (size_t)l * 5632 * 1024; K = 1024; n0d = n0; c0s = ((n0 >> 7) & 1) * DFF + (n0 >> 8) * 128 + (n0 & 127); k0 = kb * 32; }
        else if ((r -= 2 * I_FI) < 2 * I_FO) { const int l = r / I_FO; r -= l * I_FO; const int kb = r % 88, nb = r / 88; src = P.in[18] + (size_t)l * 2816 * 1024; ldn = 1024; gain = nullptr;
            dst = (bf16_t*)(ws + W_FO0) + (size_t)l * 1024 * 2816; K = 2816; n0d = nb * 64; c0s = nb * 64; k0 = kb * 32; }
        else if ((r -= 2 * I_FO) < I_KQ) { const int kb = r & 31, nb = r >> 5, n0 = nb * 64; dst = (bf16_t*)(ws + W_KQ); K = 1024; n0d = n0; k0 = kb * 32;
            if (n0 < 1024) { src = P.in[14]; ldn = 2048; gain = P.in[13]; c0s = n0; } else { src = P.in[15]; ldn = 1024; gain = P.in[2] + 1024; c0s = n0 - 1024; } }
        else if ((r -= I_KQ) < I_V) { const int kb = r & 31, nb = r >> 5; src = P.in[14]; ldn = 2048; gain = P.in[13]; dst = (bf16_t*)(ws + W_V); K = 1024; n0d = nb * 64; c0s = 1024 + nb * 64; k0 = kb * 32; }
        else { r -= I_V; const int kb = r & 31, nb = r >> 5; src = P.in[16]; ldn = 1024; gain = nullptr; dst = (bf16_t*)(ws + W_O); K = 1024; n0d = nb * 64; c0s = nb * 64; k0 = kb * 32; }
        TItem t; t.sp = src + (size_t)k0 * ldn + c0s + lane; t.gp = gain ? gain + k0 : nullptr; t.dp = dst + (size_t)(n0d + lane) * K + k0; t.ldn = ldn; return t;
    };
    auto finish = [&](const TItem& t, float (&v)[32]) __attribute__((always_inline)) {
        if (t.gp) {
#pragma unroll
            for (int k = 0; k < 32; ++k) v[k] *= t.gp[k];
        }
#pragma unroll
        for (int q = 0; q < 4; ++q) { u32x4 w; w.x = cvtpk(v[8 * q], v[8 * q + 1]); w.y = cvtpk(v[8 * q + 2], v[8 * q + 3]); w.z = cvtpk(v[8 * q + 4], v[8 * q + 5]); w.w = cvtpk(v[8 * q + 6], v[8 * q + 7]);
            *(u32x4*)(t.dp + 8 * q) = w; }
    };
    for (int it = gw; it < NITEMS; it += 2 * NGW) {
        const bool hb = it + NGW < NITEMS;
        const TItem a = decode(it), b = decode(hb ? it + NGW : it);
        float va[32], vb[32];
#pragma unroll
        for (int k = 0; k < 32; ++k) { va[k] = __builtin_nontemporal_load(a.sp + (size_t)k * a.ldn); vb[k] = __builtin_nontemporal_load(b.sp + (size_t)k * b.ldn); }
        finish(a, va);
        if (hb) finish(b, vb);
    }
    bf16_t* XB = (bf16_t*)(ws + OFF_XB);
    for (int row = gw; row < MROWS; row += 2 * NGW) {
        const int row2 = row + NGW; const bool has2 = row2 < MROWS;
        const float* src = row < MR ? P.in[0] + (size_t)row * DM : P.in[1] + (size_t)(row - MR) * DM;
        const float* src2 = has2 ? (row2 < MR ? P.in[0] + (size_t)row2 * DM : P.in[1] + (size_t)(row2 - MR) * DM) : src;
        f32x4 v[4], v2[4]; float s = 0.f, s2 = 0.f;
#pragma unroll
        for (int j = 0; j < 4; ++j) { v[j] = __builtin_nontemporal_load((const f32x4*)(src + 4 * lane + 256 * j)); v2[j] = __builtin_nontemporal_load((const f32x4*)(src2 + 4 * lane + 256 * j)); }
#pragma unroll
        for (int j = 0; j < 4; ++j) { s += (v[j][0] * v[j][0] + v[j][1] * v[j][1]) + (v[j][2] * v[j][2] + v[j][3] * v[j][3]); s2 += (v2[j][0] * v2[j][0] + v2[j][1] * v2[j][1]) + (v2[j][2] * v2[j][2] + v2[j][3] * v2[j][3]); }
#pragma unroll
        for (int o = 1; o < 64; o <<= 1) { s += __shfl_xor(s, o); s2 += __shfl_xor(s2, o); }
        const float ms = s * (1.0f / 1024.0f) + 1e-6f, ms2 = s2 * (1.0f / 1024.0f) + 1e-6f;
        const float rs = rsqrtf(ms), rs2 = rsqrtf(ms2);
        if (lane == 0) { ((float*)(ws + OFF_INV0))[row] = sqrtf(ms); if (has2) ((float*)(ws + OFF_INV0))[row2] = sqrtf(ms2); }
#pragma unroll
        for (int j = 0; j < 4; ++j) { u32x2 w; w.x = cvtpk(v[j][0] * rs, v[j][1] * rs); w.y = cvtpk(v[j][2] * rs, v[j][3] * rs); *(u32x2*)(XB + (size_t)row * DM + 4 * lane + 256 * j) = w; }
        if (has2) {
#pragma unroll
            for (int j = 0; j < 4; ++j) { u32x2 w; w.x = cvtpk(v2[j][0] * rs2, v2[j][1] * rs2); w.y = cvtpk(v2[j][2] * rs2, v2[j][3] * rs2); *(u32x2*)(XB + (size_t)row2 * DM + 4 * lane + 256 * j) = w; }
        }
    }
    const int gt = blockIdx.x * 512 + tid, NGT = gridDim.x * 512;
    u64* ss = (u64*)(ws + OFF_SS);
    for (int i = gt; i < 4 * MP; i += NGT) ss[i] = 0ull;
    const float* gain0 = P.in[2];
    for (int ii = gt; ii < 64 * 64 * 8; ii += NGT) {
        const int i = ii >> 3, c = 2 * (ii & 7);
        const int g = i >> 6;
        const double dt = exp((double)P.in[6][g]);
        const double are = (double)P.in[4][i], aim = (double)P.in[5][i];
        const double mag = exp(dt * are), ang = dt * aim;
        const double kq = rint(ang * 0.15915494309189535), rr = ang - kq * 6.283185307179586;
        const double q = rr * 0.25, q2 = q * q;
        const double sn = q * (1.0 - q2 / 6.0 * (1.0 - q2 / 20.0 * (1.0 - q2 / 42.0 * (1.0 - q2 / 72.0 * (1.0 - q2 / 110.0 * (1.0 - q2 / 156.0 * (1.0 - q2 / 210.0)))))));
        const double cs = 1.0 - q2 / 2.0 * (1.0 - q2 / 12.0 * (1.0 - q2 / 30.0 * (1.0 - q2 / 56.0 * (1.0 - q2 / 90.0 * (1.0 - q2 / 132.0 * (1.0 - q2 / 182.0 * (1.0 - q2 / 240.0)))))));
        const double s2 = 2.0 * sn * cs, c2 = 1.0 - 2.0 * sn * sn;
        const double s4 = 2.0 * s2 * c2, c4 = 1.0 - 2.0 * s2 * s2;
        const double abr = mag * c4, abi = mag * s4;
        if (c == 0) { float* ab = (float*)(ws + S5_ABAR); ab[2 * i] = (float)abr; ab[2 * i + 1] = (float)abi; }
        const double den = are * are + aim * aim;
        const double cr = ((abr - 1.0) * are + abi * aim) / den, ci = (abi * are - (abr - 1.0) * aim) / den;
        bf16_t* bb = (bf16_t*)(ws + S5_BB);
        const int p = i & 63;
        const double g0 = gain0[g * 16 + c], g1 = gain0[g * 16 + c + 1];
        const double br0 = P.in[7][(size_t)i * 16 + c], bi0 = P.in[8][(size_t)i * 16 + c], br1 = P.in[7][(size_t)i * 16 + c + 1], bi1 = P.in[8][(size_t)i * 16 + c + 1];
        *(unsigned*)(bb + ((size_t)(g * 2 + 0) * 64 + p) * 16 + c) = cvtpk((float)((cr * br0 - ci * bi0) * g0), (float)((cr * br1 - ci * bi1) * g1));
        *(unsigned*)(bb + ((size_t)(g * 2 + 1) * 64 + p) * 16 + c) = cvtpk((float)((cr * bi0 + ci * br0) * g0), (float)((cr * bi1 + ci * br1) * g1));
    }
    for (int i = gt; i < 64 * 64 * 16; i += NGT) {
        const int gp = i >> 4, t = i & 15, g = gp >> 6, p = gp & 63, sh = p >> 5, nn = p & 31;
        const double dt = exp((double)P.in[6][g]);
        const double are = (double)P.in[4][gp], aim = (double)P.in[5][gp];
        const double mag = exp(dt * are), ang = dt * aim;
        const double kq = rint(ang * 0.15915494309189535), rr = ang - kq * 6.283185307179586;
        const double q = rr * 0.25, q2 = q * q;
        const double sn = q * (1.0 - q2 / 6.0 * (1.0 - q2 / 20.0 * (1.0 - q2 / 42.0 * (1.0 - q2 / 72.0 * (1.0 - q2 / 110.0 * (1.0 - q2 / 156.0 * (1.0 - q2 / 210.0)))))));
        const double cs = 1.0 - q2 / 2.0 * (1.0 - q2 / 12.0 * (1.0 - q2 / 30.0 * (1.0 - q2 / 56.0 * (1.0 - q2 / 90.0 * (1.0 - q2 / 132.0 * (1.0 - q2 / 182.0 * (1.0 - q2 / 240.0)))))));
        const double s2 = 2.0 * sn * cs, c2 = 1.0 - 2.0 * sn * sn;
        const double s4 = 2.0 * s2 * c2, c4 = 1.0 - 2.0 * s2 * s2;
        const double abr = mag * c4, abi = mag * s4;
        const double den = are * are + aim * aim;
        const double cr = ((abr - 1.0) * are + abi * aim) / den, ci = (abi * are - (abr - 1.0) * aim) / den;
        double pwr = 1.0, pwi = 0.0, br_ = abr, bi_ = abi; const int e = 15 - t;
#pragma unroll
        for (int bit = 0; bit < 4; ++bit) {
            if ((e >> bit) & 1) { const double nr = pwr * br_ - pwi * bi_, ni = pwr * bi_ + pwi * br_; pwr = nr; pwi = ni; }
            const double sr = br_ * br_ - bi_ * bi_, si = 2.0 * br_ * bi_; br_ = sr; bi_ = si;
        }
        const double fr = pwr * cr - pwi * ci, fi = pwr * ci + pwi * cr;
        bf16_t* w1 = (bf16_t*)(ws + OFF_W1);
#pragma unroll
        for (int h8 = 0; h8 < 2; ++h8) {
            unsigned wre[4], wim[4];
#pragma unroll
            for (int jp = 0; jp < 4; ++jp) {
                const int c = 8 * h8 + 2 * jp;
                const double g0 = gain0[g * 16 + c], g1 = gain0[g * 16 + c + 1];
                const double br0 = P.in[7][(size_t)gp * 16 + c], bi0 = P.in[8][(size_t)gp * 16 + c], br1 = P.in[7][(size_t)gp * 16 + c + 1], bi1 = P.in[8][(size_t)gp * 16 + c + 1];
                wre[jp] = cvtpk((float)((fr * br0 - fi * bi0) * g0), (float)((fr * br1 - fi * bi1) * g1));
                wim[jp] = cvtpk((float)((fr * bi0 + fi * br0) * g0), (float)((fr * bi1 + fi * br1) * g1));
            }
            u32x4 vre; vre.x = wre[0]; vre.y = wre[1]; vre.z = wre[2]; vre.w = wre[3];
            u32x4 vim; vim.x = wim[0]; vim.y = wim[1]; vim.z = wim[2]; vim.w = wim[3];
            *(u32x4*)(w1 + ((((size_t)(g * 16 + t) * 2 + 0) * 2 + sh) * 64 + nn + 32 * h8) * 8) = vre;
            *(u32x4*)(w1 + ((((size_t)(g * 16 + t) * 2 + 1) * 2 + sh) * 64 + nn + 32 * h8) * 8) = vim;
        }
    }
    for (int i = gt; i < 64 * 16 * 64 / 2; i += NGT) {
        const int e = 2 * i, g = e >> 10, cp = e & 1023;
        bf16_t* cb = (bf16_t*)(ws + S5_CB);
        *(unsigned*)(cb + (size_t)(g * 2 + 0) * 1024 + cp) = cvtpk(P.in[9][e], P.in[9][e + 1]);
        *(unsigned*)(cb + (size_t)(g * 2 + 1) * 1024 + cp) = cvtpk(-P.in[10][e], -P.in[10][e + 1]);
    }
    for (int i = gt; i < 1024; i += NGT) ((float*)(ws + S5_DG))[i] = P.in[11][i] * gain0[i];
}

#define MFMA32(a, b, c) __builtin_amdgcn_mfma_f32_32x32x16_bf16((a), (b), (c), 0, 0, 0)
__device__ __forceinline__ float gelu_tanh(float y) {
    const float t = 1.5957691216057308f * (y + 0.044715f * y * y * y);
    return y * frcp(1.f + __expf(-t));
}
__device__ __forceinline__ void s5_phase(const Ptrs& P, LAS unsigned char* lds) {
    int tid = threadIdx.x; asm volatile("" : "+v"(tid));
    const int lane = tid & 63, wid = __builtin_amdgcn_readfirstlane(tid >> 6), n = lane & 31, hh = lane >> 5;
    unsigned char* ws = P.ws;
    const bf16_t* XB = (const bf16_t*)(ws + OFF_XB);
    bf16_t* Z = (bf16_t*)(ws + OFF_ZQ);
    LAS unsigned char* wl = lds + wid * 9216;
    LAS unsigned char* uimg = wl + 8192;
    LAS f32x4* Ex = (LAS f32x4*)(lds + 8 * 9216);
    const int bs = (n >> 2) & 1, tk = (n & 3) + 4 * (n >> 3);
    for (int unit = blockIdx.x; unit < 256; unit += gridDim.x) {
        const int bp = unit >> 6, g = ((unit & 7) << 3) | ((unit >> 3) & 7);
        float ar[2], ai[2];
#pragma unroll
        for (int sh = 0; sh < 2; ++sh) { const float* ab = (const float*)(ws + S5_ABAR) + 2 * (g * 64 + 32 * sh + n); ar[sh] = ab[0]; ai[sh] = ab[1]; }
        bf16x8 Bop[2][2];
#pragma unroll
        for (int ri = 0; ri < 2; ++ri)
#pragma unroll
            for (int sh = 0; sh < 2; ++sh) {
                Bop[ri][sh] = *(const bf16x8*)((const bf16_t*)(ws + S5_BB) + ((size_t)(g * 2 + ri) * 64 + 32 * sh + n) * 16 + 8 * hh);
            }
#pragma unroll
        for (int ri = 0; ri < 2; ++ri)
#pragma unroll
            for (int sh = 0; sh < 2; ++sh) asm volatile("" :: "v"(Bop[ri][sh]));
        asm volatile("" :: "v"(ar[0]), "v"(ar[1]), "v"(ai[0]), "v"(ai[1]));
        const int c_beg = 32 * wid + (wid > 0 ? 1 : 0), c_end = c_beg + 32 + (wid == 0 ? 1 : 0);
        const size_t arow_real = (size_t)((2 * bp + bs) * SEQ + tk), arow_meta = (size_t)(MR + tk);
        const int acol = g * 16 + 8 * hh;
        f32x16 zero16;
#pragma unroll
        for (int i = 0; i < 16; ++i) zero16[i] = 0.f;
        float xr[2] = {0.f, 0.f}, xi[2] = {0.f, 0.f};
#define S5_LOADA(c) (*(const bf16x8*)(XB + ((c) == 0 ? arow_meta : arow_real + (size_t)16 * ((c) - 1)) * DM + acol))
        float p16r[2], p16i[2];
#pragma unroll
        for (int sh = 0; sh < 2; ++sh) {
            float cr = ar[sh], ci = ai[sh];
#pragma unroll
            for (int k = 0; k < 4; ++k) { const float t = cr * cr - ci * ci; ci = 2.f * cr * ci; cr = t; }
            p16r[sh] = cr; p16i[sh] = ci;
        }
        {
            if (wid == 0) {
                const bf16x8 a_cur = S5_LOADA(0);
                f32x16 bu[2][2];
#pragma unroll
                for (int ri = 0; ri < 2; ++ri)
#pragma unroll
                    for (int sh = 0; sh < 2; ++sh) bu[ri][sh] = MFMA32(a_cur, Bop[ri][sh], zero16);
#pragma unroll
                for (int r = 0; r < 16; ++r)
#pragma unroll
                    for (int sh = 0; sh < 2; ++sh) {
                        const float nr = ar[sh] * xr[sh] - ai[sh] * xi[sh] + bu[0][sh][r];
                        const float ni = ar[sh] * xi[sh] + ai[sh] * xr[sh] + bu[1][sh][r];
                        xr[sh] = nr; xi[sh] = ni;
                    }
            }
            const int c1 = wid == 0 ? 1 : c_beg;
            const bf16_t* W1g = (const bf16_t*)(ws + OFF_W1) + (size_t)g * (16 * 4 * 64 * 8) + lane * 8;
            for (int blk = 0; blk < 2; ++blk) {
                const bf16_t* ab = XB + ((size_t)((2 * bp + bs) * SEQ) + (size_t)16 * (c1 - 1 + 16 * blk + tk)) * DM + acol;
                f32x16 E00 = zero16, E01 = zero16, E10 = zero16, E11 = zero16;
#pragma unroll 4
                for (int t = 0; t < 16; ++t) {
                    const bf16x8 a = *(const bf16x8*)(ab + (size_t)t * DM);
                    const bf16_t* wp = W1g + (size_t)t * (4 * 64 * 8);
                    const bf16x8 b00 = *(const bf16x8*)(wp), b01 = *(const bf16x8*)(wp + 512), b10 = *(const bf16x8*)(wp + 1024), b11 = *(const bf16x8*)(wp + 1536);
                    E00 = MFMA32(a, b00, E00); E01 = MFMA32(a, b01, E01); E10 = MFMA32(a, b10, E10); E11 = MFMA32(a, b11, E11);
                }
#pragma unroll
                for (int r = 0; r < 16; ++r) {
                    { const float nr = p16r[0] * xr[0] - p16i[0] * xi[0] + E00[r], ni = p16r[0] * xi[0] + p16i[0] * xr[0] + E10[r]; xr[0] = nr; xi[0] = ni; }
                    { const float nr = p16r[1] * xr[1] - p16i[1] * xi[1] + E01[r], ni = p16r[1] * xi[1] + p16i[1] * xr[1] + E11[r]; xr[1] = nr; xi[1] = ni; }
                }
            }
        }
        Ex[wid * 64 + lane] = (f32x4){xr[0], xi[0], xr[1], xi[1]};
        __syncthreads();
        {
            float pr[2], pi[2];
#pragma unroll
            for (int sh = 0; sh < 2; ++sh) {
                float cr = p16r[sh], ci = p16i[sh];
#pragma unroll
                for (int k = 0; k < 5; ++k) { const float t = cr * cr - ci * ci; ci = 2.f * cr * ci; cr = t; }
                pr[sh] = cr; pi[sh] = ci;
            }
            xr[0] = xr[1] = xi[0] = xi[1] = 0.f;
            for (int v = 0; v < wid; ++v) {
                const f32x4 e = Ex[v * 64 + lane];
#pragma unroll
                for (int sh = 0; sh < 2; ++sh) {
                    float qr = pr[sh], qi = pi[sh];
                    if (v == 0) { const float t = qr * p16r[sh] - qi * p16i[sh]; qi = qr * p16i[sh] + qi * p16r[sh]; qr = t; }
                    const float nr = qr * xr[sh] - qi * xi[sh] + (sh == 0 ? e[0] : e[2]);
                    const float ni = qr * xi[sh] + qi * xr[sh] + (sh == 0 ? e[1] : e[3]);
                    xr[sh] = nr; xi[sh] = ni;
                }
            }
        }
        {
            bf16x8 Cop[2][2][2];
#pragma unroll
            for (int ri = 0; ri < 2; ++ri)
#pragma unroll
                for (int sh = 0; sh < 2; ++sh) {
#pragma unroll
                    for (int s = 0; s < 2; ++s) { bf16x8 cv = {0, 0, 0, 0, 0, 0, 0, 0};
                        if (n < 16) cv = *(const bf16x8*)((const bf16_t*)(ws + S5_CB) + ((size_t)(g * 2 + ri) * 16 + n) * 64 + 32 * sh + 16 * s + 8 * hh);
                        Cop[ri][sh][s] = cv; }
                    asm volatile("" :: "v"(Cop[ri][sh][0]), "v"(Cop[ri][sh][1]));
                }
            const int xsw = (n >> 1) & 7;
            const int trq = (lane & 15) >> 2, trc = 4 * ((lane >> 4) & 1) + (lane & 3);
            const unsigned tr_lo = (unsigned)(size_t)wl + (unsigned)((8 * hh + trq) * 64 + 8 * (trc ^ ((4 * hh + (trq >> 1)) & 7)));
            const unsigned tr_hi = (unsigned)(size_t)wl + (unsigned)((8 * hh + trq + 4) * 64 + 8 * (trc ^ ((4 * hh + (trq >> 1) + 2) & 7)));
            const float* Dg = (const float*)(ws + S5_DG) + g * 16 + 4 * hh;
            const f32x4 d_lo = *(const f32x4*)Dg, d_hi = *(const f32x4*)(Dg + 8);
            asm volatile("" :: "v"(d_lo), "v"(d_hi));
            const int cl = c_end - 1;
            auto body2 = [&](const bf16x8 a_cur, const int c) __attribute__((always_inline)) {
                *(LAS bf16x8*)(uimg + n * 32 + hh * 16) = a_cur;
                f32x16 bu[2][2];
#pragma unroll
                for (int ri = 0; ri < 2; ++ri)
#pragma unroll
                    for (int sh = 0; sh < 2; ++sh) bu[ri][sh] = MFMA32(a_cur, Bop[ri][sh], zero16);
#pragma unroll
                for (int r = 0; r < 16; ++r)
#pragma unroll
                    for (int sh = 0; sh < 2; ++sh) {
                        const float nr = ar[sh] * xr[sh] - ai[sh] * xi[sh] + bu[0][sh][r];
                        const float ni = ar[sh] * xi[sh] + ai[sh] * xr[sh] + bu[1][sh][r];
                        xr[sh] = nr; xi[sh] = ni; bu[0][sh][r] = nr; bu[1][sh][r] = ni;
                    }
#pragma unroll
                for (int ri = 0; ri < 2; ++ri)
#pragma unroll
                    for (int sh = 0; sh < 2; ++sh)
#pragma unroll
                        for (int q4 = 0; q4 < 4; ++q4) { u32x2 w; w.x = cvtpk(bu[ri][sh][4 * q4], bu[ri][sh][4 * q4 + 1]); w.y = cvtpk(bu[ri][sh][4 * q4 + 2], bu[ri][sh][4 * q4 + 3]);
                            *(LAS u32x2*)(wl + (ri * 2 + sh) * 2048 + n * 64 + 8 * ((2 * q4 + hh) ^ xsw)) = w; }
                s16x4 t0, t1, t2, t3, t4, t5, t6, t7, t8, t9, t10, t11, t12, t13, t14, t15;
#define S5_TRL(o, off) "ds_read_b64_tr_b16 %" #o ", %16 offset:" #off "\n\t"
#define S5_TRH(o, off) "ds_read_b64_tr_b16 %" #o ", %17 offset:" #off "\n\t"
                asm volatile("s_waitcnt lgkmcnt(0)\n\t"
                             S5_TRL(0, 0) S5_TRH(1, 0) S5_TRL(2, 1024) S5_TRH(3, 1024) S5_TRL(4, 2048) S5_TRH(5, 2048) S5_TRL(6, 3072) S5_TRH(7, 3072)
                             S5_TRL(8, 4096) S5_TRH(9, 4096) S5_TRL(10, 5120) S5_TRH(11, 5120) S5_TRL(12, 6144) S5_TRH(13, 6144) S5_TRL(14, 7168) S5_TRH(15, 7168)
                             "s_waitcnt lgkmcnt(0)"
                             : "=&v"(t0), "=&v"(t1), "=&v"(t2), "=&v"(t3), "=&v"(t4), "=&v"(t5), "=&v"(t6), "=&v"(t7), "=&v"(t8), "=&v"(t9), "=&v"(t10), "=&v"(t11), "=&v"(t12), "=&v"(t13), "=&v"(t14), "=&v"(t15)
                             : "v"(tr_lo), "v"(tr_hi) : "memory");
#undef S5_TRL
#undef S5_TRH
#define S5_CAT(a, b) __builtin_shufflevector(a, b, 0, 1, 2, 3, 4, 5, 6, 7)
                f32x16 y0 = MFMA32(Cop[0][0][0], S5_CAT(t0, t1), zero16);   y0 = MFMA32(Cop[0][0][1], S5_CAT(t2, t3), y0);
                f32x16 y1 = MFMA32(Cop[0][1][0], S5_CAT(t4, t5), zero16);   y1 = MFMA32(Cop[0][1][1], S5_CAT(t6, t7), y1);
                f32x16 y2 = MFMA32(Cop[1][0][0], S5_CAT(t8, t9), zero16);   y2 = MFMA32(Cop[1][0][1], S5_CAT(t10, t11), y2);
                f32x16 y3 = MFMA32(Cop[1][1][0], S5_CAT(t12, t13), zero16); y3 = MFMA32(Cop[1][1][1], S5_CAT(t14, t15), y3);
#undef S5_CAT
                const u32x2 u_lo = *(const LAS u32x2*)(uimg + n * 32 + 8 * hh), u_hi = *(const LAS u32x2*)(uimg + n * 32 + 16 + 8 * hh);
                float zz[8];
#pragma unroll
                for (int i = 0; i < 8; ++i) {
                    const unsigned uw = (i < 4) ? (i < 2 ? u_lo.x : u_lo.y) : (i < 6 ? u_hi.x : u_hi.y);
                    const float uf = (i & 1) ? __uint_as_float(uw & 0xffff0000u) : __uint_as_float(uw << 16);
                    const float dd = (i < 4) ? d_lo[i & 3] : d_hi[i & 3];
                    const float y = (y0[i] + y1[i]) + (y2[i] + y3[i]) + dd * uf;
                    zz[i] = gelu_tanh(y);
                }
                if (c > 0 || (bp == 0 && bs == 0)) {
                    const size_t orow = (c == 0) ? arow_meta : arow_real + (size_t)16 * (c - 1);
                    bf16_t* zp = Z + orow * DM + g * 16 + 4 * hh;
                    u32x2 w0, w1; w0.x = cvtpk(zz[0], zz[1]); w0.y = cvtpk(zz[2], zz[3]); w1.x = cvtpk(zz[4], zz[5]); w1.y = cvtpk(zz[6], zz[7]);
                    *(u32x2*)zp = w0; *(u32x2*)(zp + 8) = w1;
                }
            };
            bf16x8 r0 = S5_LOADA(c_beg), r1 = S5_LOADA(min(c_beg + 1, cl)), r2 = S5_LOADA(min(c_beg + 2, cl)), r3 = S5_LOADA(min(c_beg + 3, cl));
            for (int c = c_beg; c < c_end; c += 4) {
                body2(r0, c); r0 = S5_LOADA(min(c + 4, cl));
                if (c + 1 < c_end) { body2(r1, c + 1); r1 = S5_LOADA(min(c + 5, cl)); }
                if (c + 2 < c_end) { body2(r2, c + 2); r2 = S5_LOADA(min(c + 6, cl)); }
                if (c + 3 < c_end) { body2(r3, c + 3); r3 = S5_LOADA(min(c + 7, cl)); }
            }
        }
        __syncthreads();
    }
#undef S5_LOADA
}

#define XB_TMO      128
#define XB_XCNT(j)  (256  + 64 * (j))
#define XB_XSUB(j)  (1280 + 64 * (j))
#define XB_XGEN(j)  (2304 + 64 * (j))
#define XB_TOP      3328
#define XB_TOPGEN   3392
#define XCD_BAR_WORDS 3456
#define XB_SPIN_CAP (1u << 18)

__device__ __forceinline__ unsigned xb_ld(unsigned* p)              { return __hip_atomic_load(p, __ATOMIC_RELAXED, __HIP_MEMORY_SCOPE_AGENT); }
__device__ __forceinline__ unsigned xb_add(unsigned* p, unsigned v) { return __hip_atomic_fetch_add(p, v, __ATOMIC_RELAXED, __HIP_MEMORY_SCOPE_AGENT); }
__device__ __forceinline__ unsigned xb_xcc_id() { return (unsigned)__builtin_amdgcn_s_getreg((3 << 11) | 20) & 0xFu; }
#define XB_SPIN(cond, bar) do { unsigned _sp = 0; while (cond) { __builtin_amdgcn_s_sleep(1); \
    if ((++_sp & 255u) == 0u) { if (xb_ld(&(bar)[XB_TMO])) break; if (_sp > XB_SPIN_CAP) { atomicAdd(&(bar)[XB_TMO], 1u); break; } } } } while (0)

struct XcdBarrier {
    unsigned* bar; unsigned x;
    volatile LAS unsigned* st;
};

__device__ __forceinline__ XcdBarrier xcd_barrier_post(unsigned* bar, volatile LAS unsigned* st) {
    XcdBarrier b; b.bar = bar; b.x = xb_xcc_id(); b.st = st;
    if (threadIdx.x == 0) (void)xb_add(&bar[XB_XCNT(b.x)], 1u);
    return b;
}
__device__ __forceinline__ void xcd_barrier_complete(unsigned* bar, unsigned x, unsigned& nloc, unsigned& nx) {
    const unsigned G = gridDim.x * gridDim.y * gridDim.z;
    unsigned sum, cnt, mine, sp = 0u;
    for (;;) {
        sum = 0u; cnt = 0u; mine = 0u;
#pragma unroll
        for (unsigned j = 0; j < 16; ++j) { const unsigned c = xb_ld(&bar[XB_XCNT(j)]); sum += c; cnt += (c > 0u) ? 1u : 0u; mine = (j == x) ? c : mine; }
        if (sum == G) break;
        __builtin_amdgcn_s_sleep(1);
        if ((++sp & 255u) == 0u) { if (xb_ld(&bar[XB_TMO])) break; if (sp > XB_SPIN_CAP) { atomicAdd(&bar[XB_TMO], 1u); break; } }
    }
    nloc = mine > 0u ? mine : 1u; nx = cnt > 0u ? cnt : 1u;
}

__device__ __forceinline__ void xcd_barrier(const XcdBarrier& b) {
    asm volatile("s_waitcnt vmcnt(0)" ::: "memory");
    __syncthreads();
    if (threadIdx.x == 0) {
        unsigned* bar = b.bar;
        __builtin_amdgcn_s_waitcnt(0);
        unsigned nloc = b.st[0], nx = b.st[1];
        if (nloc == 0u) { xcd_barrier_complete(bar, b.x, nloc, nx); b.st[0] = nloc; b.st[1] = nx; }
        const unsigned old = xb_add(&bar[XB_XSUB(b.x)], 1u);
        const unsigned gen = old / nloc;
        if (old + 1u == (gen + 1u) * nloc) {
            __builtin_amdgcn_fence(__ATOMIC_RELEASE, "agent");
            asm volatile("s_waitcnt vmcnt(0)" ::: "memory");
            const unsigned og = xb_add(&bar[XB_TOP], 1u);
            const unsigned tg = og / nx;
            if (og + 1u == (tg + 1u) * nx) xb_add(&bar[XB_TOPGEN], 1u);
            else XB_SPIN(xb_ld(&bar[XB_TOPGEN]) == tg, bar);
            __builtin_amdgcn_fence(__ATOMIC_ACQUIRE, "agent");
            xb_add(&bar[XB_XGEN(b.x)], 1u);
            asm volatile("s_waitcnt vmcnt(0)" ::: "memory");
        } else {
            XB_SPIN(xb_ld(&bar[XB_XGEN(b.x)]) == gen, bar);
            __builtin_amdgcn_fence(__ATOMIC_ACQUIRE, "agent");
            asm volatile("s_waitcnt vmcnt(0)" ::: "memory");
        }
    }
    __syncthreads();
}

constexpr float AT_STOP = 5.421011e-20f;
__device__ __forceinline__ void attn_phase(const Ptrs& P, LAS unsigned char* lds, bf16_t* Oout) {
    int tid = threadIdx.x; asm volatile("" : "+v"(tid));
    const int lane = tid & 63, wid = __builtin_amdgcn_readfirstlane(tid >> 6), n = lane & 31, hh = lane >> 5;
    unsigned char* ws = P.ws;
    const bf16_t* KB = (const bf16_t*)(ws + OFF_KB);
    const bf16_t* VB = (const bf16_t*)(ws + OFF_VT);
    bf16_t* QO = (bf16_t*)(ws + OFF_ZQ);
    LAS unsigned char* Kl = lds + wid * 10752;
    LAS unsigned char* Vl = Kl + 4608;
    const int lrow = 4 * (lane >> 3), lchk = lane & 7;
    LAS unsigned char* kst = Kl + lrow * 144 + lchk * 16;
    LAS unsigned char* vst = Vl + lrow * 192 + lchk * 16;
    const LAS unsigned char* kfr = Kl + n * 144 + 16 * hh;
    const unsigned vtr = (unsigned)(size_t)Vl + (unsigned)((4 * hh + ((lane & 15) >> 2)) * 192 + 32 * ((lane >> 4) & 1) + 8 * (lane & 3));
    const int vcu = (gridDim.x % 8 == 0) ? (blockIdx.x % 8) * (gridDim.x / 8) + blockIdx.x / 8 : blockIdx.x;
    const int gw = vcu * 8 + wid, NGW = gridDim.x * 8;
    constexpr int NREAL = NB * NHEAD * 128;
    for (int u = gw; u < NREAL; u += NGW) {
        constexpr bool metaq = false;
        const int qt = metaq ? -1 : (u & 127), h = metaq ? (u - NREAL) : ((u >> 7) & 15), b = metaq ? 0 : (u >> 11);
        const int qrow0 = metaq ? MR : b * SEQ + 32 * qt;
        auto issue = [&](u32x4& k0, u32x4& k1, u32x4& k2, u32x4& k3, u32x4& v0, u32x4& v1, u32x4& v2, u32x4& v3, const int kt_) __attribute__((always_inline)) {
            const int krow0 = kt_ >= 0 ? b * SEQ + 32 * kt_ : MR;
            const size_t off = (size_t)(krow0 + lrow + 2) * DM + h * 64 + lchk * 8;
            const bf16_t* kp = KB + off; const bf16_t* vp = VB + off;
            asm volatile("global_load_dwordx4 %0, %8, off offset:-4096\n\t"
                         "global_load_dwordx4 %1, %8, off offset:-2048\n\t"
                         "global_load_dwordx4 %2, %8, off\n\t"
                         "global_load_dwordx4 %3, %8, off offset:2048\n\t"
                         "global_load_dwordx4 %4, %9, off offset:-4096\n\t"
                         "global_load_dwordx4 %5, %9, off offset:-2048\n\t"
                         "global_load_dwordx4 %6, %9, off\n\t"
                         "global_load_dwordx4 %7, %9, off offset:2048"
                         : "=&v"(k0), "=&v"(k1), "=&v"(k2), "=&v"(k3), "=&v"(v0), "=&v"(v1), "=&v"(v2), "=&v"(v3)
                         : "v"(kp), "v"(vp) : "memory");
        };
        u32x4 ak0, ak1, ak2, ak3, av0, av1, av2, av3;
#define AT_PREV(k) ((k) > 0 ? (k) - 1 : -1)
        int kt = qt;
        issue(ak0, ak1, ak2, ak3, av0, av1, av2, av3, kt);
        bf16x8 qf[4];
#pragma unroll
        for (int s = 0; s < 4; ++s) qf[s] = *(const bf16x8*)(QO + (size_t)(qrow0 + n) * DM + h * 64 + 16 * s + 8 * hh);
        asm volatile("" :: "v"(qf[0]), "v"(qf[1]), "v"(qf[2]), "v"(qf[3]));
        f32x16 o0, o1;
#pragma unroll
        for (int i = 0; i < 16; ++i) { o0[i] = 0.f; o1[i] = 0.f; }
        float Rl = 1.f;
        const int metalim = metaq ? (n < 16 ? n : 16) : 16;
        auto stage = [&](const u32x4& k0, const u32x4& k1, const u32x4& k2, const u32x4& k3, const u32x4& v0, const u32x4& v1, const u32x4& v2, const u32x4& v3) __attribute__((always_inline)) {
            *(LAS u32x4*)(kst) = k0; *(LAS u32x4*)(kst + 144) = k1; *(LAS u32x4*)(kst + 288) = k2; *(LAS u32x4*)(kst + 432) = k3;
            *(LAS u32x4*)(vst) = v0; *(LAS u32x4*)(vst + 192) = v1; *(LAS u32x4*)(vst + 384) = v2; *(LAS u32x4*)(vst + 576) = v3;
        };
        auto compute = [&](const int kt_, auto MT) __attribute__((always_inline)) -> bool {
            constexpr bool MASKED = decltype(MT)::value;
            f32x16 z;
#pragma unroll
            for (int i = 0; i < 16; ++i) z[i] = 0.f;
#pragma unroll
            for (int s = 0; s < 4; ++s) z = MFMA32(*(const LAS bf16x8*)(kfr + 32 * s), qf[s], z);
            const int lim = kt_ < 0 ? metalim : n;
            f32x2_t be[8], om[8];
#pragma unroll
            for (int p = 0; p < 8; ++p) {
                f32x2_t e; e.x = __builtin_amdgcn_exp2f(z[2 * p]); e.y = __builtin_amdgcn_exp2f(z[2 * p + 1]);
                const f32x2_t d = e + 1.0f;
                f32x2_t bt; bt.x = frcp(d.x); bt.y = frcp(d.y);
                f32x2_t o1m = 1.0f - bt;
                if (MASKED) {
                    const int j0 = ((2 * p) & 3) + 8 * ((2 * p) >> 2) + 4 * hh;
                    if (!(j0 < lim)) { bt.x = 0.f; o1m.x = 1.f; }
                    if (!(j0 + 1 < lim)) { bt.y = 0.f; o1m.y = 1.f; }
                }
                be[p] = bt; om[p] = o1m;
            }
            float qp[4], th[4];
#pragma unroll
            for (int a = 0; a < 4; ++a) { const f32x2_t t = om[2 * a] * om[2 * a + 1]; qp[a] = t.x * t.y; th[a] = __shfl_xor(qp[a], 32); }
            float G[8];
#pragma unroll
            for (int a = 0; a < 4; ++a) { G[2 * a] = hh ? th[a] : qp[a]; G[2 * a + 1] = hh ? qp[a] : th[a]; }
            const float sf7 = 1.f, sf6 = G[7], sf5 = sf6 * G[6], sf4 = sf5 * G[5], sf3 = sf4 * G[4], sf2 = sf3 * G[3], sf1 = sf2 * G[2], sf0 = sf1 * G[1];
            const float total = sf0 * G[0];
            const float sm0 = hh ? sf1 : sf0, sm1 = hh ? sf3 : sf2, sm2 = hh ? sf5 : sf4, sm3 = hh ? sf7 : sf6;
            f32x2_t w[8];
#define AT_W(a, SM) do { const float e3 = Rl * (SM), e2 = e3 * om[2 * (a) + 1].y, e1 = e2 * om[2 * (a) + 1].x, e0 = e1 * om[2 * (a)].y; \
                w[2 * (a)] = be[2 * (a)] * (f32x2_t){e0, e1}; w[2 * (a) + 1] = be[2 * (a) + 1] * (f32x2_t){e2, e3}; } while (0)
            AT_W(0, sm0); AT_W(1, sm1); AT_W(2, sm2); AT_W(3, sm3);
#undef AT_W
            Rl *= total;
            s16x4 t0, t1, t2, t3, t4, t5, t6, t7;
            asm volatile("ds_read_b64_tr_b16 %0, %8\n\t"
                         "ds_read_b64_tr_b16 %1, %8 offset:1536\n\t"
                         "ds_read_b64_tr_b16 %2, %8 offset:3072\n\t"
                         "ds_read_b64_tr_b16 %3, %8 offset:4608\n\t"
                         "ds_read_b64_tr_b16 %4, %8 offset:64\n\t"
                         "ds_read_b64_tr_b16 %5, %8 offset:1600\n\t"
                         "ds_read_b64_tr_b16 %6, %8 offset:3136\n\t"
                         "ds_read_b64_tr_b16 %7, %8 offset:4672\n\t"
                         "s_waitcnt lgkmcnt(0)"
                         : "=&v"(t0), "=&v"(t1), "=&v"(t2), "=&v"(t3), "=&v"(t4), "=&v"(t5), "=&v"(t6), "=&v"(t7) : "v"(vtr) : "memory");
#define AT_CAT(a, b) __builtin_shufflevector(a, b, 0, 1, 2, 3, 4, 5, 6, 7)
            {
                u32x4 pw; pw.x = cvtpk(w[0].x, w[0].y); pw.y = cvtpk(w[1].x, w[1].y); pw.z = cvtpk(w[2].x, w[2].y); pw.w = cvtpk(w[3].x, w[3].y);
                const bf16x8 pf = __builtin_bit_cast(bf16x8, pw);
                o0 = MFMA32(AT_CAT(t0, t1), pf, o0); o1 = MFMA32(AT_CAT(t4, t5), pf, o1);
            }
            {
                u32x4 pw; pw.x = cvtpk(w[4].x, w[4].y); pw.y = cvtpk(w[5].x, w[5].y); pw.z = cvtpk(w[6].x, w[6].y); pw.w = cvtpk(w[7].x, w[7].y);
                const bf16x8 pf = __builtin_bit_cast(bf16x8, pw);
                o0 = MFMA32(AT_CAT(t2, t3), pf, o0); o1 = MFMA32(AT_CAT(t6, t7), pf, o1);
            }
#undef AT_CAT
            return kt_ < 0 || __all(Rl < AT_STOP);
        };
#define AT_COMPUTE(kt_) (((kt_) < 0 || (kt_) == qt) ? compute((kt_), std::true_type{}) : compute((kt_), std::false_type{}))
#define AT_WAIT(N, k0, k1, k2, k3, v0, v1, v2, v3) asm volatile("s_waitcnt vmcnt(" #N ")" : "+v"(k0), "+v"(k1), "+v"(k2), "+v"(k3), "+v"(v0), "+v"(v1), "+v"(v2), "+v"(v3) :: "memory")
        for (;;) {
            AT_WAIT(0, ak0, ak1, ak2, ak3, av0, av1, av2, av3);
            stage(ak0, ak1, ak2, ak3, av0, av1, av2, av3);
            issue(ak0, ak1, ak2, ak3, av0, av1, av2, av3, AT_PREV(kt));
            if (AT_COMPUTE(kt)) break;
            kt = AT_PREV(kt);
        }
#undef AT_PREV
#undef AT_COMPUTE
        AT_WAIT(0, ak0, ak1, ak2, ak3, av0, av1, av2, av3);
#undef AT_WAIT
        if (!metaq || n < 16) {
            bf16_t* op = Oout + (size_t)(qrow0 + n) * DM + h * 64 + 4 * hh;
#pragma unroll
            for (int a = 0; a < 4; ++a) {
                u32x2 w0; w0.x = cvtpk(o0[4 * a], o0[4 * a + 1]); w0.y = cvtpk(o0[4 * a + 2], o0[4 * a + 3]);
                u32x2 w1; w1.x = cvtpk(o1[4 * a], o1[4 * a + 1]); w1.y = cvtpk(o1[4 * a + 2], o1[4 * a + 3]);
                *(u32x2*)(op + 8 * a) = w0; *(u32x2*)(op + 32 + 8 * a) = w1;
            }
        }
    }
}

__device__ __forceinline__ void final_phase(const Ptrs& P) {
    int tid = threadIdx.x; asm volatile("" : "+v"(tid));
    const int lane = tid & 63, wid = tid >> 6;
    const bf16_t* XB = (const bf16_t*)(P.ws + OFF_XB);
    const u64* ss3 = (const u64*)(P.ws + OFF_SS) + 3 * MP;
    const float* gain = P.in[19];
    f32x4 gv[4];
#pragma unroll
    for (int j = 0; j < 4; ++j) gv[j] = *(const f32x4*)(gain + 4 * lane + 256 * j);
    const int gw = blockIdx.x * 8 + wid, NGW = gridDim.x * 8;
    for (int row = gw; row < MR; row += NGW) {
        const float rs = rstd_of(ss3[row]);
#pragma unroll
        for (int j = 0; j < 4; ++j) { const u32x2 hb = __builtin_nontemporal_load((const u32x2*)(XB + (size_t)row * DM + 4 * lane + 256 * j));
            const f32x4 v = {__uint_as_float(hb.x << 16), __uint_as_float(hb.x & 0xffff0000u), __uint_as_float(hb.y << 16), __uint_as_float(hb.y & 0xffff0000u)};
            __builtin_nontemporal_store(v * rs * gv[j], (f32x4*)(P.out + (size_t)row * DM + 4 * lane + 256 * j)); }
    }
}

#ifndef REP_P0
#define REP_P0 1
#endif
#ifndef REP_S5
#define REP_S5 1
#endif
#ifndef REP_ATT
#define REP_ATT 1
#endif
#ifndef REP_SYNC
#define REP_SYNC 0
#endif
#ifndef REP_FI
#define REP_FI 1
#endif
#ifndef REP_FI_CHEAP
#define REP_FI_CHEAP 0
#endif
#ifndef REP_FIN
#define REP_FIN 1
#endif
constexpr int LDS_BYTES = 131072 + 256;
__global__ void __launch_bounds__(512, 2) s5yoco_fwd(Ptrs P) {
    extern __shared__ __attribute__((aligned(16))) unsigned char lds_raw[];
    LAS unsigned char* lds = (LAS unsigned char*)lds_raw;
    cg::grid_group grid = cg::this_grid();
    unsigned char* ws = P.ws;
    u64* ss = (u64*)(ws + OFF_SS);
    bf16_t* XB = (bf16_t*)(ws + OFF_XB); float* H = (float*)(ws + OFF_H); bf16_t* ZQ = (bf16_t*)(ws + OFF_ZQ); bf16_t* ACT = (bf16_t*)(ws + OFF_ACT);
    const int G = gridDim.x, c = blockIdx.x;
    StaticOrder S;
    volatile LAS unsigned* bst = (volatile LAS unsigned*)(lds + 131072);
    if (threadIdx.x < 2) bst[threadIdx.x] = 0u;
    __syncthreads();
    const XcdBarrier gbar = xcd_barrier_post((unsigned*)(ws + OFF_BAR), bst);
    if (ws == nullptr) grid.sync();
#define GSYNC() xcd_barrier(gbar)

#if REP_P0 >= 2
    p0_prologue(P, lds);
#endif
    p0_prologue(P, lds);
    GSYNC();
    for (int rep = 0; rep < REP_S5; ++rep) s5_phase(P, lds);
    GSYNC();
    bf16_t* KBp = (bf16_t*)(ws + OFF_KB); bf16_t* VTp = (bf16_t*)(ws + OFF_VT);
    {
        S.init(MR, 2048, G, c);
        EpiGLU E{(const float*)(ws + OFF_INV0), XB, ss};
        pg8::gemm_phase<EpiGLU, StaticOrder, true, true>(lds, Gemm{ZQ, (const bf16_t*)(ws + W_GLU), MR, 2048, 1024}, S, E);
        meta_gemm<0, true, 1024>(lds, ZQ + (size_t)MR * DM, (const bf16_t*)(ws + W_GLU), 64, P.in[1], H, XB, nullptr, nullptr, nullptr, ss, nullptr);
    }
    GSYNC();
    {
        S.init(MR, 5632, G, c);
#if REP_FI_CHEAP
        { EpiSwiGLU<true> Ec{ss, ACT}; pg8::gemm_phase<EpiSwiGLU<true>, StaticOrder, true, true>(lds, Gemm{XB, (const bf16_t*)(ws + W_FI0), MR, 5632, 1024}, S, Ec); }
#endif
        EpiSwiGLU<false> E{ss, ACT};
#if REP_FI >= 2
        pg8::gemm_phase<EpiSwiGLU<false>, StaticOrder, true, true>(lds, Gemm{XB, (const bf16_t*)(ws + W_FI0), MR, 5632, 1024}, S, E);
#endif
        pg8::gemm_phase<EpiSwiGLU<false>, StaticOrder, true, true>(lds, Gemm{XB, (const bf16_t*)(ws + W_FI0), MR, 5632, 1024}, S, E);
        meta_gemm<1, false, 1024>(lds, XB + (size_t)MR * DM, (const bf16_t*)(ws + W_FI0), 176, nullptr, nullptr, nullptr, ACT, nullptr, nullptr, nullptr, ss);
    }
    GSYNC();
    {
        S.init(MR, 1024, G, c);
        EpiResid<true> E{XB, ss + MP};
        pg8::gemm_phase<EpiResid<true>, StaticOrder, true, true>(lds, Gemm{ACT, (const bf16_t*)(ws + W_FO0), MR, 1024, DFF}, S, E);
        meta_gemm<2, true, DFF>(lds, ACT + (size_t)MR * DFF, (const bf16_t*)(ws + W_FO0), 64, nullptr, H, XB, nullptr, nullptr, nullptr, ss + MP, nullptr);
    }
    GSYNC();
    {
        S.init(MR, 3072, G, c);
        EpiKQ E{ss + MP, ZQ};
        pg8::gemm_phase<EpiKQ, StaticOrder, true, true>(lds, Gemm{XB, (const bf16_t*)(ws + W_KQ), MR, 3072, 1024}, S, E);
        meta_gemm<3, false, 1024>(lds, XB + (size_t)MR * DM, (const bf16_t*)(ws + W_KQ), 192, nullptr, nullptr, nullptr, KBp, ZQ, VTp, nullptr, ss + MP);
    }
    GSYNC();
    for (int rep = 1; rep < REP_ATT; ++rep) attn_phase(P, lds, (bf16_t*)(ws + OFF_H));
    attn_phase(P, lds, ZQ);
    GSYNC();
    {
        S.init(MR, 1024, G, c);
        EpiResid<true> E{XB, ss + 2 * MP};
        pg8::gemm_phase<EpiResid<true>, StaticOrder, true, true>(lds, Gemm{ZQ, (const bf16_t*)(ws + W_O), MR, 1024, 1024}, S, E);
    }
    GSYNC();
    {
        S.init(MR, 5632, G, c);
        EpiSwiGLU<false> E{ss + 2 * MP, ACT};
        pg8::gemm_phase<EpiSwiGLU<false>, StaticOrder, true, true>(lds, Gemm{XB, (const bf16_t*)(ws + W_FI1), MR, 5632, 1024}, S, E);
    }
    GSYNC();
    {
        S.init(MR, 1024, G, c);
        EpiResid<false> E{XB, ss + 3 * MP};
        pg8::gemm_phase<EpiResid<false>, StaticOrder, true, true>(lds, Gemm{ACT, (const bf16_t*)(ws + W_FO1), MR, 1024, DFF}, S, E);
    }
    GSYNC();
    for (int rep = 0; rep < REP_SYNC; ++rep) GSYNC();
    for (int rep = 0; rep < REP_FIN; ++rep) final_phase(P);
}

extern "C" void kernel_launch(void* const* d_in, const int* in_sizes, int n_in, void* d_out, int out_size, void* d_ws, size_t ws_size, hipStream_t stream) {
    static int grid = 0;
    if (grid == 0) {
        if (n_in != 20 || ws_size < WS_END) { fprintf(stderr, "kernel_launch: unexpected problem (n_in %d, ws %zu < %zu)\n", n_in, ws_size, (size_t)WS_END); grid = -1; return; }
        int dev = 0, cus = 0, per_cu = 0;
        hipGetDevice(&dev);
        hipDeviceGetAttribute(&cus, hipDeviceAttributeMultiprocessorCount, dev);
        if (hipFuncSetAttribute((const void*)s5yoco_fwd, hipFuncAttributeMaxDynamicSharedMemorySize, LDS_BYTES) != hipSuccess) { fprintf(stderr, "kernel_launch: hipFuncSetAttribute failed\n"); grid = -1; return; }
        if (hipOccupancyMaxActiveBlocksPerMultiprocessor(&per_cu, (const void*)s5yoco_fwd, 512, LDS_BYTES) != hipSuccess || per_cu < 1) { fprintf(stderr, "kernel_launch: occupancy query says %d\n", per_cu); per_cu = 1; }
        (void)hipGetLastError();
        grid = cus;
    }
    if (grid < 0) return;
    if (hipMemsetAsync((char*)d_ws + OFF_BAR, 0, 16384, stream) != hipSuccess) { fprintf(stderr, "kernel_launch: memset failed\n"); return; }
    Ptrs p{};
    for (int i = 0; i < 20; ++i) p.in[i] = (const float*)d_in[i];
    p.out = (float*)d_out; p.ws = (unsigned char*)d_ws;
    void* args[] = {&p};
    hipError_t e = hipLaunchCooperativeKernel((const void*)s5yoco_fwd, dim3(grid), dim3(512), args, LDS_BYTES, stream);
    if (e != hipSuccess) fprintf(stderr, "cooperative launch failed: %s (grid %d)\n", hipGetErrorString(e), grid);
}
```

```cpp
#include <hip/hip_runtime.h>
#include <hip/hip_cooperative_groups.h>
#include <cstdio>
#include <cstdint>
#include <type_traits>
namespace cg = cooperative_groups;
namespace pg8 {
#define PG8_LAS __attribute__((address_space(3)))
typedef unsigned short bf16_t;
typedef short bf16x8 __attribute__((ext_vector_type(8)));
typedef float f32x4 __attribute__((ext_vector_type(4)));
typedef unsigned u32x4 __attribute__((ext_vector_type(4)));
constexpr int BM = 256, BK = 64, HALF = 128, HTB = HALF * BK * 2  , STAGE_BYTES = 8 * HTB, NXCD = 8, WGM = 8;

__host__ __device__ __forceinline__ int lds_byte(int r, int c) { const int st = (r >> 4) * 2 + (c >> 5), rr = r & 15, cc = c & 31, ob = rr * 64 + cc * 2; return st * 1024 + (ob ^ (((ob >> 9) & 1) << 5)); }
__host__ __device__ __forceinline__ void stage_rc(int b, int& R, int& C) { const int st = b / 1024, sb = b % 1024, swz = sb ^ (((sb >> 9) & 1) << 5); R = (st >> 1) * 16 + swz / 64; C = (st & 1) * 32 + (swz % 64) / 2; }
__host__ __device__ __forceinline__ int perm32(int rho) { const int n = rho >> 4, i = rho & 15; return 8 * (i >> 2) + 4 * n + (i & 3); }

struct Unit { int pm, pn; };
struct Gemm { const bf16_t* A; const bf16_t* Bt; int M, N, K; };

struct StaticOrder {
    int nM, nN, nwg, G, c;
    __host__ __device__ void init(int M, int N, int G_, int c_) { nM = M / BM; nN = N / BM; nwg = nM * nN; G = G_; c = c_; }
    __host__ __device__ bool next(int i, Unit& u) const {
        const long L = (long)i * G + c; if (L >= nwg) return false;
        int wgid = (int)L; { const int q = nwg / NXCD, r = nwg % NXCD, xcd = wgid % NXCD, off = wgid / NXCD; wgid = (xcd < r ? xcd * (q + 1) : r * (q + 1) + (xcd - r) * q) + off; }
        const int nig = WGM * nN, gid = wgid / nig, fm = gid * WGM, gsz = (nM - fm) < WGM ? (nM - fm) : WGM;
        u.pm = fm + ((wgid % nig) % gsz); u.pn = (wgid % nig) / gsz; return true;
    }
    __device__ __forceinline__ void a_ready(const Unit&) const {}
    __device__ __forceinline__ void done(const Unit&) const {}
};
typedef float f32x2 __attribute__((ext_vector_type(2)));

template <class Epi, class Sched, bool ALIGN_EPI = false, bool SP2 = false>
__device__ __forceinline__ void gemm_phase(PG8_LAS unsigned char* lds, const Gemm g, const Sched& S, const Epi& E) {
    const int tid = threadIdx.x, wid = __builtin_amdgcn_readfirstlane(tid >> 6), lane = tid & 63, wr = wid >> 2, wc = wid & 3, fr = lane & 15, fq = lane >> 4;
    const int K = g.K, nt = K / BK;
    unsigned voffA[2], voffB[2];
#pragma unroll
    for (int i = 0; i < 2; ++i) { int R, C; stage_rc(tid * 16 + i * 8192, R, C); const int Rb = Epi::PERM ? ((R & ~31) + perm32(R & 31)) : R;
        voffA[i] = (unsigned)(R * K + C) * 2u; voffB[i] = (unsigned)(Rb * K + C) * 2u; }
    const size_t kstep = (size_t)(BK * 2);
    const size_t hstep = (size_t)HALF * K * 2;
    const size_t tstep = 2 * hstep;
    const unsigned ldsw = (unsigned)wid * 1024u;
    const int aoff = lds_byte(wr * 64 + fr, fq * 8), boff = lds_byte(wc * 32 + fr, fq * 8);
#define PG8_SA(b, h) (((b) * 2 + (h)) * HTB)
#define PG8_SB(b, h) ((4 + (b) * 2 + (h)) * HTB)
#define PG8_STAGE(bufoff, gbase, voff) do { _Pragma("unroll") for (int _i = 0; _i < 2; ++_i) \
        __builtin_amdgcn_global_load_lds((const unsigned*)((const char*)(gbase) + (voff)[_i]), (PG8_LAS unsigned*)(lds + (bufoff) + ldsw + _i * 8192), 16, 0, 0); } while (0)
#define PG8_LDA(dst, b, h) do { _Pragma("unroll") for (int m = 0; m < 4; ++m) _Pragma("unroll") for (int k = 0; k < 2; ++k) dst[m][k] = *(const PG8_LAS bf16x8*)(lds + PG8_SA(b, h) + aoff + m * 2048 + k * 1024); } while (0)
#define PG8_LDB(dst, b, h) do { _Pragma("unroll") for (int n = 0; n < 2; ++n) _Pragma("unroll") for (int k = 0; k < 2; ++k) dst[n][k] = *(const PG8_LAS bf16x8*)(lds + PG8_SB(b, h) + boff + n * 2048 + k * 1024); } while (0)
#define PG8_MMA(ai, bj, At, Bt) do { __builtin_amdgcn_s_setprio(1); _Pragma("unroll") for (int m = 0; m < 4; ++m) _Pragma("unroll") for (int n = 0; n < 2; ++n) _Pragma("unroll") for (int k = 0; k < 2; ++k) \
        acc[ai][bj][m][n] = __builtin_amdgcn_mfma_f32_16x16x32_bf16(Bt[n][k], At[m][k], acc[ai][bj][m][n], 0, 0, 0); __builtin_amdgcn_s_setprio(0); } while (0)
#define PG8_WAIT_V(n) asm volatile("s_waitcnt vmcnt(" #n ")" ::: "memory")
#define PG8_WAIT_L(n) asm volatile("s_waitcnt lgkmcnt(" #n ")" ::: "memory")
#define PG8_BAR __builtin_amdgcn_s_barrier()
#define PG8_SCHED __builtin_amdgcn_sched_barrier(0)
    Unit cur, nxt; int ui = 0;
    if (!S.next(0, cur)) return;
    f32x4 acc[2][2][4][2];
#pragma unroll
    for (int a = 0; a < 2; ++a)
#pragma unroll
        for (int b = 0; b < 2; ++b)
#pragma unroll
            for (int m = 0; m < 4; ++m)
#pragma unroll
                for (int n = 0; n < 2; ++n) acc[a][b][m][n] = (f32x4){0.f, 0.f, 0.f, 0.f};
    bf16x8 At[4][2], B0[2][2], B1[2][2];
    const char* cA = (const char*)g.A + (size_t)cur.pm * tstep; const char* cB = (const char*)g.Bt + (size_t)cur.pn * tstep;
    S.a_ready(cur);
    if constexpr (SP2) {
        PG8_STAGE(PG8_SB(0, 0), cB, voffB); PG8_STAGE(PG8_SB(0, 1), cB + hstep, voffB); PG8_STAGE(PG8_SA(0, 0), cA, voffA); PG8_STAGE(PG8_SA(0, 1), cA + hstep, voffA);
        if (wr == 1) PG8_BAR;
        PG8_WAIT_V(2); PG8_BAR;
        PG8_STAGE(PG8_SB(1, 0), cB + kstep, voffB); PG8_STAGE(PG8_SA(1, 0), cA + kstep, voffA); PG8_STAGE(PG8_SB(1, 1), cB + hstep + kstep, voffB);
        PG8_WAIT_V(6); PG8_BAR;
    } else {
        PG8_STAGE(PG8_SB(0, 0), cB, voffB); PG8_STAGE(PG8_SA(0, 0), cA, voffA); PG8_STAGE(PG8_SB(0, 1), cB + hstep, voffB); PG8_STAGE(PG8_SA(0, 1), cA + hstep, voffA);
        if (wr == 1) PG8_BAR;
        PG8_WAIT_V(4); PG8_BAR;
        PG8_STAGE(PG8_SB(1, 0), cB + kstep, voffB); PG8_STAGE(PG8_SA(1, 0), cA + kstep, voffA); PG8_STAGE(PG8_SB(1, 1), cB + hstep + kstep, voffB);
        PG8_WAIT_V(6); PG8_BAR;
    }
    for (;;) {
        const bool has_next = S.next(ui + 1, nxt);
        const char* nA = has_next ? (const char*)g.A + (size_t)nxt.pm * tstep : cA; const char* nB = has_next ? (const char*)g.Bt + (size_t)nxt.pn * tstep : cB;
        for (int t = 0; t < nt; t += 2) {
            const bool last = (t == nt - 2);
            const char* a1 = cA + (size_t)(t + 1) * kstep;
            const char* a2 = last ? nA : cA + (size_t)(t + 2) * kstep; const char* b2 = last ? nB : cB + (size_t)(t + 2) * kstep;
            const char* a3 = a2 + kstep; const char* b3 = b2 + kstep;
            if (last && has_next) S.a_ready(nxt);
            if constexpr (SP2) {
            PG8_LDB(B0, 0, 0); PG8_LDB(B1, 0, 1); PG8_SCHED; PG8_LDA(At, 0, 0); PG8_STAGE(PG8_SA(1, 1), a1 + hstep, voffA);
            PG8_WAIT_V(8); PG8_WAIT_L(0); PG8_BAR; PG8_MMA(0, 0, At, B0); PG8_MMA(0, 1, At, B1); PG8_BAR; PG8_SCHED;
            PG8_LDA(At, 0, 1); PG8_STAGE(PG8_SB(0, 0), b2, voffB); PG8_STAGE(PG8_SB(0, 1), b2 + hstep, voffB); PG8_STAGE(PG8_SA(0, 0), a2, voffA);
            PG8_WAIT_V(8); PG8_WAIT_L(0); PG8_BAR; PG8_MMA(1, 0, At, B0); PG8_MMA(1, 1, At, B1); PG8_BAR; PG8_SCHED;
            PG8_LDB(B0, 1, 0); PG8_LDB(B1, 1, 1); PG8_SCHED; PG8_LDA(At, 1, 0); PG8_STAGE(PG8_SA(0, 1), a2 + hstep, voffA);
            PG8_WAIT_V(8); PG8_WAIT_L(0); PG8_BAR; PG8_MMA(0, 0, At, B0); PG8_MMA(0, 1, At, B1); PG8_BAR; PG8_SCHED;
            PG8_LDA(At, 1, 1); PG8_STAGE(PG8_SB(1, 0), b3, voffB); PG8_STAGE(PG8_SB(1, 1), b3 + hstep, voffB); PG8_STAGE(PG8_SA(1, 0), a3, voffA);
            PG8_WAIT_V(8); PG8_WAIT_L(0); PG8_BAR; PG8_MMA(1, 0, At, B0); PG8_MMA(1, 1, At, B1); PG8_BAR; PG8_SCHED;
            } else {
            PG8_LDB(B0, 0, 0); PG8_SCHED; PG8_LDA(At, 0, 0); PG8_STAGE(PG8_SA(1, 1), a1 + hstep, voffA);
            PG8_WAIT_L(8); PG8_BAR; PG8_WAIT_L(0); PG8_MMA(0, 0, At, B0); PG8_BAR; PG8_SCHED;
            PG8_LDB(B1, 0, 1); PG8_STAGE(PG8_SB(0, 0), b2, voffB);
            PG8_BAR; PG8_WAIT_L(0); PG8_MMA(0, 1, At, B1); PG8_BAR;
            PG8_LDA(At, 0, 1); PG8_STAGE(PG8_SA(0, 0), a2, voffA);
            PG8_BAR; PG8_WAIT_L(0); PG8_MMA(1, 0, At, B0); PG8_BAR; PG8_SCHED;
            PG8_STAGE(PG8_SB(0, 1), b2 + hstep, voffB);
            PG8_WAIT_V(6); PG8_BAR; PG8_MMA(1, 1, At, B1); PG8_BAR;
            PG8_LDB(B0, 1, 0); PG8_SCHED; PG8_LDA(At, 1, 0); PG8_STAGE(PG8_SA(0, 1), a2 + hstep, voffA);
            PG8_WAIT_L(8); PG8_BAR; PG8_WAIT_L(0); PG8_MMA(0, 0, At, B0); PG8_BAR; PG8_SCHED;
            PG8_LDB(B1, 1, 1); PG8_STAGE(PG8_SB(1, 0), b3, voffB);
            PG8_BAR; PG8_WAIT_L(0); PG8_MMA(0, 1, At, B1); PG8_BAR;
            PG8_LDA(At, 1, 1); PG8_STAGE(PG8_SA(1, 0), a3, voffA);
            PG8_BAR; PG8_WAIT_L(0); PG8_MMA(1, 0, At, B0); PG8_BAR; PG8_SCHED;
            PG8_STAGE(PG8_SB(1, 1), b3 + hstep, voffB);
            PG8_WAIT_V(6); PG8_BAR; PG8_MMA(1, 1, At, B1); PG8_BAR;
            }
        }
        if constexpr (ALIGN_EPI) { if (wr == 0) PG8_BAR; }
        if constexpr (!Epi::AFTER_DRAIN) { E(acc, cur, wr, wc, fr, fq); S.done(cur); }
        if (!has_next) break;
#pragma unroll
        for (int a = 0; a < 2; ++a)
#pragma unroll
            for (int b = 0; b < 2; ++b)
#pragma unroll
                for (int m = 0; m < 4; ++m)
#pragma unroll
                    for (int n = 0; n < 2; ++n) acc[a][b][m][n] = (f32x4){0.f, 0.f, 0.f, 0.f};
        cur = nxt; cA = nA; cB = nB; ++ui;
        if constexpr (ALIGN_EPI) { if (wr == 1) PG8_BAR; }
    }
    PG8_WAIT_V(0);
    if constexpr (!ALIGN_EPI) { if (wr == 0) PG8_BAR; }
    PG8_BAR;
    if constexpr (Epi::AFTER_DRAIN) { E.fused(acc, cur, wr, wc, fr, fq, lds, wid, lane); S.done(cur); }
#undef PG8_SA
#undef PG8_SB
#undef PG8_STAGE
#undef PG8_LDA
#undef PG8_LDB
#undef PG8_MMA
#undef PG8_WAIT_V
#undef PG8_WAIT_L
#undef PG8_BAR
#undef PG8_SCHED
}
}

using pg8::bf16_t; using pg8::bf16x8; using pg8::f32x4; using pg8::Unit; using pg8::Gemm; using pg8::StaticOrder;
#define LAS __attribute__((address_space(3)))
typedef float f32x16 __attribute__((ext_vector_type(16)));
typedef short s16x4 __attribute__((ext_vector_type(4)));
typedef unsigned u32x2 __attribute__((ext_vector_type(2)));
typedef unsigned u32x4 __attribute__((ext_vector_type(4)));
typedef float f32x2_t __attribute__((ext_vector_type(2)));
typedef __bf16 bf16x2_t __attribute__((ext_vector_type(2)));
typedef unsigned long long u64;

constexpr int NB = 8, SEQ = 4096, NMETA = 16, DM = 1024, DFF = 2816, NHEAD = 16;
constexpr int MR = NB * SEQ;
constexpr int MROWS = MR + NMETA;
constexpr int MP = 33024;
constexpr float QSCALE = -0.125f * 1.4426950408889634f;
constexpr float SS_SCALE = 1048576.0f;

constexpr size_t OFF_SS = 0;
constexpr size_t OFF_BAR = 0x108000;
constexpr size_t OFF_S5 = 0x110000;
constexpr size_t S5_ABAR = OFF_S5;
constexpr size_t S5_BB = OFF_S5 + 0x8000;
constexpr size_t S5_CB = S5_BB + 0x40000;
constexpr size_t S5_DG = S5_CB + 0x40000;
constexpr size_t OFF_INV0 = 0x1A0000;
constexpr size_t OFF_W = 0x210000;
constexpr size_t W_GLU = OFF_W;
constexpr size_t W_FI0 = W_GLU + 2048ull * 1024 * 2;
constexpr size_t W_FI1 = W_FI0 + 5632ull * 1024 * 2;
constexpr size_t W_FO0 = W_FI1 + 5632ull * 1024 * 2;
constexpr size_t W_FO1 = W_FO0 + 1024ull * 2816 * 2;
constexpr size_t W_KQ = W_FO1 + 1024ull * 2816 * 2;
constexpr size_t W_V = W_KQ + 2048ull * 1024 * 2;
constexpr size_t W_O = W_V + 1024ull * 1024 * 2;
constexpr size_t OFF_XB = W_O + 1024ull * 1024 * 2;
constexpr size_t OFF_H = OFF_XB + (size_t)MP * 1024 * 2;
constexpr size_t OFF_W1 = OFF_H;
constexpr size_t OFF_ZQ = OFF_H + (size_t)MP * 1024 * 4;
constexpr size_t OFF_KB = OFF_ZQ + (size_t)MP * 1024 * 2;
constexpr size_t OFF_VT = OFF_KB + (size_t)MP * 1024 * 2;
constexpr size_t OFF_ACT = OFF_ZQ;
constexpr size_t WS_END = OFF_VT + (size_t)MP * 1024 * 2;
static_assert((size_t)MP * DFF * 2 <= WS_END - OFF_ACT, "ACT overlay fits");
static_assert(S5_DG + 4096 <= OFF_W, "s5 params fit");
static_assert(OFF_KB == OFF_ZQ + (size_t)MP * 1024 * 2 && OFF_VT == OFF_ZQ + 2 * (size_t)MP * 1024 * 2, "Q | K | V adjacent");

__device__ __forceinline__ unsigned cvtpk(float lo, float hi) { f32x2_t v = {lo, hi}; bf16x2_t b = __builtin_convertvector(v, bf16x2_t); return __builtin_bit_cast(unsigned, b); }
__device__ __forceinline__ float frcp(float x) { return __builtin_amdgcn_rcpf(x); }
__device__ __forceinline__ float rstd_of(u64 v) { return rsqrtf((float)v * (1.0f / (SS_SCALE * 1024.0f)) + 1e-6f); }
__device__ __forceinline__ void ss_add(u64* p, float s) { __hip_atomic_fetch_add(p, (u64)(s * SS_SCALE), __ATOMIC_RELAXED, __HIP_MEMORY_SCOPE_AGENT); }
__device__ __forceinline__ float bf2f(unsigned short b) { return __uint_as_float((unsigned)b << 16); }


struct EpiGLU {
    static constexpr bool PERM = true, AFTER_DRAIN = false;
    const float* inv0; bf16_t* XB; u64* ss;
    __device__ __forceinline__ void operator()(const f32x4 (&acc)[2][2][4][2], const Unit& u, int wr, int wc, int fr, int fq) const {
        const int col0 = u.pn * 128 + wc * 32 + 8 * fq;
        const int row0 = u.pm * 256 + wr * 64 + fr;
        const size_t rbase = (size_t)row0 * DM + col0;
#pragma unroll
        for (int ai = 0; ai < 2; ++ai) {
            u32x4 hv[4]; float iv[4];
#pragma unroll
            for (int m = 0; m < 4; ++m) { hv[m] = *(const u32x4*)(XB + rbase + (size_t)(ai * 128 + m * 16) * DM); iv[m] = inv0[row0 + ai * 128 + m * 16]; }
            float s[4];
#pragma unroll
            for (int m = 0; m < 4; ++m) {
                const u32x4 hb = hv[m];
                f32x4 h0 = {__uint_as_float(hb.x << 16), __uint_as_float(hb.x & 0xffff0000u), __uint_as_float(hb.y << 16), __uint_as_float(hb.y & 0xffff0000u)};
                f32x4 h1 = {__uint_as_float(hb.z << 16), __uint_as_float(hb.z & 0xffff0000u), __uint_as_float(hb.w << 16), __uint_as_float(hb.w & 0xffff0000u)};
                h0 *= iv[m]; h1 *= iv[m];
                const f32x4 v0 = acc[ai][0][m][0], v1 = acc[ai][0][m][1], g0 = acc[ai][1][m][0], g1 = acc[ai][1][m][1];
#pragma unroll
                for (int j = 0; j < 4; ++j) { h0[j] += v0[j] * frcp(1.f + __expf(-g0[j])); h1[j] += v1[j] * frcp(1.f + __expf(-g1[j])); }
                const size_t off = rbase + (size_t)(ai * 128 + m * 16) * DM;
                u32x4 w; w.x = cvtpk(h0[0], h0[1]); w.y = cvtpk(h0[2], h0[3]); w.z = cvtpk(h1[0], h1[1]); w.w = cvtpk(h1[2], h1[3]);
                *(u32x4*)(XB + off) = w;
                s[m] = (h0[0] * h0[0] + h0[1] * h0[1]) + (h0[2] * h0[2] + h0[3] * h0[3]) + (h1[0] * h1[0] + h1[1] * h1[1]) + (h1[2] * h1[2] + h1[3] * h1[3]);
            }
#pragma unroll
            for (int m = 0; m < 4; ++m) { s[m] += __shfl_xor(s[m], 16); s[m] += __shfl_xor(s[m], 32); }
            const float mine = fq == 0 ? s[0] : (fq == 1 ? s[1] : (fq == 2 ? s[2] : s[3]));
            ss_add(ss + (u.pm * 256 + ai * 128 + wr * 64 + fq * 16 + fr), mine);
        }
    }
};

template <bool CHEAP = false> struct EpiSwiGLU {
    static constexpr bool PERM = true, AFTER_DRAIN = false;
    const u64* ss; bf16_t* ACT;
    __device__ __forceinline__ void operator()(const f32x4 (&acc)[2][2][4][2], const Unit& u, int wr, int wc, int fr, int fq) const {
        const int col0 = u.pn * 128 + wc * 32 + 8 * fq;
        const int row0 = u.pm * 256 + wr * 64 + fr;
        u64 sv[2][4];
#pragma unroll
        for (int ai = 0; ai < 2; ++ai)
#pragma unroll
            for (int m = 0; m < 4; ++m) sv[ai][m] = ss[row0 + ai * 128 + m * 16];
#pragma unroll
        for (int ai = 0; ai < 2; ++ai)
#pragma unroll
            for (int m = 0; m < 4; ++m) {
                const int row = row0 + ai * 128 + m * 16;
                const float rs = rstd_of(sv[ai][m]);
                const float c1 = rs * -1.4426950408889634f, rs2 = rs * rs;
                unsigned ow[4];
#pragma unroll
                for (int n = 0; n < 2; ++n)
#pragma unroll
                    for (int jp = 0; jp < 2; ++jp) {
                        const f32x2_t ag = {acc[ai][0][m][n][2 * jp], acc[ai][0][m][n][2 * jp + 1]}, au = {acc[ai][1][m][n][2 * jp], acc[ai][1][m][n][2 * jp + 1]};
                        f32x2_t ov;
                        if (CHEAP) ov = ag * au;
                        else { const f32x2_t t = ag * c1; f32x2_t e; e.x = __builtin_amdgcn_exp2f(t.x); e.y = __builtin_amdgcn_exp2f(t.y);
                            const f32x2_t d = e + 1.0f; f32x2_t r; r.x = frcp(d.x); r.y = frcp(d.y);
                            ov = (ag * au) * (r * rs2); }
                        ow[2 * n + jp] = cvtpk(ov.x, ov.y);
                    }
                u32x4 w; w.x = ow[0]; w.y = ow[1]; w.z = ow[2]; w.w = ow[3];
                *(u32x4*)(ACT + (size_t)row * DFF + col0) = w;
            }
    }
};

template <bool WRITE_XB> struct EpiResid {
    static constexpr bool PERM = true, AFTER_DRAIN = false;
    bf16_t* XB; u64* ss;
    __device__ __forceinline__ void operator()(const f32x4 (&acc)[2][2][4][2], const Unit& u, int wr, int wc, int fr, int fq) const {
        const int col0 = u.pn * 256 + wc * 32 + 8 * fq;
        const size_t rbase = (size_t)(u.pm * 256 + wr * 64 + fr) * DM + col0;
#pragma unroll
        for (int ai = 0; ai < 2; ++ai) {
            u32x4 hv[4][2];
#pragma unroll
            for (int m = 0; m < 4; ++m)
#pragma unroll
                for (int bj = 0; bj < 2; ++bj) hv[m][bj] = *(const u32x4*)(XB + rbase + (size_t)(ai * 128 + m * 16) * DM + bj * 128);
            float s[4];
#pragma unroll
            for (int m = 0; m < 4; ++m) {
                float sq = 0.f;
#pragma unroll
                for (int bj = 0; bj < 2; ++bj) {
                    const size_t off = rbase + (size_t)(ai * 128 + m * 16) * DM + bj * 128;
                    const u32x4 hb = hv[m][bj];
                    f32x4 h0 = {__uint_as_float(hb.x << 16), __uint_as_float(hb.x & 0xffff0000u), __uint_as_float(hb.y << 16), __uint_as_float(hb.y & 0xffff0000u)};
                    f32x4 h1 = {__uint_as_float(hb.z << 16), __uint_as_float(hb.z & 0xffff0000u), __uint_as_float(hb.w << 16), __uint_as_float(hb.w & 0xffff0000u)};
                    h0 += acc[ai][bj][m][0]; h1 += acc[ai][bj][m][1];
                    u32x4 w; w.x = cvtpk(h0[0], h0[1]); w.y = cvtpk(h0[2], h0[3]); w.z = cvtpk(h1[0], h1[1]); w.w = cvtpk(h1[2], h1[3]);
                    *(u32x4*)(XB + off) = w;
                    sq += (h0[0] * h0[0] + h0[1] * h0[1]) + (h0[2] * h0[2] + h0[3] * h0[3]) + (h1[0] * h1[0] + h1[1] * h1[1]) + (h1[2] * h1[2] + h1[3] * h1[3]);
                }
                s[m] = sq;
            }
#pragma unroll
            for (int m = 0; m < 4; ++m) { s[m] += __shfl_xor(s[m], 16); s[m] += __shfl_xor(s[m], 32); }
            const float mine = fq == 0 ? s[0] : (fq == 1 ? s[1] : (fq == 2 ? s[2] : s[3]));
            ss_add(ss + (u.pm * 256 + ai * 128 + wr * 64 + fq * 16 + fr), mine);
        }
    }
};

struct EpiKQ {
    static constexpr bool PERM = true, AFTER_DRAIN = false;
    const u64* ss; bf16_t* QB;
    __device__ __forceinline__ void operator()(const f32x4 (&acc)[2][2][4][2], const Unit& u, int wr, int wc, int fr, int fq) const {
        const int t3 = u.pn >> 2; const bool isq = t3 == 1;
        const int sel = t3 == 2 ? 2 : 1 - t3;
        bf16_t* base = QB + (size_t)sel * ((size_t)MP * DM); const float sc = isq ? QSCALE : 1.0f;
        const int col0 = (u.pn & 3) * 256 + wc * 32 + 8 * fq;
        const int row0 = u.pm * 256 + wr * 64 + fr;
        u64 sv[2][4];
#pragma unroll
        for (int ai = 0; ai < 2; ++ai)
#pragma unroll
            for (int m = 0; m < 4; ++m) sv[ai][m] = ss[row0 + ai * 128 + m * 16];
#pragma unroll
        for (int ai = 0; ai < 2; ++ai)
#pragma unroll
            for (int m = 0; m < 4; ++m) {
                const int row = row0 + ai * 128 + m * 16;
                const float rs = rstd_of(sv[ai][m]) * sc;
#pragma unroll
                for (int bj = 0; bj < 2; ++bj) { const f32x4 v0 = acc[ai][bj][m][0] * rs, v1 = acc[ai][bj][m][1] * rs;
                    u32x4 w; w.x = cvtpk(v0[0], v0[1]); w.y = cvtpk(v0[2], v0[3]); w.z = cvtpk(v1[0], v1[1]); w.w = cvtpk(v1[2], v1[3]);
                    *(u32x4*)(base + (size_t)row * DM + col0 + bj * 128) = w; }
            }
    }
};

struct EpiVt {
    static constexpr bool PERM = true, AFTER_DRAIN = false;
    const u64* ss; bf16_t* VT;
    __device__ __forceinline__ void operator()(const f32x4 (&acc)[2][2][4][2], const Unit& u, int wr, int wc, int fr, int fq) const {
        const int col0 = u.pn * 256 + wc * 32 + 8 * fq;
#pragma unroll
        for (int bj = 0; bj < 2; ++bj) {
            float rs[8];
#pragma unroll
            for (int j = 0; j < 8; ++j) rs[j] = rstd_of(ss[col0 + bj * 128 + j]);
#pragma unroll
            for (int ai = 0; ai < 2; ++ai)
#pragma unroll
                for (int m = 0; m < 4; ++m) {
                    const int ch = u.pm * 256 + ai * 128 + wr * 64 + m * 16 + fr;
                    const f32x4 v0 = acc[ai][bj][m][0], v1 = acc[ai][bj][m][1];
                    u32x4 w; w.x = cvtpk(v0[0] * rs[0], v0[1] * rs[1]); w.y = cvtpk(v0[2] * rs[2], v0[3] * rs[3]); w.z = cvtpk(v1[0] * rs[4], v1[1] * rs[5]); w.w = cvtpk(v1[2] * rs[6], v1[3] * rs[7]);
                    *(u32x4*)(VT + (size_t)ch * MP + col0 + bj * 128) = w;
                }
        }
    }
};

template <int MODE, bool WXB, int K>
__device__ __forceinline__ void meta_gemm(LAS unsigned char* lds, const bf16_t* A, const bf16_t* Bt, int nitems, const float* meta, float* H, bf16_t* XB, bf16_t* O1, bf16_t* O2, bf16_t* O3, u64* ss_out, const u64* ss_in) {
    constexpr bool GATED = (MODE == 0 || MODE == 1);
    int tid = threadIdx.x; asm volatile("" : "+v"(tid));
    const int lane = tid & 63, wid = __builtin_amdgcn_readfirstlane(tid >> 6);
    LAS f32x4* red = (LAS f32x4*)lds;
    for (int it = blockIdx.x; it < nitems; it += gridDim.x) {
        const int c0 = it * 16;
        const int brow0 = GATED ? 256 * (c0 >> 7) + (c0 & 127) : c0;
        const int kw = K >> 3, k0 = wid * kw;
        f32x4 acc0 = {0.f, 0.f, 0.f, 0.f}, acc1 = {0.f, 0.f, 0.f, 0.f};
        const bf16_t* ap = A + (size_t)(lane & 15) * K + k0 + 8 * (lane >> 4);
        const bf16_t* bp = Bt + (size_t)(brow0 + (lane & 15)) * K + k0 + 8 * (lane >> 4);
        constexpr int NKS = K / 8 / 32;
        bf16x8 av[NKS], bv0[NKS], bv1[GATED ? NKS : 1];
#pragma unroll
        for (int i = 0; i < NKS; ++i) { av[i] = *(const bf16x8*)(ap + 32 * i); bv0[i] = *(const bf16x8*)(bp + 32 * i); if (GATED) bv1[i] = *(const bf16x8*)(bp + (size_t)128 * K + 32 * i); }
#pragma unroll
        for (int i = 0; i < NKS; ++i) {
            acc0 = __builtin_amdgcn_mfma_f32_16x16x32_bf16(av[i], bv0[i], acc0, 0, 0, 0);
            if (GATED) acc1 = __builtin_amdgcn_mfma_f32_16x16x32_bf16(av[i], bv1[i], acc1, 0, 0, 0);
        }
        red[wid * 64 + lane] = acc0; if (GATED) red[512 + wid * 64 + lane] = acc1;
        __syncthreads();
        if (wid == 0) {
            f32x4 s0 = red[lane], s1 = {0.f, 0.f, 0.f, 0.f};
#pragma unroll
            for (int w = 1; w < 8; ++w) s0 += red[w * 64 + lane];
            if (GATED) { s1 = red[512 + lane];
#pragma unroll
                for (int w = 1; w < 8; ++w) s1 += red[512 + w * 64 + lane]; }
            const int c = c0 + (lane & 15);
#pragma unroll
            for (int j = 0; j < 4; ++j) {
                const int r = 4 * (lane >> 4) + j;
                if (MODE == 0 || MODE == 2) {
                    float hn;
                    if (MODE == 0) hn = meta[r * DM + c] + s0[j] * frcp(1.f + __expf(-s1[j]));
                    else hn = bf2f(XB[(size_t)(MR + r) * DM + c]) + s0[j];
                    XB[(size_t)(MR + r) * DM + c] = (bf16_t)(cvtpk(hn, 0.f) & 0xffffu);
                    float sq = hn * hn;
                    sq += __shfl_xor(sq, 1); sq += __shfl_xor(sq, 2); sq += __shfl_xor(sq, 4); sq += __shfl_xor(sq, 8);
                    if ((lane & 15) == 0) ss_add(ss_out + MR + r, sq);
                } else {
                    const float rs = rstd_of(ss_in[MR + r]);
                    if (MODE == 1) { const float g = s0[j] * rs, uu = s1[j] * rs; O1[(size_t)(MR + r) * DFF + c] = (bf16_t)(cvtpk(g * uu * frcp(1.f + __expf(-g)), 0.f) & 0xffffu); }
                    if (MODE == 3) { if (c < 1024) O1[(size_t)(MR + r) * DM + c] = (bf16_t)(cvtpk(s0[j] * rs, 0.f) & 0xffffu);
                        else if (c < 2048) O2[(size_t)(MR + r) * DM + c - 1024] = (bf16_t)(cvtpk(s0[j] * rs * QSCALE, 0.f) & 0xffffu);
                        else { O3[(size_t)(MR + r) * DM + c - 2048] = (bf16_t)(cvtpk(s0[j] * rs, 0.f) & 0xffffu); O3[(size_t)(MR + 16 + r) * DM + c - 2048] = 0; } }
                    if (MODE == 4) { O1[(size_t)c * MP + MR + r] = (bf16_t)(cvtpk(s0[j] * rs, 0.f) & 0xffffu); O1[(size_t)c * MP + MR + 16 + r] = 0; }
                }
            }
        }
        __syncthreads();
    }
}

__device__ __forceinline__ void transpose_item(const float* src, int ldn, const float* gain, bf16_t* dst, int K, int n0d, int c0s, int k0, int lane) {
    const float* sp = src + (size_t)k0 * ldn + c0s + lane;
    float v[32];
#pragma unroll
    for (int k = 0; k < 32; ++k) v[k] = sp[(size_t)k * ldn];
    if (gain) {
#pragma unroll
        for (int k = 0; k < 32; ++k) v[k] *= gain[k0 + k];
    }
    bf16_t* dp = dst + (size_t)(n0d + lane) * K + k0;
#pragma unroll
    for (int q = 0; q < 4; ++q) { u32x4 w; w.x = cvtpk(v[8 * q], v[8 * q + 1]); w.y = cvtpk(v[8 * q + 2], v[8 * q + 3]); w.z = cvtpk(v[8 * q + 4], v[8 * q + 5]); w.w = cvtpk(v[8 * q + 6], v[8 * q + 7]);
        *(u32x4*)(dp + 8 * q) = w; }
}

struct Ptrs {
    const float* in[20]; float* out; unsigned char* ws;
};

__device__ __forceinline__ void p0_prologue(const Ptrs& P, LAS unsigned char* lds) {
    int tid = threadIdx.x; asm volatile("" : "+v"(tid));
    const int lane = tid & 63, wid = tid >> 6;
    unsigned char* ws = P.ws;
    const int gw = blockIdx.x * 8 + wid, NGW = gridDim.x * 8;
    constexpr int I_GLU = 32 * 32, I_FI = 32 * 88, I_FO = 88 * 16, I_KQ = 32 * 32, I_V = 32 * 16, I_O = 32 * 16;
    constexpr int NITEMS = I_GLU + 2 * I_FI + 2 * I_FO + I_KQ + I_V + I_O;
    struct TItem { const float* sp; const float* gp; bf16_t* dp; int ldn; };
    auto decode = [&](const int it) __attribute__((always_inline)) -> TItem {
        int r = it; const float* src; const float* gain; bf16_t* dst; int ldn, K, n0d, c0s, k0;
        if (r < I_GLU) { const int kb = r & 31, nb = r >> 5, n0 = nb * 64; src = P.in[12]; ldn = 2048; gain = nullptr; dst = (bf16_t*)(ws + W_GLU); K = 1024; n0d = n0; c0s = ((n0 >> 7) & 1) * 1024 + (n0 >> 8) * 128 + (n0 & 127); k0 = kb * 32; }
        else if ((r -= I_GLU) < 2 * I_FI) { const int l = r / I_FI; r -= l * I_FI; const int kb = r & 31, nb = r >> 5, n0 = nb * 64; src = P.in[17] + (size_t)l * 1024 * 5632; ldn = 5632; gain = P.in[3] + l * 1024;
            dst = (bf16_t*)(ws + W_FI0) + (size_t)l * 5632 * 1024; K = 1024; n0d = n0; c0s = ((n0 >> 7) & 1) * DFF + (n0 >> 8) * 128 + (n0 & 127); k0 = kb * 32; }
        else if ((r -= 2 * I_FI) < 2 * I_FO) { const int l = r / I_FO; r -= l * I_FO; const int kb = r % 88, nb = r / 88; src = P.in[18] + (size_t)l * 2816 * 1024; ldn = 1024; gain = nullptr;
            dst = (bf16_t*)(ws + W_FO0) + (size_t)l * 1024 * 2816; K = 2816; n0d = nb * 64; c0s = nb * 64; k0 = kb * 32; }
        else if ((r -= 2 * I_FO) < I_KQ) { const int kb = r & 31, nb = r >> 5, n0 = nb * 64; dst = (bf16_t*)(ws + W_KQ); K = 1024; n0d = n0; k0 = kb * 32;
            if (n0 < 1024) { src = P.in[14]; ldn = 2048; gain = P.in[13]; c0s = n0; } else { src = P.in[15]; ldn = 1024; gain = P.in[2] + 1024; c0s = n0 - 1024; } }
        else if ((r -= I_KQ) < I_V) { const int kb = r & 31, nb = r >> 5; src = P.in[14]; ldn = 2048; gain = P.in[13]; dst = (bf16_t*)(ws + W_V); K = 1024; n0d = nb * 64; c0s = 1024 + nb * 64; k0 = kb * 32; }
        else { r -= I_V; const int kb = r & 31, nb = r >> 5; src = P.in[16]; ldn = 1024; gain = nullptr; dst = (bf16_t*)(ws + W_O); K = 1024; n0d = nb * 64; c0s = nb * 64; k0 = kb * 32; }
        TItem t; t.sp = src + (size_t)k0 * ldn + c0s + lane; t.gp = gain ? gain + k0 : nullptr; t.dp = dst + (size_t)(n0d + lane) * K + k0; t.ldn = ldn; return t;
    };
    auto finish = [&](const TItem& t, float (&v)[32]) __attribute__((always_inline)) {
        if (t.gp) {
#pragma unroll
            for (int k = 0; k < 32; ++k) v[k] *= t.gp[k];
        }
#pragma unroll
        for (int q = 0; q < 4; ++q) { u32x4 w; w.x = cvtpk(v[8 * q], v[8 * q + 1]); w.y = cvtpk(v[8 * q + 2], v[8 * q + 3]); w.z = cvtpk(v[8 * q + 4], v[8 * q + 5]); w.w = cvtpk(v[8 * q + 6], v[8 * q + 7]);
            *(u32x4*)(t.dp + 8 * q) = w; }
    };
    for (int it = gw; it < NITEMS; it += 2 * NGW) {
        const bool hb = it + NGW < NITEMS;
        const TItem a = decode(it), b = decode(hb ? it + NGW : it);
        float va[32], vb[32];
#pragma unroll
        for (int k = 0; k < 32; ++k) { va[k] = __builtin_nontemporal_load(a.sp + (size_t)k * a.ldn); vb[k] = __builtin_nontemporal_load(b.sp + (size_t)k * b.ldn); }
        finish(a, va);
        if (hb) finish(b, vb);
    }
    bf16_t* XB = (bf16_t*)(ws + OFF_XB);
    for (int row = gw; row < MROWS; row += 2 * NGW) {
        const int row2 = row + NGW; const bool has2 = row2 < MROWS;
        const float* src = row < MR ? P.in[0] + (size_t)row * DM : P.in[1] + (size_t)(row - MR) * DM;
        const float* src2 = has2 ? (row2 < MR ? P.in[0] + (size_t)row2 * DM : P.in[1] + (size_t)(row2 - MR) * DM) : src;
        f32x4 v[4], v2[4]; float s = 0.f, s2 = 0.f;
#pragma unroll
        for (int j = 0; j < 4; ++j) { v[j] = __builtin_nontemporal_load((const f32x4*)(src + 4 * lane + 256 * j)); v2[j] = __builtin_nontemporal_load((const f32x4*)(src2 + 4 * lane + 256 * j)); }
#pragma unroll
        for (int j = 0; j < 4; ++j) { s += (v[j][0] * v[j][0] + v[j][1] * v[j][1]) + (v[j][2] * v[j][2] + v[j][3] * v[j][3]); s2 += (v2[j][0] * v2[j][0] + v2[j][1] * v2[j][1]) + (v2[j][2] * v2[j][2] + v2[j][3] * v2[j][3]); }
#pragma unroll
        for (int o = 1; o < 64; o <<= 1) { s += __shfl_xor(s, o); s2 += __shfl_xor(s2, o); }
        const float ms = s * (1.0f / 1024.0f) + 1e-6f, ms2 = s2 * (1.0f / 1024.0f) + 1e-6f;
        const float rs = rsqrtf(ms), rs2 = rsqrtf(ms2);
        if (lane == 0) { ((float*)(ws + OFF_INV0))[row] = sqrtf(ms); if (has2) ((float*)(ws + OFF_INV0))[row2] = sqrtf(ms2); }
#pragma unroll
        for (int j = 0; j < 4; ++j) { u32x2 w; w.x = cvtpk(v[j][0] * rs, v[j][1] * rs); w.y = cvtpk(v[j][2] * rs, v[j][3] * rs); *(u32x2*)(XB + (size_t)row * DM + 4 * lane + 256 * j) = w; }
        if (has2) {
#pragma unroll
            for (int j = 0; j < 4; ++j) { u32x2 w; w.x = cvtpk(v2[j][0] * rs2, v2[j][1] * rs2); w.y = cvtpk(v2[j][2] * rs2, v2[j][3] * rs2); *(u32x2*)(XB + (size_t)row2 * DM + 4 * lane + 256 * j) = w; }
        }
    }
    const int gt = blockIdx.x * 512 + tid, NGT = gridDim.x * 512;
    u64* ss = (u64*)(ws + OFF_SS);
    for (int i = gt; i < 4 * MP; i += NGT) ss[i] = 0ull;
    const float* gain0 = P.in[2];
    for (int ii = gt; ii < 64 * 64 * 8; ii += NGT) {
        const int i = ii >> 3, c = 2 * (ii & 7);
        const int g = i >> 6;
        const double dt = exp((double)P.in[6][g]);
        const double are = (double)P.in[4][i], aim = (double)P.in[5][i];
        const double mag = exp(dt * are), ang = dt * aim;
        const double kq = rint(ang * 0.15915494309189535), rr = ang - kq * 6.283185307179586;
        const double q = rr * 0.25, q2 = q * q;
        const double sn = q * (1.0 - q2 / 6.0 * (1.0 - q2 / 20.0 * (1.0 - q2 / 42.0 * (1.0 - q2 / 72.0 * (1.0 - q2 / 110.0 * (1.0 - q2 / 156.0 * (1.0 - q2 / 210.0)))))));
        const double cs = 1.0 - q2 / 2.0 * (1.0 - q2 / 12.0 * (1.0 - q2 / 30.0 * (1.0 - q2 / 56.0 * (1.0 - q2 / 90.0 * (1.0 - q2 / 132.0 * (1.0 - q2 / 182.0 * (1.0 - q2 / 240.0)))))));
        const double s2 = 2.0 * sn * cs, c2 = 1.0 - 2.0 * sn * sn;
        const double s4 = 2.0 * s2 * c2, c4 = 1.0 - 2.0 * s2 * s2;
        const double abr = mag * c4, abi = mag * s4;
        if (c == 0) { float* ab = (float*)(ws + S5_ABAR); ab[2 * i] = (float)abr; ab[2 * i + 1] = (float)abi; }
        const double den = are * are + aim * aim;
        const double cr = ((abr - 1.0) * are + abi * aim) / den, ci = (abi * are - (abr - 1.0) * aim) / den;
        bf16_t* bb = (bf16_t*)(ws + S5_BB);
        const int p = i & 63;
        const double g0 = gain0[g * 16 + c], g1 = gain0[g * 16 + c + 1];
        const double br0 = P.in[7][(size_t)i * 16 + c], bi0 = P.in[8][(size_t)i * 16 + c], br1 = P.in[7][(size_t)i * 16 + c + 1], bi1 = P.in[8][(size_t)i * 16 + c + 1];
        *(unsigned*)(bb + ((size_t)(g * 2 + 0) * 64 + p) * 16 + c) = cvtpk((float)((cr * br0 - ci * bi0) * g0), (float)((cr * br1 - ci * bi1) * g1));
        *(unsigned*)(bb + ((size_t)(g * 2 + 1) * 64 + p) * 16 + c) = cvtpk((float)((cr * bi0 + ci * br0) * g0), (float)((cr * bi1 + ci * br1) * g1));
    }
    for (int i = gt; i < 64 * 64 * 16; i += NGT) {
        const int gp = i >> 4, t = i & 15, g = gp >> 6, p = gp & 63, sh = p >> 5, nn = p & 31;
        const double dt = exp((double)P.in[6][g]);
        const double are = (double)P.in[4][gp], aim = (double)P.in[5][gp];
        const double mag = exp(dt * are), ang = dt * aim;
        const double kq = rint(ang * 0.15915494309189535), rr = ang - kq * 6.283185307179586;
        const double q = rr * 0.25, q2 = q * q;
        const double sn = q * (1.0 - q2 / 6.0 * (1.0 - q2 / 20.0 * (1.0 - q2 / 42.0 * (1.0 - q2 / 72.0 * (1.0 - q2 / 110.0 * (1.0 - q2 / 156.0 * (1.0 - q2 / 210.0)))))));
        const double cs = 1.0 - q2 / 2.0 * (1.0 - q2 / 12.0 * (1.0 - q2 / 30.0 * (1.0 - q2 / 56.0 * (1.0 - q2 / 90.0 * (1.0 - q2 / 132.0 * (1.0 - q2 / 182.0 * (1.0 - q2 / 240.0)))))));
        const double s2 = 2.0 * sn * cs, c2 = 1.0 - 2.0 * sn * sn;
        const double s4 = 2.0 * s2 * c2, c4 = 1.0 - 2.0 * s2 * s2;
        const double abr = mag * c4, abi = mag * s4;
        const double den = are * are + aim * aim;
        const double cr = ((abr - 1.0) * are + abi * aim) / den, ci = (abi * are - (abr - 1.0) * aim) / den;
        double pwr = 1.0, pwi = 0.0, br_ = abr, bi_ = abi; const int e = 15 - t;
#pragma unroll
        for (int bit = 0; bit < 4; ++bit) {
            if ((e >> bit) & 1) { const double nr = pwr * br_ - pwi * bi_, ni = pwr * bi_ + pwi * br_; pwr = nr; pwi = ni; }
            const double sr = br_ * br_ - bi_ * bi_, si = 2.0 * br_ * bi_; br_ = sr; bi_ = si;
        }
        const double fr = pwr * cr - pwi * ci, fi = pwr * ci + pwi * cr;
        bf16_t* w1 = (bf16_t*)(ws + OFF_W1);
#pragma unroll
        for (int h8 = 0; h8 < 2; ++h8) {
            unsigned wre[4], wim[4];
#pragma unroll
            for (int jp = 0; jp < 4; ++jp) {
                const int c = 8 * h8 + 2 * jp;
                const double g0 = gain0[g * 16 + c], g1 = gain0[g * 16 + c + 1];
                const double br0 = P.in[7][(size_t)gp * 16 + c], bi0 = P.in[8][(size_t)gp * 16 + c], br1 = P.in[7][(size_t)gp * 16 + c + 1], bi1 = P.in[8][(size_t)gp * 16 + c + 1];
                wre[jp] = cvtpk((float)((fr * br0 - fi * bi0) * g0), (float)((fr * br1 - fi * bi1) * g1));
                wim[jp] = cvtpk((float)((fr * bi0 + fi * br0) * g0), (float)((fr * bi1 + fi * br1) * g1));
            }
            u32x4 vre; vre.x = wre[0]; vre.y = wre[1]; vre.z = wre[2]; vre.w = wre[3];
            u32x4 vim; vim.x = wim[0]; vim.y = wim[1]; vim.z = wim[2]; vim.w = wim[3];
            *(u32x4*)(w1 + ((((size_t)(g * 16 + t) * 2 + 0) * 2 + sh) * 64 + nn + 32 * h8) * 8) = vre;
            *(u32x4*)(w1 + ((((size_t)(g * 16 + t) * 2 + 1) * 2 + sh) * 64 + nn + 32 * h8) * 8) = vim;
        }
    }
    for (int i = gt; i < 64 * 16 * 64 / 2; i += NGT) {
        const int e = 2 * i, g = e >> 10, cp = e & 1023;
        bf16_t* cb = (bf16_t*)(ws + S5_CB);
        *(unsigned*)(cb + (size_t)(g * 2 + 0) * 1024 + cp) = cvtpk(P.in[9][e], P.in[9][e + 1]);
        *(unsigned*)(cb + (size_t)(g * 2 + 1) * 1024 + cp) = cvtpk(-P.in[10][e], -P.in[10][e + 1]);
    }
    for (int i = gt; i < 1024; i += NGT) ((float*)(ws + S5_DG))[i] = P.in[11][i] * gain0[i];
}

#define MFMA32(a, b, c) __builtin_amdgcn_mfma_f32_32x32x16_bf16((a), (b), (c), 0, 0, 0)
__device__ __forceinline__ float gelu_tanh(float y) {
    const float t = 1.5957691216057308f * (y + 0.044715f * y * y * y);
    return y * frcp(1.f + __expf(-t));
}
__device__ __forceinline__ void s5_phase(const Ptrs& P, LAS unsigned char* lds) {
    int tid = threadIdx.x; asm volatile("" : "+v"(tid));
    const int lane = tid & 63, wid = __builtin_amdgcn_readfirstlane(tid >> 6), n = lane & 31, hh = lane >> 5;
    unsigned char* ws = P.ws;
    const bf16_t* XB = (const bf16_t*)(ws + OFF_XB);
    bf16_t* Z = (bf16_t*)(ws + OFF_ZQ);
    LAS unsigned char* wl = lds + wid * 9216;
    LAS unsigned char* uimg = wl + 8192;
    LAS f32x4* Ex = (LAS f32x4*)(lds + 8 * 9216);
    const int bs = (n >> 2) & 1, tk = (n & 3) + 4 * (n >> 3);
    for (int unit = blockIdx.x; unit < 256; unit += gridDim.x) {
        const int bp = unit >> 6, g = ((unit & 7) << 3) | ((unit >> 3) & 7);
        float ar[2], ai[2];
#pragma unroll
        for (int sh = 0; sh < 2; ++sh) { const float* ab = (const float*)(ws + S5_ABAR) + 2 * (g * 64 + 32 * sh + n); ar[sh] = ab[0]; ai[sh] = ab[1]; }
        bf16x8 Bop[2][2];
#pragma unroll
        for (int ri = 0; ri < 2; ++ri)
#pragma unroll
            for (int sh = 0; sh < 2; ++sh) {
                Bop[ri][sh] = *(const bf16x8*)((const bf16_t*)(ws + S5_BB) + ((size_t)(g * 2 + ri) * 64 + 32 * sh + n) * 16 + 8 * hh);
            }
#pragma unroll
        for (int ri = 0; ri < 2; ++ri)
#pragma unroll
            for (int sh = 0; sh < 2; ++sh) asm volatile("" :: "v"(Bop[ri][sh]));
        asm volatile("" :: "v"(ar[0]), "v"(ar[1]), "v"(ai[0]), "v"(ai[1]));
        const int c_beg = 32 * wid + (wid > 0 ? 1 : 0), c_end = c_beg + 32 + (wid == 0 ? 1 : 0);
        const size_t arow_real = (size_t)((2 * bp + bs) * SEQ + tk), arow_meta = (size_t)(MR + tk);
        const int acol = g * 16 + 8 * hh;
        f32x16 zero16;
#pragma unroll
        for (int i = 0; i < 16; ++i) zero16[i] = 0.f;
        float xr[2] = {0.f, 0.f}, xi[2] = {0.f, 0.f};
#define S5_LOADA(c) (*(const bf16x8*)(XB + ((c) == 0 ? arow_meta : arow_real + (size_t)16 * ((c) - 1)) * DM + acol))
        float p16r[2], p16i[2];
#pragma unroll
        for (int sh = 0; sh < 2; ++sh) {
            float cr = ar[sh], ci = ai[sh];
#pragma unroll
            for (int k = 0; k < 4; ++k) { const float t = cr * cr - ci * ci; ci = 2.f * cr * ci; cr = t; }
            p16r[sh] = cr; p16i[sh] = ci;
        }
        {
            if (wid == 0) {
                const bf16x8 a_cur = S5_LOADA(0);
                f32x16 bu[2][2];
#pragma unroll
                for (int ri = 0; ri < 2; ++ri)
#pragma unroll
                    for (int sh = 0; sh < 2; ++sh) bu[ri][sh] = MFMA32(a_cur, Bop[ri][sh], zero16);
#pragma unroll
                for (int r = 0; r < 16; ++r)
#pragma unroll
                    for (int sh = 0; sh < 2; ++sh) {
                        const float nr = ar[sh] * xr[sh] - ai[sh] * xi[sh] + bu[0][sh][r];
                        const float ni = ar[sh] * xi[sh] + ai[sh] * xr[sh] + bu[1][sh][r];
                        xr[sh] = nr; xi[sh] = ni;
                    }
            }
            const int c1 = wid == 0 ? 1 : c_beg;
            const bf16_t* W1g = (const bf16_t*)(ws + OFF_W1) + (size_t)g * (16 * 4 * 64 * 8) + lane * 8;
            for (int blk = 0; blk < 2; ++blk) {
                const bf16_t* ab = XB + ((size_t)((2 * bp + bs) * SEQ) + (size_t)16 * (c1 - 1 + 16 * blk + tk)) * DM + acol;
                f32x16 E00 = zero16, E01 = zero16, E10 = zero16, E11 = zero16;
#pragma unroll 4
                for (int t = 0; t < 16; ++t) {
                    const bf16x8 a = *(const bf16x8*)(ab + (size_t)t * DM);
                    const bf16_t* wp = W1g + (size_t)t * (4 * 64 * 8);
                    const bf16x8 b00 = *(const bf16x8*)(wp), b01 = *(const bf16x8*)(wp + 512), b10 = *(const bf16x8*)(wp + 1024), b11 = *(const bf16x8*)(wp + 1536);
                    E00 = MFMA32(a, b00, E00); E01 = MFMA32(a, b01, E01); E10 = MFMA32(a, b10, E10); E11 = MFMA32(a, b11, E11);
                }
#pragma unroll
                for (int r = 0; r < 16; ++r) {
                    { const float nr = p16r[0] * xr[0] - p16i[0] * xi[0] + E00[r], ni = p16r[0] * xi[0] + p16i[0] * xr[0] + E10[r]; xr[0] = nr; xi[0] = ni; }
                    { const float nr = p16r[1] * xr[1] - p16i[1] * xi[1] + E01[r], ni = p16r[1] * xi[1] + p16i[1] * xr[1] + E11[r]; xr[1] = nr; xi[1] = ni; }
                }
            }
        }
        Ex[wid * 64 + lane] = (f32x4){xr[0], xi[0], xr[1], xi[1]};
        __syncthreads();
        {
            float pr[2], pi[2];
#pragma unroll
            for (int sh = 0; sh < 2; ++sh) {
                float cr = p16r[sh], ci = p16i[sh];
#pragma unroll
                for (int k = 0; k < 5; ++k) { const float t = cr * cr - ci * ci; ci = 2.f * cr * ci; cr = t; }
                pr[sh] = cr; pi[sh] = ci;
            }
            xr[0] = xr[1] = xi[0] = xi[1] = 0.f;
            for (int v = 0; v < wid; ++v) {
                const f32x4 e = Ex[v * 64 + lane];
#pragma unroll
                for (int sh = 0; sh < 2; ++sh) {
                    float qr = pr[sh], qi = pi[sh];
                    if (v == 0) { const float t = qr * p16r[sh] - qi * p16i[sh]; qi = qr * p16i[sh] + qi * p16r[sh]; qr = t; }
                    const float nr = qr * xr[sh] - qi * xi[sh] + (sh == 0 ? e[0] : e[2]);
                    const float ni = qr * xi[sh] + qi * xr[sh] + (sh == 0 ? e[1] : e[3]);
                    xr[sh] = nr; xi[sh] = ni;
                }
            }
        }
        {
            bf16x8 Cop[2][2][2];
#pragma unroll
            for (int ri = 0; ri < 2; ++ri)
#pragma unroll
                for (int sh = 0; sh < 2; ++sh) {
#pragma unroll
                    for (int s = 0; s < 2; ++s) { bf16x8 cv = {0, 0, 0, 0, 0, 0, 0, 0};
                        if (n < 16) cv = *(const bf16x8*)((const bf16_t*)(ws + S5_CB) + ((size_t)(g * 2 + ri) * 16 + n) * 64 + 32 * sh + 16 * s + 8 * hh);
                        Cop[ri][sh][s] = cv; }
                    asm volatile("" :: "v"(Cop[ri][sh][0]), "v"(Cop[ri][sh][1]));
                }
            const int xsw = (n >> 1) & 7;
            const int trq = (lane & 15) >> 2, trc = 4 * ((lane >> 4) & 1) + (lane & 3);
            const unsigned tr_lo = (unsigned)(size_t)wl + (unsigned)((8 * hh + trq) * 64 + 8 * (trc ^ ((4 * hh + (trq >> 1)) & 7)));
            const unsigned tr_hi = (unsigned)(size_t)wl + (unsigned)((8 * hh + trq + 4) * 64 + 8 * (trc ^ ((4 * hh + (trq >> 1) + 2) & 7)));
            const float* Dg = (const float*)(ws + S5_DG) + g * 16 + 4 * hh;
            const f32x4 d_lo = *(const f32x4*)Dg, d_hi = *(const f32x4*)(Dg + 8);
            asm volatile("" :: "v"(d_lo), "v"(d_hi));
            const int cl = c_end - 1;
            auto body2 = [&](const bf16x8 a_cur, const int c) __attribute__((always_inline)) {
                *(LAS bf16x8*)(uimg + n * 32 + hh * 16) = a_cur;
                f32x16 bu[2][2];
#pragma unroll
                for (int ri = 0; ri < 2; ++ri)
#pragma unroll
                    for (int sh = 0; sh < 2; ++sh) bu[ri][sh] = MFMA32(a_cur, Bop[ri][sh], zero16);
#pragma unroll
                for (int r = 0; r < 16; ++r)
#pragma unroll
                    for (int sh = 0; sh < 2; ++sh) {
                        const float nr = ar[sh] * xr[sh] - ai[sh] * xi[sh] + bu[0][sh][r];
                        const float ni = ar[sh] * xi[sh] + ai[sh] * xr[sh] + bu[1][sh][r];
                        xr[sh] = nr; xi[sh] = ni; bu[0][sh][r] = nr; bu[1][sh][r] = ni;
                    }
#pragma unroll
                for (int ri = 0; ri < 2; ++ri)
#pragma unroll
                    for (int sh = 0; sh < 2; ++sh)
#pragma unroll
                        for (int q4 = 0; q4 < 4; ++q4) { u32x2 w; w.x = cvtpk(bu[ri][sh][4 * q4], bu[ri][sh][4 * q4 + 1]); w.y = cvtpk(bu[ri][sh][4 * q4 + 2], bu[ri][sh][4 * q4 + 3]);
                            *(LAS u32x2*)(wl + (ri * 2 + sh) * 2048 + n * 64 + 8 * ((2 * q4 + hh) ^ xsw)) = w; }
                s16x4 t0, t1, t2, t3, t4, t5, t6, t7, t8, t9, t10, t11, t12, t13, t14, t15;
#define S5_TRL(o, off) "ds_read_b64_tr_b16 %" #o ", %16 offset:" #off "\n\t"
#define S5_TRH(o, off) "ds_read_b64_tr_b16 %" #o ", %17 offset:" #off "\n\t"
                asm volatile("s_waitcnt lgkmcnt(0)\n\t"
                             S5_TRL(0, 0) S5_TRH(1, 0) S5_TRL(2, 1024) S5_TRH(3, 1024) S5_TRL(4, 2048) S5_TRH(5, 2048) S5_TRL(6, 3072) S5_TRH(7, 3072)
                             S5_TRL(8, 4096) S5_TRH(9, 4096) S5_TRL(10, 5120) S5_TRH(11, 5120) S5_TRL(12, 6144) S5_TRH(13, 6144) S5_TRL(14, 7168) S5_TRH(15, 7168)
                             "s_waitcnt lgkmcnt(0)"
                             : "=&v"(t0), "=&v"(t1), "=&v"(t2), "=&v"(t3), "=&v"(t4), "=&v"(t5), "=&v"(t6), "=&v"(t7), "=&v"(t8), "=&v"(t9), "=&v"(t10), "=&v"(t11), "=&v"(t12), "=&v"(t13), "=&v"(t14), "=&v"(t15)
                             : "v"(tr_lo), "v"(tr_hi) : "memory");
#undef S5_TRL
#undef S5_TRH
#define S5_CAT(a, b) __builtin_shufflevector(a, b, 0, 1, 2, 3, 4, 5, 6, 7)
                f32x16 y0 = MFMA32(Cop[0][0][0], S5_CAT(t0, t1), zero16);   y0 = MFMA32(Cop[0][0][1], S5_CAT(t2, t3), y0);
                f32x16 y1 = MFMA32(Cop[0][1][0], S5_CAT(t4, t5), zero16);   y1 = MFMA32(Cop[0][1][1], S5_CAT(t6, t7), y1);
                f32x16 y2 = MFMA32(Cop[1][0][0], S5_CAT(t8, t9), zero16);   y2 = MFMA32(Cop[1][0][1], S5_CAT(t10, t11), y2);
                f32x16 y3 = MFMA32(Cop[1][1][0], S5_CAT(t12, t13), zero16); y3 = MFMA32(Cop[1][1][1], S5_CAT(t14, t15), y3);
#undef S5_CAT
                const u32x2 u_lo = *(const LAS u32x2*)(uimg + n * 32 + 8 * hh), u_hi = *(const LAS u32x2*)(uimg + n * 32 + 16 + 8 * hh);
                float zz[8];
#pragma unroll
                for (int i = 0; i < 8; ++i) {
                    const unsigned uw = (i < 4) ? (i < 2 ? u_lo.x : u_lo.y) : (i < 6 ? u_hi.x : u_hi.y);
                    const float uf = (i & 1) ? __uint_as_float(uw & 0xffff0000u) : __uint_as_float(uw << 16);
                    const float dd = (i < 4) ? d_lo[i & 3] : d_hi[i & 3];
                    const float y = (y0[i] + y1[i]) + (y2[i] + y3[i]) + dd * uf;
                    zz[i] = gelu_tanh(y);
                }
                if (c > 0 || (bp == 0 && bs == 0)) {
                    const size_t orow = (c == 0) ? arow_meta : arow_real + (size_t)16 * (c - 1);
                    bf16_t* zp = Z + orow * DM + g * 16 + 4 * hh;
                    u32x2 w0, w1; w0.x = cvtpk(zz[0], zz[1]); w0.y = cvtpk(zz[2], zz[3]); w1.x = cvtpk(zz[4], zz[5]); w1.y = cvtpk(zz[6], zz[7]);
                    *(u32x2*)zp = w0; *(u32x2*)(zp + 8) = w1;
                }
            };
            bf16x8 r0 = S5_LOADA(c_beg), r1 = S5_LOADA(min(c_beg + 1, cl));
            for (int c = c_beg; c < c_end; c += 2) {
                body2(r0, c); r0 = S5_LOADA(min(c + 2, cl));
                if (c + 1 < c_end) { body2(r1, c + 1); r1 = S5_LOADA(min(c + 3, cl)); }
            }
        }
        __syncthreads();
    }
#undef S5_LOADA
}

#define XB_TMO      128
#define XB_XCNT(j)  (256  + 64 * (j))
#define XB_XSUB(j)  (1280 + 64 * (j))
#define XB_XGEN(j)  (2304 + 64 * (j))
#define XB_TOP      3328
#define XB_TOPGEN   3392
#define XCD_BAR_WORDS 3456
#define XB_SPIN_CAP (1u << 18)

__device__ __forceinline__ unsigned xb_ld(unsigned* p)              { return __hip_atomic_load(p, __ATOMIC_RELAXED, __HIP_MEMORY_SCOPE_AGENT); }
__device__ __forceinline__ unsigned xb_add(unsigned* p, unsigned v) { return __hip_atomic_fetch_add(p, v, __ATOMIC_RELAXED, __HIP_MEMORY_SCOPE_AGENT); }
__device__ __forceinline__ unsigned xb_xcc_id() { return (unsigned)__builtin_amdgcn_s_getreg((3 << 11) | 20) & 0xFu; }
#define XB_SPIN(cond, bar) do { unsigned _sp = 0; while (cond) { __builtin_amdgcn_s_sleep(1); \
    if ((++_sp & 255u) == 0u) { if (xb_ld(&(bar)[XB_TMO])) break; if (_sp > XB_SPIN_CAP) { atomicAdd(&(bar)[XB_TMO], 1u); break; } } } } while (0)

struct XcdBarrier {
    unsigned* bar; unsigned x;
    volatile LAS unsigned* st;
};

__device__ __forceinline__ XcdBarrier xcd_barrier_post(unsigned* bar, volatile LAS unsigned* st) {
    XcdBarrier b; b.bar = bar; b.x = xb_xcc_id(); b.st = st;
    if (threadIdx.x == 0) (void)xb_add(&bar[XB_XCNT(b.x)], 1u);
    return b;
}
__device__ __forceinline__ void xcd_barrier_complete(unsigned* bar, unsigned x, unsigned& nloc, unsigned& nx) {
    const unsigned G = gridDim.x * gridDim.y * gridDim.z;
    unsigned sum, cnt, mine, sp = 0u;
    for (;;) {
        sum = 0u; cnt = 0u; mine = 0u;
#pragma unroll
        for (unsigned j = 0; j < 16; ++j) { const unsigned c = xb_ld(&bar[XB_XCNT(j)]); sum += c; cnt += (c > 0u) ? 1u : 0u; mine = (j == x) ? c : mine; }
        if (sum == G) break;
        __builtin_amdgcn_s_sleep(1);
        if ((++sp & 255u) == 0u) { if (xb_ld(&bar[XB_TMO])) break; if (sp > XB_SPIN_CAP) { atomicAdd(&bar[XB_TMO], 1u); break; } }
    }
    nloc = mine > 0u ? mine : 1u; nx = cnt > 0u ? cnt : 1u;
}

__device__ __forceinline__ void xcd_barrier(const XcdBarrier& b) {
    asm volatile("s_waitcnt vmcnt(0)" ::: "memory");
    __syncthreads();
    if (threadIdx.x == 0) {
        unsigned* bar = b.bar;
        __builtin_amdgcn_s_waitcnt(0);
        unsigned nloc = b.st[0], nx = b.st[1];
        if (nloc == 0u) { xcd_barrier_complete(bar, b.x, nloc, nx); b.st[0] = nloc; b.st[1] = nx; }
        const unsigned old = xb_add(&bar[XB_XSUB(b.x)], 1u);
        const unsigned gen = old / nloc;
        if (old + 1u == (gen + 1u) * nloc) {
            __builtin_amdgcn_fence(__ATOMIC_RELEASE, "agent");
            asm volatile("s_waitcnt vmcnt(0)" ::: "memory");
            const unsigned og = xb_add(&bar[XB_TOP], 1u);
            const unsigned tg = og / nx;
            if (og + 1u == (tg + 1u) * nx) xb_add(&bar[XB_TOPGEN], 1u);
            else XB_SPIN(xb_ld(&bar[XB_TOPGEN]) == tg, bar);
            __builtin_amdgcn_fence(__ATOMIC_ACQUIRE, "agent");
            xb_add(&bar[XB_XGEN(b.x)], 1u);
            asm volatile("s_waitcnt vmcnt(0)" ::: "memory");
        } else {
            XB_SPIN(xb_ld(&bar[XB_XGEN(b.x)]) == gen, bar);
            __builtin_amdgcn_fence(__ATOMIC_ACQUIRE, "agent");
            asm volatile("s_waitcnt vmcnt(0)" ::: "memory");
        }
    }
    __syncthreads();
}

constexpr float AT_STOP = 5.421011e-20f;
__device__ __forceinline__ void attn_phase(const Ptrs& P, LAS unsigned char* lds, bf16_t* Oout) {
    int tid = threadIdx.x; asm volatile("" : "+v"(tid));
    const int lane = tid & 63, wid = __builtin_amdgcn_readfirstlane(tid >> 6), n = lane & 31, hh = lane >> 5;
    unsigned char* ws = P.ws;
    const bf16_t* KB = (const bf16_t*)(ws + OFF_KB);
    const bf16_t* VB = (const bf16_t*)(ws + OFF_VT);
    bf16_t* QO = (bf16_t*)(ws + OFF_ZQ);
    LAS unsigned char* Kl = lds + wid * 10752;
    LAS unsigned char* Vl = Kl + 4608;
    const int lrow = 4 * (lane >> 3), lchk = lane & 7;
    LAS unsigned char* kst = Kl + lrow * 144 + lchk * 16;
    LAS unsigned char* vst = Vl + lrow * 192 + lchk * 16;
    const LAS unsigned char* kfr = Kl + n * 144 + 16 * hh;
    const unsigned vtr = (unsigned)(size_t)Vl + (unsigned)((4 * hh + ((lane & 15) >> 2)) * 192 + 32 * ((lane >> 4) & 1) + 8 * (lane & 3));
    const int vcu = (gridDim.x % 8 == 0) ? (blockIdx.x % 8) * (gridDim.x / 8) + blockIdx.x / 8 : blockIdx.x;
    const int gw = vcu * 8 + wid, NGW = gridDim.x * 8;
    constexpr int NREAL = NB * NHEAD * 128;
    for (int u = gw; u < NREAL; u += NGW) {
        constexpr bool metaq = false;
        const int qt = metaq ? -1 : (u & 127), h = metaq ? (u - NREAL) : ((u >> 7) & 15), b = metaq ? 0 : (u >> 11);
        const int qrow0 = metaq ? MR : b * SEQ + 32 * qt;
        auto issue = [&](u32x4& k0, u32x4& k1, u32x4& k2, u32x4& k3, u32x4& v0, u32x4& v1, u32x4& v2, u32x4& v3, const int kt_) __attribute__((always_inline)) {
            const int krow0 = kt_ >= 0 ? b * SEQ + 32 * kt_ : MR;
            const size_t off = (size_t)(krow0 + lrow + 2) * DM + h * 64 + lchk * 8;
            const bf16_t* kp = KB + off; const bf16_t* vp = VB + off;
            asm volatile("global_load_dwordx4 %0, %8, off offset:-4096\n\t"
                         "global_load_dwordx4 %1, %8, off offset:-2048\n\t"
                         "global_load_dwordx4 %2, %8, off\n\t"
                         "global_load_dwordx4 %3, %8, off offset:2048\n\t"
                         "global_load_dwordx4 %4, %9, off offset:-4096\n\t"
                         "global_load_dwordx4 %5, %9, off offset:-2048\n\t"
                         "global_load_dwordx4 %6, %9, off\n\t"
                         "global_load_dwordx4 %7, %9, off offset:2048"
                         : "=&v"(k0), "=&v"(k1), "=&v"(k2), "=&v"(k3), "=&v"(v0), "=&v"(v1), "=&v"(v2), "=&v"(v3)
                         : "v"(kp), "v"(vp) : "memory");
        };
        u32x4 ak0, ak1, ak2, ak3, av0, av1, av2, av3;
#define AT_PREV(k) ((k) > 0 ? (k) - 1 : -1)
        int kt = qt;
        issue(ak0, ak1, ak2, ak3, av0, av1, av2, av3, kt);
        bf16x8 qf[4];
#pragma unroll
        for (int s = 0; s < 4; ++s) qf[s] = *(const bf16x8*)(QO + (size_t)(qrow0 + n) * DM + h * 64 + 16 * s + 8 * hh);
        asm volatile("" :: "v"(qf[0]), "v"(qf[1]), "v"(qf[2]), "v"(qf[3]));
        f32x16 o0, o1;
#pragma unroll
        for (int i = 0; i < 16; ++i) { o0[i] = 0.f; o1[i] = 0.f; }
        float Rl = 1.f;
        const int metalim = metaq ? (n < 16 ? n : 16) : 16;
        auto stage = [&](const u32x4& k0, const u32x4& k1, const u32x4& k2, const u32x4& k3, const u32x4& v0, const u32x4& v1, const u32x4& v2, const u32x4& v3) __attribute__((always_inline)) {
            *(LAS u32x4*)(kst) = k0; *(LAS u32x4*)(kst + 144) = k1; *(LAS u32x4*)(kst + 288) = k2; *(LAS u32x4*)(kst + 432) = k3;
            *(LAS u32x4*)(vst) = v0; *(LAS u32x4*)(vst + 192) = v1; *(LAS u32x4*)(vst + 384) = v2; *(LAS u32x4*)(vst + 576) = v3;
        };
        auto compute = [&](const int kt_, auto MT) __attribute__((always_inline)) -> bool {
            constexpr bool MASKED = decltype(MT)::value;
            f32x16 z;
#pragma unroll
            for (int i = 0; i < 16; ++i) z[i] = 0.f;
#pragma unroll
            for (int s = 0; s < 4; ++s) z = MFMA32(*(const LAS bf16x8*)(kfr + 32 * s), qf[s], z);
            const int lim = kt_ < 0 ? metalim : n;
            f32x2_t be[8], om[8];
#pragma unroll
            for (int p = 0; p < 8; ++p) {
                f32x2_t e; e.x = __builtin_amdgcn_exp2f(z[2 * p]); e.y = __builtin_amdgcn_exp2f(z[2 * p + 1]);
                const f32x2_t d = e + 1.0f;
                f32x2_t bt; bt.x = frcp(d.x); bt.y = frcp(d.y);
                f32x2_t o1m = 1.0f - bt;
                if (MASKED) {
                    const int j0 = ((2 * p) & 3) + 8 * ((2 * p) >> 2) + 4 * hh;
                    if (!(j0 < lim)) { bt.x = 0.f; o1m.x = 1.f; }
                    if (!(j0 + 1 < lim)) { bt.y = 0.f; o1m.y = 1.f; }
                }
                be[p] = bt; om[p] = o1m;
            }
            float qp[4], th[4];
#pragma unroll
            for (int a = 0; a < 4; ++a) { const f32x2_t t = om[2 * a] * om[2 * a + 1]; qp[a] = t.x * t.y; th[a] = __shfl_xor(qp[a], 32); }
            float G[8];
#pragma unroll
            for (int a = 0; a < 4; ++a) { G[2 * a] = hh ? th[a] : qp[a]; G[2 * a + 1] = hh ? qp[a] : th[a]; }
            const float sf7 = 1.f, sf6 = G[7], sf5 = sf6 * G[6], sf4 = sf5 * G[5], sf3 = sf4 * G[4], sf2 = sf3 * G[3], sf1 = sf2 * G[2], sf0 = sf1 * G[1];
            const float total = sf0 * G[0];
            const float sm0 = hh ? sf1 : sf0, sm1 = hh ? sf3 : sf2, sm2 = hh ? sf5 : sf4, sm3 = hh ? sf7 : sf6;
            f32x2_t w[8];
#define AT_W(a, SM) do { const float e3 = Rl * (SM), e2 = e3 * om[2 * (a) + 1].y, e1 = e2 * om[2 * (a) + 1].x, e0 = e1 * om[2 * (a)].y; \
                w[2 * (a)] = be[2 * (a)] * (f32x2_t){e0, e1}; w[2 * (a) + 1] = be[2 * (a) + 1] * (f32x2_t){e2, e3}; } while (0)
            AT_W(0, sm0); AT_W(1, sm1); AT_W(2, sm2); AT_W(3, sm3);
#undef AT_W
            Rl *= total;
            s16x4 t0, t1, t2, t3, t4, t5, t6, t7;
            asm volatile("ds_read_b64_tr_b16 %0, %8\n\t"
                         "ds_read_b64_tr_b16 %1, %8 offset:1536\n\t"
                         "ds_read_b64_tr_b16 %2, %8 offset:3072\n\t"
                         "ds_read_b64_tr_b16 %3, %8 offset:4608\n\t"
                         "ds_read_b64_tr_b16 %4, %8 offset:64\n\t"
                         "ds_read_b64_tr_b16 %5, %8 offset:1600\n\t"
                         "ds_read_b64_tr_b16 %6, %8 offset:3136\n\t"
                         "ds_read_b64_tr_b16 %7, %8 offset:4672\n\t"
                         "s_waitcnt lgkmcnt(0)"
                         : "=&v"(t0), "=&v"(t1), "=&v"(t2), "=&v"(t3), "=&v"(t4), "=&v"(t5), "=&v"(t6), "=&v"(t7) : "v"(vtr) : "memory");
#define AT_CAT(a, b) __builtin_shufflevector(a, b, 0, 1, 2, 3, 4, 5, 6, 7)
            {
                u32x4 pw; pw.x = cvtpk(w[0].x, w[0].y); pw.y = cvtpk(w[1].x, w[1].y); pw.z = cvtpk(w[2].x, w[2].y); pw.w = cvtpk(w[3].x, w[3].y);
                const bf16x8 pf = __builtin_bit_cast(bf16x8, pw);
                o0 = MFMA32(AT_CAT(t0, t1), pf, o0); o1 = MFMA32(AT_CAT(t4, t5), pf, o1);
            }
            {
                u32x4 pw; pw.x = cvtpk(w[4].x, w[4].y); pw.y = cvtpk(w[5].x, w[5].y); pw.z = cvtpk(w[6].x, w[6].y); pw.w = cvtpk(w[7].x, w[7].y);
                const bf16x8 pf = __builtin_bit_cast(bf16x8, pw);
                o0 = MFMA32(AT_CAT(t2, t3), pf, o0); o1 = MFMA32(AT_CAT(t6, t7), pf, o1);
            }
#undef AT_CAT
            return kt_ < 0 || __all(Rl < AT_STOP);
        };
#define AT_COMPUTE(kt_) (((kt_) < 0 || (kt_) == qt) ? compute((kt_), std::true_type{}) : compute((kt_), std::false_type{}))
#define AT_WAIT(N, k0, k1, k2, k3, v0, v1, v2, v3) asm volatile("s_waitcnt vmcnt(" #N ")" : "+v"(k0), "+v"(k1), "+v"(k2), "+v"(k3), "+v"(v0), "+v"(v1), "+v"(v2), "+v"(v3) :: "memory")
        for (;;) {
            AT_WAIT(0, ak0, ak1, ak2, ak3, av0, av1, av2, av3);
            stage(ak0, ak1, ak2, ak3, av0, av1, av2, av3);
            issue(ak0, ak1, ak2, ak3, av0, av1, av2, av3, AT_PREV(kt));
            if (AT_COMPUTE(kt)) break;
            kt = AT_PREV(kt);
        }
#undef AT_PREV
#undef AT_COMPUTE
        AT_WAIT(0, ak0, ak1, ak2, ak3, av0, av1, av2, av3);
#undef AT_WAIT
        if (!metaq || n < 16) {
            bf16_t* op = Oout + (size_t)(qrow0 + n) * DM + h * 64 + 4 * hh;
#pragma unroll
            for (int a = 0; a < 4; ++a) {
                u32x2 w0; w0.x = cvtpk(o0[4 * a], o0[4 * a + 1]); w0.y = cvtpk(o0[4 * a + 2], o0[4 * a + 3]);
                u32x2 w1; w1.x = cvtpk(o1[4 * a], o1[4 * a + 1]); w1.y = cvtpk(o1[4 * a + 2], o1[4 * a + 3]);
                *(u32x2*)(op + 8 * a) = w0; *(u32x2*)(op + 32 + 8 * a) = w1;
            }
        }
    }
}

__device__ __forceinline__ void final_phase(const Ptrs& P) {
    int tid = threadIdx.x; asm volatile("" : "+v"(tid));
    const int lane = tid & 63, wid = tid >> 6;
    const bf16_t* XB = (const bf16_t*)(P.ws + OFF_XB);
    const u64* ss3 = (const u64*)(P.ws + OFF_SS) + 3 * MP;
    const float* gain = P.in[19];
    f32x4 gv[4];
#pragma unroll
    for (int j = 0; j < 4; ++j) gv[j] = *(const f32x4*)(gain + 4 * lane + 256 * j);
    const int gw = blockIdx.x * 8 + wid, NGW = gridDim.x * 8;
    for (int row = gw; row < MR; row += NGW) {
        const float rs = rstd_of(ss3[row]);
#pragma unroll
        for (int j = 0; j < 4; ++j) { const u32x2 hb = __builtin_nontemporal_load((const u32x2*)(XB + (size_t)row * DM + 4 * lane + 256 * j));
            const f32x4 v = {__uint_as_float(hb.x << 16), __uint_as_float(hb.x & 0xffff0000u), __uint_as_float(hb.y << 16), __uint_as_float(hb.y & 0xffff0000u)};
            __builtin_nontemporal_store(v * rs * gv[j], (f32x4*)(P.out + (size_t)row * DM + 4 * lane + 256 * j)); }
    }
}

#ifndef REP_P0
#define REP_P0 1
#endif
#ifndef REP_S5
#define REP_S5 1
#endif
#ifndef REP_ATT
#define REP_ATT 1
#endif
#ifndef REP_SYNC
#define REP_SYNC 0
#endif
#ifndef REP_FI
#define REP_FI 1
#endif
#ifndef REP_FI_CHEAP
#define REP_FI_CHEAP 0
#endif
#ifndef REP_FIN
#define REP_FIN 1
#endif
constexpr int LDS_BYTES = 131072 + 256;
__global__ void __launch_bounds__(512, 2) s5yoco_fwd(Ptrs P) {
    extern __shared__ __attribute__((aligned(16))) unsigned char lds_raw[];
    LAS unsigned char* lds = (LAS unsigned char*)lds_raw;
    cg::grid_group grid = cg::this_grid();
    unsigned char* ws = P.ws;
    u64* ss = (u64*)(ws + OFF_SS);
    bf16_t* XB = (bf16_t*)(ws + OFF_XB); float* H = (float*)(ws + OFF_H); bf16_t* ZQ = (bf16_t*)(ws + OFF_ZQ); bf16_t* ACT = (bf16_t*)(ws + OFF_ACT);
    const int G = gridDim.x, c = blockIdx.x;
    StaticOrder S;
    volatile LAS unsigned* bst = (volatile LAS unsigned*)(lds + 131072);
    if (threadIdx.x < 2) bst[threadIdx.x] = 0u;
    __syncthreads();
    const XcdBarrier gbar = xcd_barrier_post((unsigned*)(ws + OFF_BAR), bst);
    if (ws == nullptr) grid.sync();
#define GSYNC() xcd_barrier(gbar)

#if REP_P0 >= 2
    p0_prologue(P, lds);
#endif
    p0_prologue(P, lds);
    GSYNC();
    for (int rep = 0; rep < REP_S5; ++rep) s5_phase(P, lds);
    GSYNC();
    bf16_t* KBp = (bf16_t*)(ws + OFF_KB); bf16_t* VTp = (bf16_t*)(ws + OFF_VT);
    {
        S.init(MR, 2048, G, c);
        EpiGLU E{(const float*)(ws + OFF_INV0), XB, ss};
        pg8::gemm_phase<EpiGLU, StaticOrder, true, true>(lds, Gemm{ZQ, (const bf16_t*)(ws + W_GLU), MR, 2048, 1024}, S, E);
        meta_gemm<0, true, 1024>(lds, ZQ + (size_t)MR * DM, (const bf16_t*)(ws + W_GLU), 64, P.in[1], H, XB, nullptr, nullptr, nullptr, ss, nullptr);
    }
    GSYNC();
    {
        S.init(MR, 5632, G, c);
#if REP_FI_CHEAP
        { EpiSwiGLU<true> Ec{ss, ACT}; pg8::gemm_phase<EpiSwiGLU<true>, StaticOrder, true, true>(lds, Gemm{XB, (const bf16_t*)(ws + W_FI0), MR, 5632, 1024}, S, Ec); }
#endif
        EpiSwiGLU<false> E{ss, ACT};
#if REP_FI >= 2
        pg8::gemm_phase<EpiSwiGLU<false>, StaticOrder, true, true>(lds, Gemm{XB, (const bf16_t*)(ws + W_FI0), MR, 5632, 1024}, S, E);
#endif
        pg8::gemm_phase<EpiSwiGLU<false>, StaticOrder, true, true>(lds, Gemm{XB, (const bf16_t*)(ws + W_FI0), MR, 5632, 1024}, S, E);
        meta_gemm<1, false, 1024>(lds, XB + (size_t)MR * DM, (const bf16_t*)(ws + W_FI0), 176, nullptr, nullptr, nullptr, ACT, nullptr, nullptr, nullptr, ss);
    }
    GSYNC();
    {
        S.init(MR, 1024, G, c);
        EpiResid<true> E{XB, ss + MP};
        pg8::gemm_phase<EpiResid<true>, StaticOrder, true, true>(lds, Gemm{ACT, (const bf16_t*)(ws + W_FO0), MR, 1024, DFF}, S, E);
        meta_gemm<2, true, DFF>(lds, ACT + (size_t)MR * DFF, (const bf16_t*)(ws + W_FO0), 64, nullptr, H, XB, nullptr, nullptr, nullptr, ss + MP, nullptr);
    }
    GSYNC();
    {
        S.init(MR, 3072, G, c);
        EpiKQ E{ss + MP, ZQ};
        pg8::gemm_phase<EpiKQ, StaticOrder, true, true>(lds, Gemm{XB, (const bf16_t*)(ws + W_KQ), MR, 3072, 1024}, S, E);
        meta_gemm<3, false, 1024>(lds, XB + (size_t)MR * DM, (const bf16_t*)(ws + W_KQ), 192, nullptr, nullptr, nullptr, KBp, ZQ, VTp, nullptr, ss + MP);
    }
    GSYNC();
    for (int rep = 1; rep < REP_ATT; ++rep) attn_phase(P, lds, (bf16_t*)(ws + OFF_H));
    attn_phase(P, lds, ZQ);
    GSYNC();
    {
        S.init(MR, 1024, G, c);
        EpiResid<true> E{XB, ss + 2 * MP};
        pg8::gemm_phase<EpiResid<true>, StaticOrder, true, true>(lds, Gemm{ZQ, (const bf16_t*)(ws + W_O), MR, 1024, 1024}, S, E);
    }
    GSYNC();
    {
        S.init(MR, 5632, G, c);
        EpiSwiGLU<false> E{ss + 2 * MP, ACT};
        pg8::gemm_phase<EpiSwiGLU<false>, StaticOrder, true, true>(lds, Gemm{XB, (const bf16_t*)(ws + W_FI1), MR, 5632, 1024}, S, E);
    }
    GSYNC();
    {
        S.init(MR, 1024, G, c);
        EpiResid<false> E{XB, ss + 3 * MP};
        pg8::gemm_phase<EpiResid<false>, StaticOrder, true, true>(lds, Gemm{ACT, (const bf16_t*)(ws + W_FO1), MR, 1024, DFF}, S, E);
    }
    GSYNC();
    for (int rep = 0; rep < REP_SYNC; ++rep) GSYNC();
    for (int rep = 0; rep < REP_FIN; ++rep) final_phase(P);
}

extern "C" void kernel_launch(void* const* d_in, const int* in_sizes, int n_in, void* d_out, int out_size, void* d_ws, size_t ws_size, hipStream_t stream) {
    static int grid = 0;
    if (grid == 0) {
        if (n_in != 20 || ws_size < WS_END) { fprintf(stderr, "kernel_launch: unexpected problem (n_in %d, ws %zu < %zu)\n", n_in, ws_size, (size_t)WS_END); grid = -1; return; }
        int dev = 0, cus = 0, per_cu = 0;
        hipGetDevice(&dev);
        hipDeviceGetAttribute(&cus, hipDeviceAttributeMultiprocessorCount, dev);
        if (hipFuncSetAttribute((const void*)s5yoco_fwd, hipFuncAttributeMaxDynamicSharedMemorySize, LDS_BYTES) != hipSuccess) { fprintf(stderr, "kernel_launch: hipFuncSetAttribute failed\n"); grid = -1; return; }
        if (hipOccupancyMaxActiveBlocksPerMultiprocessor(&per_cu, (const void*)s5yoco_fwd, 512, LDS_BYTES) != hipSuccess || per_cu < 1) { fprintf(stderr, "kernel_launch: occupancy query says %d\n", per_cu); per_cu = 1; }
        (void)hipGetLastError();
        grid = cus;
    }
    if (grid < 0) return;
    if (hipMemsetAsync((char*)d_ws + OFF_BAR, 0, 16384, stream) != hipSuccess) { fprintf(stderr, "kernel_launch: memset failed\n"); return; }
    Ptrs p{};
    for (int i = 0; i < 20; ++i) p.in[i] = (const float*)d_in[i];
    p.out = (float*)d_out; p.ws = (unsigned char*)d_ws;
    void* args[] = {&p};
    hipError_t e = hipLaunchCooperativeKernel((const void*)s5yoco_fwd, dim3(grid), dim3(512), args, LDS_BYTES, stream);
    if (e != hipSuccess) fprintf(stderr, "cooperative launch failed: %s (grid %d)\n", hipGetErrorString(e), grid);
}
```

```cpp
#include <hip/hip_runtime.h>
#include <hip/hip_cooperative_groups.h>
#include <cstdio>
#include <cstdint>
#include <type_traits>
namespace cg = cooperative_groups;
namespace pg8 {
#define PG8_LAS __attribute__((address_space(3)))
typedef unsigned short bf16_t;
typedef short bf16x8 __attribute__((ext_vector_type(8)));
typedef float f32x4 __attribute__((ext_vector_type(4)));
typedef unsigned u32x4 __attribute__((ext_vector_type(4)));
constexpr int BM = 256, BK = 64, HALF = 128, HTB = HALF * BK * 2  , STAGE_BYTES = 8 * HTB, NXCD = 8, WGM = 8;

__host__ __device__ __forceinline__ int lds_byte(int r, int c) { const int st = (r >> 4) * 2 + (c >> 5), rr = r & 15, cc = c & 31, ob = rr * 64 + cc * 2; return st * 1024 + (ob ^ (((ob >> 9) & 1) << 5)); }
__host__ __device__ __forceinline__ void stage_rc(int b, int& R, int& C) { const int st = b / 1024, sb = b % 1024, swz = sb ^ (((sb >> 9) & 1) << 5); R = (st >> 1) * 16 + swz / 64; C = (st & 1) * 32 + (swz % 64) / 2; }
__host__ __device__ __forceinline__ int perm32(int rho) { const int n = rho >> 4, i = rho & 15; return 8 * (i >> 2) + 4 * n + (i & 3); }

struct Unit { int pm, pn; };
struct Gemm { const bf16_t* A; const bf16_t* Bt; int M, N, K; };

struct StaticOrder {
    int nM, nN, nwg, G, c;
    __host__ __device__ void init(int M, int N, int G_, int c_) { nM = M / BM; nN = N / BM; nwg = nM * nN; G = G_; c = c_; }
    __host__ __device__ bool next(int i, Unit& u) const {
        const long L = (long)i * G + c; if (L >= nwg) return false;
        int wgid = (int)L; { const int q = nwg / NXCD, r = nwg % NXCD, xcd = wgid % NXCD, off = wgid / NXCD; wgid = (xcd < r ? xcd * (q + 1) : r * (q + 1) + (xcd - r) * q) + off; }
        const int nig = WGM * nN, gid = wgid / nig, fm = gid * WGM, gsz = (nM - fm) < WGM ? (nM - fm) : WGM;
        u.pm = fm + ((wgid % nig) % gsz); u.pn = (wgid % nig) / gsz; return true;
    }
    __device__ __forceinline__ void a_ready(const Unit&) const {}
    __device__ __forceinline__ void done(const Unit&) const {}
};
typedef float f32x2 __attribute__((ext_vector_type(2)));

template <class Epi, class Sched, bool ALIGN_EPI = false, bool SP2 = false>
__device__ __forceinline__ void gemm_phase(PG8_LAS unsigned char* lds, const Gemm g, const Sched& S, const Epi& E) {
    const int tid = threadIdx.x, wid = __builtin_amdgcn_readfirstlane(tid >> 6), lane = tid & 63, wr = wid >> 2, wc = wid & 3, fr = lane & 15, fq = lane >> 4;
    const int K = g.K, nt = K / BK;
    unsigned voffA[2], voffB[2];
#pragma unroll
    for (int i = 0; i < 2; ++i) { int R, C; stage_rc(tid * 16 + i * 8192, R, C); const int Rb = Epi::PERM ? ((R & ~31) + perm32(R & 31)) : R;
        voffA[i] = (unsigned)(R * K + C) * 2u; voffB[i] = (unsigned)(Rb * K + C) * 2u; }
    const size_t kstep = (size_t)(BK * 2);
    const size_t hstep = (size_t)HALF * K * 2;
    const size_t tstep = 2 * hstep;
    const unsigned ldsw = (unsigned)wid * 1024u;
    const int aoff = lds_byte(wr * 64 + fr, fq * 8), boff = lds_byte(wc * 32 + fr, fq * 8);
#define PG8_SA(b, h) (((b) * 2 + (h)) * HTB)
#define PG8_SB(b, h) ((4 + (b) * 2 + (h)) * HTB)
#define PG8_STAGE(bufoff, gbase, voff) do { _Pragma("unroll") for (int _i = 0; _i < 2; ++_i) \
        __builtin_amdgcn_global_load_lds((const unsigned*)((const char*)(gbase) + (voff)[_i]), (PG8_LAS unsigned*)(lds + (bufoff) + ldsw + _i * 8192), 16, 0, 0); } while (0)
#define PG8_LDA(dst, b, h) do { _Pragma("unroll") for (int m = 0; m < 4; ++m) _Pragma("unroll") for (int k = 0; k < 2; ++k) dst[m][k] = *(const PG8_LAS bf16x8*)(lds + PG8_SA(b, h) + aoff + m * 2048 + k * 1024); } while (0)
#define PG8_LDB(dst, b, h) do { _Pragma("unroll") for (int n = 0; n < 2; ++n) _Pragma("unroll") for (int k = 0; k < 2; ++k) dst[n][k] = *(const PG8_LAS bf16x8*)(lds + PG8_SB(b, h) + boff + n * 2048 + k * 1024); } while (0)
#define PG8_MMA(ai, bj, At, Bt) do { __builtin_amdgcn_s_setprio(1); _Pragma("unroll") for (int m = 0; m < 4; ++m) _Pragma("unroll") for (int n = 0; n < 2; ++n) _Pragma("unroll") for (int k = 0; k < 2; ++k) \
        acc[ai][bj][m][n] = __builtin_amdgcn_mfma_f32_16x16x32_bf16(Bt[n][k], At[m][k], acc[ai][bj][m][n], 0, 0, 0); __builtin_amdgcn_s_setprio(0); } while (0)
#define PG8_WAIT_V(n) asm volatile("s_waitcnt vmcnt(" #n ")" ::: "memory")
#define PG8_WAIT_L(n) asm volatile("s_waitcnt lgkmcnt(" #n ")" ::: "memory")
#define PG8_BAR __builtin_amdgcn_s_barrier()
#define PG8_SCHED __builtin_amdgcn_sched_barrier(0)
    Unit cur, nxt; int ui = 0;
    if (!S.next(0, cur)) return;
    f32x4 acc[2][2][4][2];
#pragma unroll
    for (int a = 0; a < 2; ++a)
#pragma unroll
        for (int b = 0; b < 2; ++b)
#pragma unroll
            for (int m = 0; m < 4; ++m)
#pragma unroll
                for (int n = 0; n < 2; ++n) acc[a][b][m][n] = (f32x4){0.f, 0.f, 0.f, 0.f};
    bf16x8 At[4][2], B0[2][2], B1[2][2];
    const char* cA = (const char*)g.A + (size_t)cur.pm * tstep; const char* cB = (const char*)g.Bt + (size_t)cur.pn * tstep;
    S.a_ready(cur);
    if constexpr (SP2) {
        PG8_STAGE(PG8_SB(0, 0), cB, voffB); PG8_STAGE(PG8_SB(0, 1), cB + hstep, voffB); PG8_STAGE(PG8_SA(0, 0), cA, voffA); PG8_STAGE(PG8_SA(0, 1), cA + hstep, voffA);
        if (wr == 1) PG8_BAR;
        PG8_WAIT_V(2); PG8_BAR;
        PG8_STAGE(PG8_SB(1, 0), cB + kstep, voffB); PG8_STAGE(PG8_SA(1, 0), cA + kstep, voffA); PG8_STAGE(PG8_SB(1, 1), cB + hstep + kstep, voffB);
        PG8_WAIT_V(6); PG8_BAR;
    } else {
        PG8_STAGE(PG8_SB(0, 0), cB, voffB); PG8_STAGE(PG8_SA(0, 0), cA, voffA); PG8_STAGE(PG8_SB(0, 1), cB + hstep, voffB); PG8_STAGE(PG8_SA(0, 1), cA + hstep, voffA);
        if (wr == 1) PG8_BAR;
        PG8_WAIT_V(4); PG8_BAR;
        PG8_STAGE(PG8_SB(1, 0), cB + kstep, voffB); PG8_STAGE(PG8_SA(1, 0), cA + kstep, voffA); PG8_STAGE(PG8_SB(1, 1), cB + hstep + kstep, voffB);
        PG8_WAIT_V(6); PG8_BAR;
    }
    for (;;) {
        const bool has_next = S.next(ui + 1, nxt);
        const char* nA = has_next ? (const char*)g.A + (size_t)nxt.pm * tstep : cA; const char* nB = has_next ? (const char*)g.Bt + (size_t)nxt.pn * tstep : cB;
        for (int t = 0; t < nt; t += 2) {
            const bool last = (t == nt - 2);
            const char* a1 = cA + (size_t)(t + 1) * kstep;
            const char* a2 = last ? nA : cA + (size_t)(t + 2) * kstep; const char* b2 = last ? nB : cB + (size_t)(t + 2) * kstep;
            const char* a3 = a2 + kstep; const char* b3 = b2 + kstep;
            if (last && has_next) S.a_ready(nxt);
            if constexpr (SP2) {
            PG8_LDB(B0, 0, 0); PG8_LDB(B1, 0, 1); PG8_SCHED; PG8_LDA(At, 0, 0); PG8_STAGE(PG8_SA(1, 1), a1 + hstep, voffA);
            PG8_WAIT_V(8); PG8_WAIT_L(0); PG8_BAR; PG8_MMA(0, 0, At, B0); PG8_MMA(0, 1, At, B1); PG8_BAR; PG8_SCHED;
            PG8_LDA(At, 0, 1); PG8_STAGE(PG8_SB(0, 0), b2, voffB); PG8_STAGE(PG8_SB(0, 1), b2 + hstep, voffB); PG8_STAGE(PG8_SA(0, 0), a2, voffA);
            PG8_WAIT_V(8); PG8_WAIT_L(0); PG8_BAR; PG8_MMA(1, 0, At, B0); PG8_MMA(1, 1, At, B1); PG8_BAR; PG8_SCHED;
            PG8_LDB(B0, 1, 0); PG8_LDB(B1, 1, 1); PG8_SCHED; PG8_LDA(At, 1, 0); PG8_STAGE(PG8_SA(0, 1), a2 + hstep, voffA);
            PG8_WAIT_V(8); PG8_WAIT_L(0); PG8_BAR; PG8_MMA(0, 0, At, B0); PG8_MMA(0, 1, At, B1); PG8_BAR; PG8_SCHED;
            PG8_LDA(At, 1, 1); PG8_STAGE(PG8_SB(1, 0), b3, voffB); PG8_STAGE(PG8_SB(1, 1), b3 + hstep, voffB); PG8_STAGE(PG8_SA(1, 0), a3, voffA);
            PG8_WAIT_V(8); PG8_WAIT_L(0); PG8_BAR; PG8_MMA(1, 0, At, B0); PG8_MMA(1, 1, At, B1); PG8_BAR; PG8_SCHED;
            } else {
            PG8_LDB(B0, 0, 0); PG8_SCHED; PG8_LDA(At, 0, 0); PG8_STAGE(PG8_SA(1, 1), a1 + hstep, voffA);
            PG8_WAIT_L(8); PG8_BAR; PG8_WAIT_L(0); PG8_MMA(0, 0, At, B0); PG8_BAR; PG8_SCHED;
            PG8_LDB(B1, 0, 1); PG8_STAGE(PG8_SB(0, 0), b2, voffB);
            PG8_BAR; PG8_WAIT_L(0); PG8_MMA(0, 1, At, B1); PG8_BAR;
            PG8_LDA(At, 0, 1); PG8_STAGE(PG8_SA(0, 0), a2, voffA);
            PG8_BAR; PG8_WAIT_L(0); PG8_MMA(1, 0, At, B0); PG8_BAR; PG8_SCHED;
            PG8_STAGE(PG8_SB(0, 1), b2 + hstep, voffB);
            PG8_WAIT_V(6); PG8_BAR; PG8_MMA(1, 1, At, B1); PG8_BAR;
            PG8_LDB(B0, 1, 0); PG8_SCHED; PG8_LDA(At, 1, 0); PG8_STAGE(PG8_SA(0, 1), a2 + hstep, voffA);
            PG8_WAIT_L(8); PG8_BAR; PG8_WAIT_L(0); PG8_MMA(0, 0, At, B0); PG8_BAR; PG8_SCHED;
            PG8_LDB(B1, 1, 1); PG8_STAGE(PG8_SB(1, 0), b3, voffB);
            PG8_BAR; PG8_WAIT_L(0); PG8_MMA(0, 1, At, B1); PG8_BAR;
            PG8_LDA(At, 1, 1); PG8_STAGE(PG8_SA(1, 0), a3, voffA);
            PG8_BAR; PG8_WAIT_L(0); PG8_MMA(1, 0, At, B0); PG8_BAR; PG8_SCHED;
            PG8_STAGE(PG8_SB(1, 1), b3 + hstep, voffB);
            PG8_WAIT_V(6); PG8_BAR; PG8_MMA(1, 1, At, B1); PG8_BAR;
            }
        }
        if constexpr (ALIGN_EPI) { if (wr == 0) PG8_BAR; }
        if constexpr (!Epi::AFTER_DRAIN) { E(acc, cur, wr, wc, fr, fq); S.done(cur); }
        if (!has_next) break;
#pragma unroll
        for (int a = 0; a < 2; ++a)
#pragma unroll
            for (int b = 0; b < 2; ++b)
#pragma unroll
                for (int m = 0; m < 4; ++m)
#pragma unroll
                    for (int n = 0; n < 2; ++n) acc[a][b][m][n] = (f32x4){0.f, 0.f, 0.f, 0.f};
        cur = nxt; cA = nA; cB = nB; ++ui;
        if constexpr (ALIGN_EPI) { if (wr == 1) PG8_BAR; }
    }
    PG8_WAIT_V(0);
    if constexpr (!ALIGN_EPI) { if (wr == 0) PG8_BAR; }
    PG8_BAR;
    if constexpr (Epi::AFTER_DRAIN) { E.fused(acc, cur, wr, wc, fr, fq, lds, wid, lane); S.done(cur); }
#undef PG8_SA
#undef PG8_SB
#undef PG8_STAGE
#undef PG8_LDA
#undef PG8_LDB
#undef PG8_MMA
#undef PG8_WAIT_V
#undef PG8_WAIT_L
#undef PG8_BAR
#undef PG8_SCHED
}
}

using pg8::bf16_t; using pg8::bf16x8; using pg8::f32x4; using pg8::Unit; using pg8::Gemm; using pg8::StaticOrder;
#define LAS __attribute__((address_space(3)))
typedef float f32x16 __attribute__((ext_vector_type(16)));
typedef short s16x4 __attribute__((ext_vector_type(4)));
typedef unsigned u32x2 __attribute__((ext_vector_type(2)));
typedef unsigned u32x4 __attribute__((ext_vector_type(4)));
typedef float f32x2_t __attribute__((ext_vector_type(2)));
typedef __bf16 bf16x2_t __attribute__((ext_vector_type(2)));
typedef unsigned long long u64;

constexpr int NB = 8, SEQ = 4096, NMETA = 16, DM = 1024, DFF = 2816, NHEAD = 16;
constexpr int MR = NB * SEQ;
constexpr int MROWS = MR + NMETA;
constexpr int MP = 33024;
constexpr float QSCALE = -0.125f * 1.4426950408889634f;
constexpr float SS_SCALE = 1048576.0f;

constexpr size_t OFF_SS = 0;
constexpr size_t OFF_BAR = 0x108000;
constexpr size_t OFF_S5 = 0x110000;
constexpr size_t S5_ABAR = OFF_S5;
constexpr size_t S5_BB = OFF_S5 + 0x8000;
constexpr size_t S5_CB = S5_BB + 0x40000;
constexpr size_t S5_DG = S5_CB + 0x40000;
constexpr size_t OFF_INV0 = 0x1A0000;
constexpr size_t OFF_W = 0x210000;
constexpr size_t W_GLU = OFF_W;
constexpr size_t W_FI0 = W_GLU + 2048ull * 1024 * 2;
constexpr size_t W_FI1 = W_FI0 + 5632ull * 1024 * 2;
constexpr size_t W_FO0 = W_FI1 + 5632ull * 1024 * 2;
constexpr size_t W_FO1 = W_FO0 + 1024ull * 2816 * 2;
constexpr size_t W_KQ = W_FO1 + 1024ull * 2816 * 2;
constexpr size_t W_V = W_KQ + 2048ull * 1024 * 2;
constexpr size_t W_O = W_V + 1024ull * 1024 * 2;
constexpr size_t OFF_XB = W_O + 1024ull * 1024 * 2;
constexpr size_t OFF_H = OFF_XB + (size_t)MP * 1024 * 2;
constexpr size_t OFF_W1 = OFF_H;
constexpr size_t OFF_ZQ = OFF_H + (size_t)MP * 1024 * 4;
constexpr size_t OFF_KB = OFF_ZQ + (size_t)MP * 1024 * 2;
constexpr size_t OFF_VT = OFF_KB + (size_t)MP * 1024 * 2;
constexpr size_t OFF_ACT = OFF_ZQ;
constexpr size_t WS_END = OFF_VT + (size_t)MP * 1024 * 2;
static_assert((size_t)MP * DFF * 2 <= WS_END - OFF_ACT, "ACT overlay fits");
static_assert(S5_DG + 4096 <= OFF_W, "s5 params fit");
static_assert(OFF_KB == OFF_ZQ + (size_t)MP * 1024 * 2 && OFF_VT == OFF_ZQ + 2 * (size_t)MP * 1024 * 2, "Q | K | V adjacent");

__device__ __forceinline__ unsigned cvtpk(float lo, float hi) { f32x2_t v = {lo, hi}; bf16x2_t b = __builtin_convertvector(v, bf16x2_t); return __builtin_bit_cast(unsigned, b); }
__device__ __forceinline__ float frcp(float x) { return __builtin_amdgcn_rcpf(x); }
__device__ __forceinline__ float rstd_of(u64 v) { return rsqrtf((float)v * (1.0f / (SS_SCALE * 1024.0f)) + 1e-6f); }
__device__ __forceinline__ void ss_add(u64* p, float s) { __hip_atomic_fetch_add(p, (u64)(s * SS_SCALE), __ATOMIC_RELAXED, __HIP_MEMORY_SCOPE_AGENT); }
__device__ __forceinline__ float bf2f(unsigned short b) { return __uint_as_float((unsigned)b << 16); }


struct EpiGLU {
    static constexpr bool PERM = true, AFTER_DRAIN = false;
    const float* inv0; bf16_t* XB; u64* ss;
    __device__ __forceinline__ void operator()(const f32x4 (&acc)[2][2][4][2], const Unit& u, int wr, int wc, int fr, int fq) const {
        const int col0 = u.pn * 128 + wc * 32 + 8 * fq;
        const int row0 = u.pm * 256 + wr * 64 + fr;
        const size_t rbase = (size_t)row0 * DM + col0;
#pragma unroll
        for (int ai = 0; ai < 2; ++ai) {
            u32x4 hv[4]; float iv[4];
#pragma unroll
            for (int m = 0; m < 4; ++m) { hv[m] = *(const u32x4*)(XB + rbase + (size_t)(ai * 128 + m * 16) * DM); iv[m] = inv0[row0 + ai * 128 + m * 16]; }
            float s[4];
#pragma unroll
            for (int m = 0; m < 4; ++m) {
                const u32x4 hb = hv[m];
                f32x4 h0 = {__uint_as_float(hb.x << 16), __uint_as_float(hb.x & 0xffff0000u), __uint_as_float(hb.y << 16), __uint_as_float(hb.y & 0xffff0000u)};
                f32x4 h1 = {__uint_as_float(hb.z << 16), __uint_as_float(hb.z & 0xffff0000u), __uint_as_float(hb.w << 16), __uint_as_float(hb.w & 0xffff0000u)};
                h0 *= iv[m]; h1 *= iv[m];
                const f32x4 v0 = acc[ai][0][m][0], v1 = acc[ai][0][m][1], g0 = acc[ai][1][m][0], g1 = acc[ai][1][m][1];
#pragma unroll
                for (int j = 0; j < 4; ++j) { h0[j] += v0[j] * frcp(1.f + __builtin_amdgcn_exp2f(g0[j] * -1.4426950408889634f)); h1[j] += v1[j] * frcp(1.f + __builtin_amdgcn_exp2f(g1[j] * -1.4426950408889634f)); }
                const size_t off = rbase + (size_t)(ai * 128 + m * 16) * DM;
                u32x4 w; w.x = cvtpk(h0[0], h0[1]); w.y = cvtpk(h0[2], h0[3]); w.z = cvtpk(h1[0], h1[1]); w.w = cvtpk(h1[2], h1[3]);
                *(u32x4*)(XB + off) = w;
                s[m] = (h0[0] * h0[0] + h0[1] * h0[1]) + (h0[2] * h0[2] + h0[3] * h0[3]) + (h1[0] * h1[0] + h1[1] * h1[1]) + (h1[2] * h1[2] + h1[3] * h1[3]);
            }
#pragma unroll
            for (int m = 0; m < 4; ++m) { s[m] += __shfl_xor(s[m], 16); s[m] += __shfl_xor(s[m], 32); }
            const float mine = fq == 0 ? s[0] : (fq == 1 ? s[1] : (fq == 2 ? s[2] : s[3]));
            ss_add(ss + (u.pm * 256 + ai * 128 + wr * 64 + fq * 16 + fr), mine);
        }
    }
};

template <bool CHEAP = false> struct EpiSwiGLU {
    static constexpr bool PERM = true, AFTER_DRAIN = false;
    const u64* ss; bf16_t* ACT;
    __device__ __forceinline__ void operator()(const f32x4 (&acc)[2][2][4][2], const Unit& u, int wr, int wc, int fr, int fq) const {
        const int col0 = u.pn * 128 + wc * 32 + 8 * fq;
        const int row0 = u.pm * 256 + wr * 64 + fr;
        u64 sv[2][4];
#pragma unroll
        for (int ai = 0; ai < 2; ++ai)
#pragma unroll
            for (int m = 0; m < 4; ++m) sv[ai][m] = ss[row0 + ai * 128 + m * 16];
#pragma unroll
        for (int ai = 0; ai < 2; ++ai)
#pragma unroll
            for (int m = 0; m < 4; ++m) {
                const int row = row0 + ai * 128 + m * 16;
                const float rs = rstd_of(sv[ai][m]);
                const float c1 = rs * -1.4426950408889634f, rs2 = rs * rs;
                unsigned ow[4];
#pragma unroll
                for (int n = 0; n < 2; ++n)
#pragma unroll
                    for (int jp = 0; jp < 2; ++jp) {
                        const f32x2_t ag = {acc[ai][0][m][n][2 * jp], acc[ai][0][m][n][2 * jp + 1]}, au = {acc[ai][1][m][n][2 * jp], acc[ai][1][m][n][2 * jp + 1]};
                        f32x2_t ov;
                        if (CHEAP) ov = ag * au;
                        else { const f32x2_t t = ag * c1; f32x2_t e; e.x = __builtin_amdgcn_exp2f(t.x); e.y = __builtin_amdgcn_exp2f(t.y);
                            const f32x2_t d = e + 1.0f; f32x2_t r; r.x = frcp(d.x); r.y = frcp(d.y);
                            ov = (ag * au) * (r * rs2); }
                        ow[2 * n + jp] = cvtpk(ov.x, ov.y);
                    }
                u32x4 w; w.x = ow[0]; w.y = ow[1]; w.z = ow[2]; w.w = ow[3];
                __builtin_nontemporal_store(w, (u32x4*)(ACT + (size_t)row * DFF + col0));
            }
    }
};

template <bool WRITE_XB> struct EpiResid {
    static constexpr bool PERM = true, AFTER_DRAIN = false;
    bf16_t* XB; u64* ss;
    __device__ __forceinline__ void operator()(const f32x4 (&acc)[2][2][4][2], const Unit& u, int wr, int wc, int fr, int fq) const {
        const int col0 = u.pn * 256 + wc * 32 + 8 * fq;
        const size_t rbase = (size_t)(u.pm * 256 + wr * 64 + fr) * DM + col0;
#pragma unroll
        for (int ai = 0; ai < 2; ++ai) {
            u32x4 hv[4][2];
#pragma unroll
            for (int m = 0; m < 4; ++m)
#pragma unroll
                for (int bj = 0; bj < 2; ++bj) hv[m][bj] = *(const u32x4*)(XB + rbase + (size_t)(ai * 128 + m * 16) * DM + bj * 128);
            float s[4];
#pragma unroll
            for (int m = 0; m < 4; ++m) {
                float sq = 0.f;
#pragma unroll
                for (int bj = 0; bj < 2; ++bj) {
                    const size_t off = rbase + (size_t)(ai * 128 + m * 16) * DM + bj * 128;
                    const u32x4 hb = hv[m][bj];
                    f32x4 h0 = {__uint_as_float(hb.x << 16), __uint_as_float(hb.x & 0xffff0000u), __uint_as_float(hb.y << 16), __uint_as_float(hb.y & 0xffff0000u)};
                    f32x4 h1 = {__uint_as_float(hb.z << 16), __uint_as_float(hb.z & 0xffff0000u), __uint_as_float(hb.w << 16), __uint_as_float(hb.w & 0xffff0000u)};
                    h0 += acc[ai][bj][m][0]; h1 += acc[ai][bj][m][1];
                    u32x4 w; w.x = cvtpk(h0[0], h0[1]); w.y = cvtpk(h0[2], h0[3]); w.z = cvtpk(h1[0], h1[1]); w.w = cvtpk(h1[2], h1[3]);
                    *(u32x4*)(XB + off) = w;
                    sq += (h0[0] * h0[0] + h0[1] * h0[1]) + (h0[2] * h0[2] + h0[3] * h0[3]) + (h1[0] * h1[0] + h1[1] * h1[1]) + (h1[2] * h1[2] + h1[3] * h1[3]);
                }
                s[m] = sq;
            }
#pragma unroll
            for (int m = 0; m < 4; ++m) { s[m] += __shfl_xor(s[m], 16); s[m] += __shfl_xor(s[m], 32); }
            const float mine = fq == 0 ? s[0] : (fq == 1 ? s[1] : (fq == 2 ? s[2] : s[3]));
            ss_add(ss + (u.pm * 256 + ai * 128 + wr * 64 + fq * 16 + fr), mine);
        }
    }
};

struct EpiKQ {
    static constexpr bool PERM = true, AFTER_DRAIN = false;
    const u64* ss; bf16_t* QB;
    __device__ __forceinline__ void operator()(const f32x4 (&acc)[2][2][4][2], const Unit& u, int wr, int wc, int fr, int fq) const {
        const int t3 = u.pn >> 2; const bool isq = t3 == 1;
        const int sel = t3 == 2 ? 2 : 1 - t3;
        bf16_t* base = QB + (size_t)sel * ((size_t)MP * DM); const float sc = isq ? QSCALE : 1.0f;
        const int col0 = (u.pn & 3) * 256 + wc * 32 + 8 * fq;
        const int row0 = u.pm * 256 + wr * 64 + fr;
        u64 sv[2][4];
#pragma unroll
        for (int ai = 0; ai < 2; ++ai)
#pragma unroll
            for (int m = 0; m < 4; ++m) sv[ai][m] = ss[row0 + ai * 128 + m * 16];
#pragma unroll
        for (int ai = 0; ai < 2; ++ai)
#pragma unroll
            for (int m = 0; m < 4; ++m) {
                const int row = row0 + ai * 128 + m * 16;
                const float rs = rstd_of(sv[ai][m]) * sc;
#pragma unroll
                for (int bj = 0; bj < 2; ++bj) { const f32x4 v0 = acc[ai][bj][m][0] * rs, v1 = acc[ai][bj][m][1] * rs;
                    u32x4 w; w.x = cvtpk(v0[0], v0[1]); w.y = cvtpk(v0[2], v0[3]); w.z = cvtpk(v1[0], v1[1]); w.w = cvtpk(v1[2], v1[3]);
                    *(u32x4*)(base + (size_t)row * DM + col0 + bj * 128) = w; }
            }
    }
};

struct EpiVt {
    static constexpr bool PERM = true, AFTER_DRAIN = false;
    const u64* ss; bf16_t* VT;
    __device__ __forceinline__ void operator()(const f32x4 (&acc)[2][2][4][2], const Unit& u, int wr, int wc, int fr, int fq) const {
        const int col0 = u.pn * 256 + wc * 32 + 8 * fq;
#pragma unroll
        for (int bj = 0; bj < 2; ++bj) {
            float rs[8];
#pragma unroll
            for (int j = 0; j < 8; ++j) rs[j] = rstd_of(ss[col0 + bj * 128 + j]);
#pragma unroll
            for (int ai = 0; ai < 2; ++ai)
#pragma unroll
                for (int m = 0; m < 4; ++m) {
                    const int ch = u.pm * 256 + ai * 128 + wr * 64 + m * 16 + fr;
                    const f32x4 v0 = acc[ai][bj][m][0], v1 = acc[ai][bj][m][1];
                    u32x4 w; w.x = cvtpk(v0[0] * rs[0], v0[1] * rs[1]); w.y = cvtpk(v0[2] * rs[2], v0[3] * rs[3]); w.z = cvtpk(v1[0] * rs[4], v1[1] * rs[5]); w.w = cvtpk(v1[2] * rs[6], v1[3] * rs[7]);
                    *(u32x4*)(VT + (size_t)ch * MP + col0 + bj * 128) = w;
                }
        }
    }
};

template <int MODE, bool WXB, int K>
__device__ __forceinline__ void meta_gemm(LAS unsigned char* lds, const bf16_t* A, const bf16_t* Bt, int nitems, const float* meta, float* H, bf16_t* XB, bf16_t* O1, bf16_t* O2, bf16_t* O3, u64* ss_out, const u64* ss_in) {
    constexpr bool GATED = (MODE == 0 || MODE == 1);
    int tid = threadIdx.x; asm volatile("" : "+v"(tid));
    const int lane = tid & 63, wid = __builtin_amdgcn_readfirstlane(tid >> 6);
    LAS f32x4* red = (LAS f32x4*)lds;
    for (int it = blockIdx.x; it < nitems; it += gridDim.x) {
        const int c0 = it * 16;
        const int brow0 = GATED ? 256 * (c0 >> 7) + (c0 & 127) : c0;
        const int kw = K >> 3, k0 = wid * kw;
        f32x4 acc0 = {0.f, 0.f, 0.f, 0.f}, acc1 = {0.f, 0.f, 0.f, 0.f};
        const bf16_t* ap = A + (size_t)(lane & 15) * K + k0 + 8 * (lane >> 4);
        const bf16_t* bp = Bt + (size_t)(brow0 + (lane & 15)) * K + k0 + 8 * (lane >> 4);
        constexpr int NKS = K / 8 / 32;
        bf16x8 av[NKS], bv0[NKS], bv1[GATED ? NKS : 1];
#pragma unroll
        for (int i = 0; i < NKS; ++i) { av[i] = *(const bf16x8*)(ap + 32 * i); bv0[i] = *(const bf16x8*)(bp + 32 * i); if (GATED) bv1[i] = *(const bf16x8*)(bp + (size_t)128 * K + 32 * i); }
#pragma unroll
        for (int i = 0; i < NKS; ++i) {
            acc0 = __builtin_amdgcn_mfma_f32_16x16x32_bf16(av[i], bv0[i], acc0, 0, 0, 0);
            if (GATED) acc1 = __builtin_amdgcn_mfma_f32_16x16x32_bf16(av[i], bv1[i], acc1, 0, 0, 0);
        }
        red[wid * 64 + lane] = acc0; if (GATED) red[512 + wid * 64 + lane] = acc1;
        __syncthreads();
        if (wid == 0) {
            f32x4 s0 = red[lane], s1 = {0.f, 0.f, 0.f, 0.f};
#pragma unroll
            for (int w = 1; w < 8; ++w) s0 += red[w * 64 + lane];
            if (GATED) { s1 = red[512 + lane];
#pragma unroll
                for (int w = 1; w < 8; ++w) s1 += red[512 + w * 64 + lane]; }
            const int c = c0 + (lane & 15);
#pragma unroll
            for (int j = 0; j < 4; ++j) {
                const int r = 4 * (lane >> 4) + j;
                if (MODE == 0 || MODE == 2) {
                    float hn;
                    if (MODE == 0) hn = meta[r * DM + c] + s0[j] * frcp(1.f + __expf(-s1[j]));
                    else hn = bf2f(XB[(size_t)(MR + r) * DM + c]) + s0[j];
                    XB[(size_t)(MR + r) * DM + c] = (bf16_t)(cvtpk(hn, 0.f) & 0xffffu);
                    float sq = hn * hn;
                    sq += __shfl_xor(sq, 1); sq += __shfl_xor(sq, 2); sq += __shfl_xor(sq, 4); sq += __shfl_xor(sq, 8);
                    if ((lane & 15) == 0) ss_add(ss_out + MR + r, sq);
                } else {
                    const float rs = rstd_of(ss_in[MR + r]);
                    if (MODE == 1) { const float g = s0[j] * rs, uu = s1[j] * rs; O1[(size_t)(MR + r) * DFF + c] = (bf16_t)(cvtpk(g * uu * frcp(1.f + __expf(-g)), 0.f) & 0xffffu); }
                    if (MODE == 3) { if (c < 1024) O1[(size_t)(MR + r) * DM + c] = (bf16_t)(cvtpk(s0[j] * rs, 0.f) & 0xffffu);
                        else if (c < 2048) O2[(size_t)(MR + r) * DM + c - 1024] = (bf16_t)(cvtpk(s0[j] * rs * QSCALE, 0.f) & 0xffffu);
                        else { O3[(size_t)(MR + r) * DM + c - 2048] = (bf16_t)(cvtpk(s0[j] * rs, 0.f) & 0xffffu); O3[(size_t)(MR + 16 + r) * DM + c - 2048] = 0; } }
                    if (MODE == 4) { O1[(size_t)c * MP + MR + r] = (bf16_t)(cvtpk(s0[j] * rs, 0.f) & 0xffffu); O1[(size_t)c * MP + MR + 16 + r] = 0; }
                }
            }
        }
        __syncthreads();
    }
}

__device__ __forceinline__ void transpose_item(const float* src, int ldn, const float* gain, bf16_t* dst, int K, int n0d, int c0s, int k0, int lane) {
    const float* sp = src + (size_t)k0 * ldn + c0s + lane;
    float v[32];
#pragma unroll
    for (int k = 0; k < 32; ++k) v[k] = sp[(size_t)k * ldn];
    if (gain) {
#pragma unroll
        for (int k = 0; k < 32; ++k) v[k] *= gain[k0 + k];
    }
    bf16_t* dp = dst + (size_t)(n0d + lane) * K + k0;
#pragma unroll
    for (int q = 0; q < 4; ++q) { u32x4 w; w.x = cvtpk(v[8 * q], v[8 * q + 1]); w.y = cvtpk(v[8 * q + 2], v[8 * q + 3]); w.z = cvtpk(v[8 * q + 4], v[8 * q + 5]); w.w = cvtpk(v[8 * q + 6], v[8 * q + 7]);
        *(u32x4*)(dp + 8 * q) = w; }
}

struct Ptrs {
    const float* in[20]; float* out; unsigned char* ws;
};

__device__ __forceinline__ void p0_prologue(const Ptrs& P, LAS unsigned char* lds) {
    int tid = threadIdx.x; asm volatile("" : "+v"(tid));
    const int lane = tid & 63, wid = tid >> 6;
    unsigned char* ws = P.ws;
    const int gw = blockIdx.x * 8 + wid, NGW = gridDim.x * 8;
    constexpr int I_GLU = 32 * 32, I_FI = 32 * 88, I_FO = 88 * 16, I_KQ = 32 * 32, I_V = 32 * 16, I_O = 32 * 16;
    constexpr int NITEMS = I_GLU + 2 * I_FI + 2 * I_FO + I_KQ + I_V + I_O;
    struct TItem { const float* sp; const float* gp; bf16_t* dp; int ldn; };
    auto decode = [&](const int it) __attribute__((always_inline)) -> TItem {
        int r = it; const float* src; const float* gain; bf16_t* dst; int ldn, K, n0d, c0s, k0;
        if (r < I_GLU) { const int kb = r & 31, nb = r >> 5, n0 = nb * 64; src = P.in[12]; ldn = 2048; gain = nullptr; dst = (bf16_t*)(ws + W_GLU); K = 1024; n0d = n0; c0s = ((n0 >> 7) & 1) * 1024 + (n0 >> 8) * 128 + (n0 & 127); k0 = kb * 32; }
        else if ((r -= I_GLU) < 2 * I_FI) { const int l = r / I_FI; r -= l * I_FI; const int kb = r & 31, nb = r >> 5, n0 = nb * 64; src = P.in[17] + (size_t)l * 1024 * 5632; ldn = 5632; gain = P.in[3] + l * 1024;
            dst = (bf16_t*)(ws + W_FI0) + (size_t)l * 5632 * 1024; K = 1024; n0d = n0; c0s = ((n0 >> 7) & 1) * DFF + (n0 >> 8) * 128 + (n0 & 127); k0 = kb * 32; }
        else if ((r -= 2 * I_FI) < 2 * I_FO) { const int l = r / I_FO; r -= l * I_FO; const int kb = r % 88, nb = r / 88; src = P.in[18] + (size_t)l * 2816 * 1024; ldn = 1024; gain = nullptr;
            dst = (bf16_t*)(ws + W_FO0) + (size_t)l * 1024 * 2816; K = 2816; n0d = nb * 64; c0s = nb * 64; k0 = kb * 32; }
        else if ((r -= 2 * I_FO) < I_KQ) { const int kb = r & 31, nb = r >> 5, n0 = nb * 64; dst = (bf16_t*)(ws + W_KQ); K = 1024; n0d = n0; k0 = kb * 32;
            if (n0 < 1024) { src = P.in[14]; ldn = 2048; gain = P.in[13]; c0s = n0; } else { src = P.in[15]; ldn = 1024; gain = P.in[2] + 1024; c0s = n0 - 1024; } }
        else if ((r -= I_KQ) < I_V) { const int kb = r & 31, nb = r >> 5; src = P.in[14]; ldn = 2048; gain = P.in[13]; dst = (bf16_t*)(ws + W_V); K = 1024; n0d = nb * 64; c0s = 1024 + nb * 64; k0 = kb * 32; }
        else { r -= I_V; const int kb = r & 31, nb = r >> 5; src = P.in[16]; ldn = 1024; gain = nullptr; dst = (bf16_t*)(ws + W_O); K = 1024; n0d = nb * 64; c0s = nb * 64; k0 = kb * 32; }
        TItem t; t.sp = src + (size_t)k0 * ldn + c0s + lane; t.gp = gain ? gain + k0 : nullptr; t.dp = dst + (size_t)(n0d + lane) * K + k0; t.ldn = ldn; return t;
    };
    auto finish = [&](const TItem& t, float (&v)[32]) __attribute__((always_inline)) {
        if (t.gp) {
#pragma unroll
            for (int k = 0; k < 32; ++k) v[k] *= t.gp[k];
        }
#pragma unroll
        for (int q = 0; q < 4; ++q) { u32x4 w; w.x = cvtpk(v[8 * q], v[8 * q + 1]); w.y = cvtpk(v[8 * q + 2], v[8 * q + 3]); w.z = cvtpk(v[8 * q + 4], v[8 * q + 5]); w.w = cvtpk(v[8 * q + 6], v[8 * q + 7]);
            *(u32x4*)(t.dp + 8 * q) = w; }
    };
    for (int it = gw; it < NITEMS; it += 2 * NGW) {
        const bool hb = it + NGW < NITEMS;
        const TItem a = decode(it), b = decode(hb ? it + NGW : it);
        float va[32], vb[32];
#pragma unroll
        for (int k = 0; k < 32; ++k) { va[k] = __builtin_nontemporal_load(a.sp + (size_t)k * a.ldn); vb[k] = __builtin_nontemporal_load(b.sp + (size_t)k * b.ldn); }
        finish(a, va);
        if (hb) finish(b, vb);
    }
    bf16_t* XB = (bf16_t*)(ws + OFF_XB);
    for (int row = gw; row < MROWS; row += 2 * NGW) {
        const int row2 = row + NGW; const bool has2 = row2 < MROWS;
        const float* src = row < MR ? P.in[0] + (size_t)row * DM : P.in[1] + (size_t)(row - MR) * DM;
        const float* src2 = has2 ? (row2 < MR ? P.in[0] + (size_t)row2 * DM : P.in[1] + (size_t)(row2 - MR) * DM) : src;
        f32x4 v[4], v2[4]; float s = 0.f, s2 = 0.f;
#pragma unroll
        for (int j = 0; j < 4; ++j) { v[j] = __builtin_nontemporal_load((const f32x4*)(src + 4 * lane + 256 * j)); v2[j] = __builtin_nontemporal_load((const f32x4*)(src2 + 4 * lane + 256 * j)); }
#pragma unroll
        for (int j = 0; j < 4; ++j) { s += (v[j][0] * v[j][0] + v[j][1] * v[j][1]) + (v[j][2] * v[j][2] + v[j][3] * v[j][3]); s2 += (v2[j][0] * v2[j][0] + v2[j][1] * v2[j][1]) + (v2[j][2] * v2[j][2] + v2[j][3] * v2[j][3]); }
#pragma unroll
        for (int o = 1; o < 64; o <<= 1) { s += __shfl_xor(s, o); s2 += __shfl_xor(s2, o); }
        const float ms = s * (1.0f / 1024.0f) + 1e-6f, ms2 = s2 * (1.0f / 1024.0f) + 1e-6f;
        const float rs = rsqrtf(ms), rs2 = rsqrtf(ms2);
        if (lane == 0) { ((float*)(ws + OFF_INV0))[row] = sqrtf(ms); if (has2) ((float*)(ws + OFF_INV0))[row2] = sqrtf(ms2); }
#pragma unroll
        for (int j = 0; j < 4; ++j) { u32x2 w; w.x = cvtpk(v[j][0] * rs, v[j][1] * rs); w.y = cvtpk(v[j][2] * rs, v[j][3] * rs); *(u32x2*)(XB + (size_t)row * DM + 4 * lane + 256 * j) = w; }
        if (has2) {
#pragma unroll
            for (int j = 0; j < 4; ++j) { u32x2 w; w.x = cvtpk(v2[j][0] * rs2, v2[j][1] * rs2); w.y = cvtpk(v2[j][2] * rs2, v2[j][3] * rs2); *(u32x2*)(XB + (size_t)row2 * DM + 4 * lane + 256 * j) = w; }
        }
    }
    const int gt = blockIdx.x * 512 + tid, NGT = gridDim.x * 512;
    u64* ss = (u64*)(ws + OFF_SS);
    for (int i = gt; i < 4 * MP; i += NGT) ss[i] = 0ull;
    const float* gain0 = P.in[2];
    for (int ii = gt; ii < 64 * 64 * 8; ii += NGT) {
        const int i = ii >> 3, c = 2 * (ii & 7);
        const int g = i >> 6;
        const double dt = exp((double)P.in[6][g]);
        const double are = (double)P.in[4][i], aim = (double)P.in[5][i];
        const double mag = exp(dt * are), ang = dt * aim;
        const double kq = rint(ang * 0.15915494309189535), rr = ang - kq * 6.283185307179586;
        const double q = rr * 0.25, q2 = q * q;
        const double sn = q * (1.0 - q2 / 6.0 * (1.0 - q2 / 20.0 * (1.0 - q2 / 42.0 * (1.0 - q2 / 72.0 * (1.0 - q2 / 110.0 * (1.0 - q2 / 156.0 * (1.0 - q2 / 210.0)))))));
        const double cs = 1.0 - q2 / 2.0 * (1.0 - q2 / 12.0 * (1.0 - q2 / 30.0 * (1.0 - q2 / 56.0 * (1.0 - q2 / 90.0 * (1.0 - q2 / 132.0 * (1.0 - q2 / 182.0 * (1.0 - q2 / 240.0)))))));
        const double s2 = 2.0 * sn * cs, c2 = 1.0 - 2.0 * sn * sn;
        const double s4 = 2.0 * s2 * c2, c4 = 1.0 - 2.0 * s2 * s2;
        const double abr = mag * c4, abi = mag * s4;
        if (c == 0) { float* ab = (float*)(ws + S5_ABAR); ab[2 * i] = (float)abr; ab[2 * i + 1] = (float)abi; }
        const double den = are * are + aim * aim;
        const double cr = ((abr - 1.0) * are + abi * aim) / den, ci = (abi * are - (abr - 1.0) * aim) / den;
        bf16_t* bb = (bf16_t*)(ws + S5_BB);
        const int p = i & 63;
        const double g0 = gain0[g * 16 + c], g1 = gain0[g * 16 + c + 1];
        const double br0 = P.in[7][(size_t)i * 16 + c], bi0 = P.in[8][(size_t)i * 16 + c], br1 = P.in[7][(size_t)i * 16 + c + 1], bi1 = P.in[8][(size_t)i * 16 + c + 1];
        *(unsigned*)(bb + ((size_t)(g * 2 + 0) * 64 + p) * 16 + c) = cvtpk((float)((cr * br0 - ci * bi0) * g0), (float)((cr * br1 - ci * bi1) * g1));
        *(unsigned*)(bb + ((size_t)(g * 2 + 1) * 64 + p) * 16 + c) = cvtpk((float)((cr * bi0 + ci * br0) * g0), (float)((cr * bi1 + ci * br1) * g1));
    }
    for (int i = gt; i < 64 * 64 * 16; i += NGT) {
        const int gp = i >> 4, t = i & 15, g = gp >> 6, p = gp & 63, sh = p >> 5, nn = p & 31;
        const double dt = exp((double)P.in[6][g]);
        const double are = (double)P.in[4][gp], aim = (double)P.in[5][gp];
        const double mag = exp(dt * are), ang = dt * aim;
        const double kq = rint(ang * 0.15915494309189535), rr = ang - kq * 6.283185307179586;
        const double q = rr * 0.25, q2 = q * q;
        const double sn = q * (1.0 - q2 / 6.0 * (1.0 - q2 / 20.0 * (1.0 - q2 / 42.0 * (1.0 - q2 / 72.0 * (1.0 - q2 / 110.0 * (1.0 - q2 / 156.0 * (1.0 - q2 / 210.0)))))));
        const double cs = 1.0 - q2 / 2.0 * (1.0 - q2 / 12.0 * (1.0 - q2 / 30.0 * (1.0 - q2 / 56.0 * (1.0 - q2 / 90.0 * (1.0 - q2 / 132.0 * (1.0 - q2 / 182.0 * (1.0 - q2 / 240.0)))))));
        const double s2 = 2.0 * sn * cs, c2 = 1.0 - 2.0 * sn * sn;
        const double s4 = 2.0 * s2 * c2, c4 = 1.0 - 2.0 * s2 * s2;
        const double abr = mag * c4, abi = mag * s4;
        const double den = are * are + aim * aim;
        const double cr = ((abr - 1.0) * are + abi * aim) / den, ci = (abi * are - (abr - 1.0) * aim) / den;
        double pwr = 1.0, pwi = 0.0, br_ = abr, bi_ = abi; const int e = 15 - t;
#pragma unroll
        for (int bit = 0; bit < 4; ++bit) {
            if ((e >> bit) & 1) { const double nr = pwr * br_ - pwi * bi_, ni = pwr * bi_ + pwi * br_; pwr = nr; pwi = ni; }
            const double sr = br_ * br_ - bi_ * bi_, si = 2.0 * br_ * bi_; br_ = sr; bi_ = si;
        }
        const double fr = pwr * cr - pwi * ci, fi = pwr * ci + pwi * cr;
        bf16_t* w1 = (bf16_t*)(ws + OFF_W1);
#pragma unroll
        for (int h8 = 0; h8 < 2; ++h8) {
            unsigned wre[4], wim[4];
#pragma unroll
            for (int jp = 0; jp < 4; ++jp) {
                const int c = 8 * h8 + 2 * jp;
                const double g0 = gain0[g * 16 + c], g1 = gain0[g * 16 + c + 1];
                const double br0 = P.in[7][(size_t)gp * 16 + c], bi0 = P.in[8][(size_t)gp * 16 + c], br1 = P.in[7][(size_t)gp * 16 + c + 1], bi1 = P.in[8][(size_t)gp * 16 + c + 1];
                wre[jp] = cvtpk((float)((fr * br0 - fi * bi0) * g0), (float)((fr * br1 - fi * bi1) * g1));
                wim[jp] = cvtpk((float)((fr * bi0 + fi * br0) * g0), (float)((fr * bi1 + fi * br1) * g1));
            }
            u32x4 vre; vre.x = wre[0]; vre.y = wre[1]; vre.z = wre[2]; vre.w = wre[3];
            u32x4 vim; vim.x = wim[0]; vim.y = wim[1]; vim.z = wim[2]; vim.w = wim[3];
            *(u32x4*)(w1 + ((((size_t)(g * 16 + t) * 2 + 0) * 2 + sh) * 64 + nn + 32 * h8) * 8) = vre;
            *(u32x4*)(w1 + ((((size_t)(g * 16 + t) * 2 + 1) * 2 + sh) * 64 + nn + 32 * h8) * 8) = vim;
        }
    }
    for (int i = gt; i < 64 * 16 * 64 / 2; i += NGT) {
        const int e = 2 * i, g = e >> 10, cp = e & 1023;
        bf16_t* cb = (bf16_t*)(ws + S5_CB);
        *(unsigned*)(cb + (size_t)(g * 2 + 0) * 1024 + cp) = cvtpk(P.in[9][e], P.in[9][e + 1]);
        *(unsigned*)(cb + (size_t)(g * 2 + 1) * 1024 + cp) = cvtpk(-P.in[10][e], -P.in[10][e + 1]);
    }
    for (int i = gt; i < 1024; i += NGT) ((float*)(ws + S5_DG))[i] = P.in[11][i] * gain0[i];
}

#define MFMA32(a, b, c) __builtin_amdgcn_mfma_f32_32x32x16_bf16((a), (b), (c), 0, 0, 0)
__device__ __forceinline__ float gelu_tanh(float y) {
    const float t = 1.5957691216057308f * (y + 0.044715f * y * y * y);
    return y * frcp(1.f + __expf(-t));
}
__device__ __forceinline__ void s5_phase(const Ptrs& P, LAS unsigned char* lds) {
    int tid = threadIdx.x; asm volatile("" : "+v"(tid));
    const int lane = tid & 63, wid = __builtin_amdgcn_readfirstlane(tid >> 6), n = lane & 31, hh = lane >> 5;
    unsigned char* ws = P.ws;
    const bf16_t* XB = (const bf16_t*)(ws + OFF_XB);
    bf16_t* Z = (bf16_t*)(ws + OFF_ZQ);
    LAS unsigned char* wl = lds + wid * 9216;
    LAS unsigned char* uimg = wl + 8192;
    LAS f32x4* Ex = (LAS f32x4*)(lds + 8 * 9216);
    const int bs = (n >> 2) & 1, tk = (n & 3) + 4 * (n >> 3);
    for (int unit = blockIdx.x; unit < 256; unit += gridDim.x) {
        const int bp = unit >> 6, g = ((unit & 7) << 3) | ((unit >> 3) & 7);
        float ar[2], ai[2];
#pragma unroll
        for (int sh = 0; sh < 2; ++sh) { const float* ab = (const float*)(ws + S5_ABAR) + 2 * (g * 64 + 32 * sh + n); ar[sh] = ab[0]; ai[sh] = ab[1]; }
        bf16x8 Bop[2][2];
#pragma unroll
        for (int ri = 0; ri < 2; ++ri)
#pragma unroll
            for (int sh = 0; sh < 2; ++sh) {
                Bop[ri][sh] = *(const bf16x8*)((const bf16_t*)(ws + S5_BB) + ((size_t)(g * 2 + ri) * 64 + 32 * sh + n) * 16 + 8 * hh);
            }
#pragma unroll
        for (int ri = 0; ri < 2; ++ri)
#pragma unroll
            for (int sh = 0; sh < 2; ++sh) asm volatile("" :: "v"(Bop[ri][sh]));
        asm volatile("" :: "v"(ar[0]), "v"(ar[1]), "v"(ai[0]), "v"(ai[1]));
        const int c_beg = 32 * wid + (wid > 0 ? 1 : 0), c_end = c_beg + 32 + (wid == 0 ? 1 : 0);
        const size_t arow_real = (size_t)((2 * bp + bs) * SEQ + tk), arow_meta = (size_t)(MR + tk);
        const int acol = g * 16 + 8 * hh;
        f32x16 zero16;
#pragma unroll
        for (int i = 0; i < 16; ++i) zero16[i] = 0.f;
        float xr[2] = {0.f, 0.f}, xi[2] = {0.f, 0.f};
#define S5_LOADA(c) (*(const bf16x8*)(XB + ((c) == 0 ? arow_meta : arow_real + (size_t)16 * ((c) - 1)) * DM + acol))
        float p16r[2], p16i[2];
#pragma unroll
        for (int sh = 0; sh < 2; ++sh) {
            float cr = ar[sh], ci = ai[sh];
#pragma unroll
            for (int k = 0; k < 4; ++k) { const float t = cr * cr - ci * ci; ci = 2.f * cr * ci; cr = t; }
            p16r[sh] = cr; p16i[sh] = ci;
        }
        {
            if (wid == 0) {
                const bf16x8 a_cur = S5_LOADA(0);
                f32x16 bu[2][2];
#pragma unroll
                for (int ri = 0; ri < 2; ++ri)
#pragma unroll
                    for (int sh = 0; sh < 2; ++sh) bu[ri][sh] = MFMA32(a_cur, Bop[ri][sh], zero16);
#pragma unroll
                for (int r = 0; r < 16; ++r)
#pragma unroll
                    for (int sh = 0; sh < 2; ++sh) {
                        const float nr = ar[sh] * xr[sh] - ai[sh] * xi[sh] + bu[0][sh][r];
                        const float ni = ar[sh] * xi[sh] + ai[sh] * xr[sh] + bu[1][sh][r];
                        xr[sh] = nr; xi[sh] = ni;
                    }
            }
            const int c1 = wid == 0 ? 1 : c_beg;
            const bf16_t* W1g = (const bf16_t*)(ws + OFF_W1) + (size_t)g * (16 * 4 * 64 * 8) + lane * 8;
            for (int blk = 0; blk < 2; ++blk) {
                const bf16_t* ab = XB + ((size_t)((2 * bp + bs) * SEQ) + (size_t)16 * (c1 - 1 + 16 * blk + tk)) * DM + acol;
                f32x16 E00 = zero16, E01 = zero16, E10 = zero16, E11 = zero16;
#pragma unroll 4
                for (int t = 0; t < 16; ++t) {
                    const bf16x8 a = *(const bf16x8*)(ab + (size_t)t * DM);
                    const bf16_t* wp = W1g + (size_t)t * (4 * 64 * 8);
                    const bf16x8 b00 = *(const bf16x8*)(wp), b01 = *(const bf16x8*)(wp + 512), b10 = *(const bf16x8*)(wp + 1024), b11 = *(const bf16x8*)(wp + 1536);
                    E00 = MFMA32(a, b00, E00); E01 = MFMA32(a, b01, E01); E10 = MFMA32(a, b10, E10); E11 = MFMA32(a, b11, E11);
                }
#pragma unroll
                for (int r = 0; r < 16; ++r) {
                    { const float nr = p16r[0] * xr[0] - p16i[0] * xi[0] + E00[r], ni = p16r[0] * xi[0] + p16i[0] * xr[0] + E10[r]; xr[0] = nr; xi[0] = ni; }
                    { const float nr = p16r[1] * xr[1] - p16i[1] * xi[1] + E01[r], ni = p16r[1] * xi[1] + p16i[1] * xr[1] + E11[r]; xr[1] = nr; xi[1] = ni; }
                }
            }
        }
        Ex[wid * 64 + lane] = (f32x4){xr[0], xi[0], xr[1], xi[1]};
        __syncthreads();
        {
            float pr[2], pi[2];
#pragma unroll
            for (int sh = 0; sh < 2; ++sh) {
                float cr = p16r[sh], ci = p16i[sh];
#pragma unroll
                for (int k = 0; k < 5; ++k) { const float t = cr * cr - ci * ci; ci = 2.f * cr * ci; cr = t; }
                pr[sh] = cr; pi[sh] = ci;
            }
            xr[0] = xr[1] = xi[0] = xi[1] = 0.f;
            for (int v = 0; v < wid; ++v) {
                const f32x4 e = Ex[v * 64 + lane];
#pragma unroll
                for (int sh = 0; sh < 2; ++sh) {
                    float qr = pr[sh], qi = pi[sh];
                    if (v == 0) { const float t = qr * p16r[sh] - qi * p16i[sh]; qi = qr * p16i[sh] + qi * p16r[sh]; qr = t; }
                    const float nr = qr * xr[sh] - qi * xi[sh] + (sh == 0 ? e[0] : e[2]);
                    const float ni = qr * xi[sh] + qi * xr[sh] + (sh == 0 ? e[1] : e[3]);
                    xr[sh] = nr; xi[sh] = ni;
                }
            }
        }
        {
            bf16x8 Cop[2][2][2];
#pragma unroll
            for (int ri = 0; ri < 2; ++ri)
#pragma unroll
                for (int sh = 0; sh < 2; ++sh) {
#pragma unroll
                    for (int s = 0; s < 2; ++s) { bf16x8 cv = {0, 0, 0, 0, 0, 0, 0, 0};
                        if (n < 16) cv = *(const bf16x8*)((const bf16_t*)(ws + S5_CB) + ((size_t)(g * 2 + ri) * 16 + n) * 64 + 32 * sh + 16 * s + 8 * hh);
                        Cop[ri][sh][s] = cv; }
                    asm volatile("" :: "v"(Cop[ri][sh][0]), "v"(Cop[ri][sh][1]));
                }
            const int xsw = (n >> 1) & 7;
            const int trq = (lane & 15) >> 2, trc = 4 * ((lane >> 4) & 1) + (lane & 3);
            const unsigned tr_lo = (unsigned)(size_t)wl + (unsigned)((8 * hh + trq) * 64 + 8 * (trc ^ ((4 * hh + (trq >> 1)) & 7)));
            const unsigned tr_hi = (unsigned)(size_t)wl + (unsigned)((8 * hh + trq + 4) * 64 + 8 * (trc ^ ((4 * hh + (trq >> 1) + 2) & 7)));
            const float* Dg = (const float*)(ws + S5_DG) + g * 16 + 4 * hh;
            const f32x4 d_lo = *(const f32x4*)Dg, d_hi = *(const f32x4*)(Dg + 8);
            asm volatile("" :: "v"(d_lo), "v"(d_hi));
            const int cl = c_end - 1;
            auto body2 = [&](const bf16x8 a_cur, const int c) __attribute__((always_inline)) {
                *(LAS bf16x8*)(uimg + n * 32 + hh * 16) = a_cur;
                f32x16 bu[2][2];
#pragma unroll
                for (int ri = 0; ri < 2; ++ri)
#pragma unroll
                    for (int sh = 0; sh < 2; ++sh) bu[ri][sh] = MFMA32(a_cur, Bop[ri][sh], zero16);
#pragma unroll
                for (int r = 0; r < 16; ++r)
#pragma unroll
                    for (int sh = 0; sh < 2; ++sh) {
                        const float nr = ar[sh] * xr[sh] - ai[sh] * xi[sh] + bu[0][sh][r];
                        const float ni = ar[sh] * xi[sh] + ai[sh] * xr[sh] + bu[1][sh][r];
                        xr[sh] = nr; xi[sh] = ni; bu[0][sh][r] = nr; bu[1][sh][r] = ni;
                    }
#pragma unroll
                for (int ri = 0; ri < 2; ++ri)
#pragma unroll
                    for (int sh = 0; sh < 2; ++sh)
#pragma unroll
                        for (int q4 = 0; q4 < 4; ++q4) { u32x2 w; w.x = cvtpk(bu[ri][sh][4 * q4], bu[ri][sh][4 * q4 + 1]); w.y = cvtpk(bu[ri][sh][4 * q4 + 2], bu[ri][sh][4 * q4 + 3]);
                            *(LAS u32x2*)(wl + (ri * 2 + sh) * 2048 + n * 64 + 8 * ((2 * q4 + hh) ^ xsw)) = w; }
                s16x4 t0, t1, t2, t3, t4, t5, t6, t7, t8, t9, t10, t11, t12, t13, t14, t15;
#define S5_TRL(o, off) "ds_read_b64_tr_b16 %" #o ", %16 offset:" #off "\n\t"
#define S5_TRH(o, off) "ds_read_b64_tr_b16 %" #o ", %17 offset:" #off "\n\t"
                asm volatile("s_waitcnt lgkmcnt(0)\n\t"
                             S5_TRL(0, 0) S5_TRH(1, 0) S5_TRL(2, 1024) S5_TRH(3, 1024) S5_TRL(4, 2048) S5_TRH(5, 2048) S5_TRL(6, 3072) S5_TRH(7, 3072)
                             S5_TRL(8, 4096) S5_TRH(9, 4096) S5_TRL(10, 5120) S5_TRH(11, 5120) S5_TRL(12, 6144) S5_TRH(13, 6144) S5_TRL(14, 7168) S5_TRH(15, 7168)
                             "s_waitcnt lgkmcnt(0)"
                             : "=&v"(t0), "=&v"(t1), "=&v"(t2), "=&v"(t3), "=&v"(t4), "=&v"(t5), "=&v"(t6), "=&v"(t7), "=&v"(t8), "=&v"(t9), "=&v"(t10), "=&v"(t11), "=&v"(t12), "=&v"(t13), "=&v"(t14), "=&v"(t15)
                             : "v"(tr_lo), "v"(tr_hi) : "memory");
#undef S5_TRL
#undef S5_TRH
#define S5_CAT(a, b) __builtin_shufflevector(a, b, 0, 1, 2, 3, 4, 5, 6, 7)
                f32x16 y0 = MFMA32(Cop[0][0][0], S5_CAT(t0, t1), zero16);   y0 = MFMA32(Cop[0][0][1], S5_CAT(t2, t3), y0);
                f32x16 y1 = MFMA32(Cop[0][1][0], S5_CAT(t4, t5), zero16);   y1 = MFMA32(Cop[0][1][1], S5_CAT(t6, t7), y1);
                f32x16 y2 = MFMA32(Cop[1][0][0], S5_CAT(t8, t9), zero16);   y2 = MFMA32(Cop[1][0][1], S5_CAT(t10, t11), y2);
                f32x16 y3 = MFMA32(Cop[1][1][0], S5_CAT(t12, t13), zero16); y3 = MFMA32(Cop[1][1][1], S5_CAT(t14, t15), y3);
#undef S5_CAT
                const u32x2 u_lo = *(const LAS u32x2*)(uimg + n * 32 + 8 * hh), u_hi = *(const LAS u32x2*)(uimg + n * 32 + 16 + 8 * hh);
                float zz[8];
#pragma unroll
                for (int i = 0; i < 8; ++i) {
                    const unsigned uw = (i < 4) ? (i < 2 ? u_lo.x : u_lo.y) : (i < 6 ? u_hi.x : u_hi.y);
                    const float uf = (i & 1) ? __uint_as_float(uw & 0xffff0000u) : __uint_as_float(uw << 16);
                    const float dd = (i < 4) ? d_lo[i & 3] : d_hi[i & 3];
                    const float y = (y0[i] + y1[i]) + (y2[i] + y3[i]) + dd * uf;
                    zz[i] = gelu_tanh(y);
                }
                if (c > 0 || (bp == 0 && bs == 0)) {
                    const size_t orow = (c == 0) ? arow_meta : arow_real + (size_t)16 * (c - 1);
                    bf16_t* zp = Z + orow * DM + g * 16 + 4 * hh;
                    u32x2 w0, w1; w0.x = cvtpk(zz[0], zz[1]); w0.y = cvtpk(zz[2], zz[3]); w1.x = cvtpk(zz[4], zz[5]); w1.y = cvtpk(zz[6], zz[7]);
                    *(u32x2*)zp = w0; *(u32x2*)(zp + 8) = w1;
                }
            };
            bf16x8 r0 = S5_LOADA(c_beg), r1 = S5_LOADA(min(c_beg + 1, cl));
            for (int c = c_beg; c < c_end; c += 2) {
                body2(r0, c); r0 = S5_LOADA(min(c + 2, cl));
                if (c + 1 < c_end) { body2(r1, c + 1); r1 = S5_LOADA(min(c + 3, cl)); }
            }
        }
        __syncthreads();
    }
#undef S5_LOADA
}

#define XB_TMO      128
#define XB_XCNT(j)  (256  + 64 * (j))
#define XB_XSUB(j)  (1280 + 64 * (j))
#define XB_XGEN(j)  (2304 + 64 * (j))
#define XB_TOP      3328
#define XB_TOPGEN   3392
#define XCD_BAR_WORDS 3456
#define XB_SPIN_CAP (1u << 18)

__device__ __forceinline__ unsigned xb_ld(unsigned* p)              { return __hip_atomic_load(p, __ATOMIC_RELAXED, __HIP_MEMORY_SCOPE_AGENT); }
__device__ __forceinline__ unsigned xb_add(unsigned* p, unsigned v) { return __hip_atomic_fetch_add(p, v, __ATOMIC_RELAXED, __HIP_MEMORY_SCOPE_AGENT); }
__device__ __forceinline__ unsigned xb_xcc_id() { return (unsigned)__builtin_amdgcn_s_getreg((3 << 11) | 20) & 0xFu; }
#define XB_SPIN(cond, bar) do { unsigned _sp = 0; while (cond) { __builtin_amdgcn_s_sleep(1); \
    if ((++_sp & 255u) == 0u) { if (xb_ld(&(bar)[XB_TMO])) break; if (_sp > XB_SPIN_CAP) { atomicAdd(&(bar)[XB_TMO], 1u); break; } } } } while (0)

struct XcdBarrier {
    unsigned* bar; unsigned x;
    volatile LAS unsigned* st;
};

__device__ __forceinline__ XcdBarrier xcd_barrier_post(unsigned* bar, volatile LAS unsigned* st) {
    XcdBarrier b; b.bar = bar; b.x = xb_xcc_id(); b.st = st;
    if (threadIdx.x == 0) (void)xb_add(&bar[XB_XCNT(b.x)], 1u);
    return b;
}
__device__ __forceinline__ void xcd_barrier_complete(unsigned* bar, unsigned x, unsigned& nloc, unsigned& nx) {
    const unsigned G = gridDim.x * gridDim.y * gridDim.z;
    unsigned sum, cnt, mine, sp = 0u;
    for (;;) {
        sum = 0u; cnt = 0u; mine = 0u;
#pragma unroll
        for (unsigned j = 0; j < 16; ++j) { const unsigned c = xb_ld(&bar[XB_XCNT(j)]); sum += c; cnt += (c > 0u) ? 1u : 0u; mine = (j == x) ? c : mine; }
        if (sum == G) break;
        __builtin_amdgcn_s_sleep(1);
        if ((++sp & 255u) == 0u) { if (xb_ld(&bar[XB_TMO])) break; if (sp > XB_SPIN_CAP) { atomicAdd(&bar[XB_TMO], 1u); break; } }
    }
    nloc = mine > 0u ? mine : 1u; nx = cnt > 0u ? cnt : 1u;
}

__device__ __forceinline__ void xcd_barrier(const XcdBarrier& b) {
    asm volatile("s_waitcnt vmcnt(0)" ::: "memory");
    __syncthreads();
    if (threadIdx.x == 0) {
        unsigned* bar = b.bar;
        __builtin_amdgcn_s_waitcnt(0);
        unsigned nloc = b.st[0], nx = b.st[1];
        if (nloc == 0u) { xcd_barrier_complete(bar, b.x, nloc, nx); b.st[0] = nloc; b.st[1] = nx; }
        const unsigned old = xb_add(&bar[XB_XSUB(b.x)], 1u);
        const unsigned gen = old / nloc;
        if (old + 1u == (gen + 1u) * nloc) {
            __builtin_amdgcn_fence(__ATOMIC_RELEASE, "agent");
            asm volatile("s_waitcnt vmcnt(0)" ::: "memory");
            const unsigned og = xb_add(&bar[XB_TOP], 1u);
            const unsigned tg = og / nx;
            if (og + 1u == (tg + 1u) * nx) xb_add(&bar[XB_TOPGEN], 1u);
            else XB_SPIN(xb_ld(&bar[XB_TOPGEN]) == tg, bar);
            __builtin_amdgcn_fence(__ATOMIC_ACQUIRE, "agent");
            xb_add(&bar[XB_XGEN(b.x)], 1u);
            asm volatile("s_waitcnt vmcnt(0)" ::: "memory");
        } else {
            XB_SPIN(xb_ld(&bar[XB_XGEN(b.x)]) == gen, bar);
            __builtin_amdgcn_fence(__ATOMIC_ACQUIRE, "agent");
            asm volatile("s_waitcnt vmcnt(0)" ::: "memory");
        }
    }
    __syncthreads();
}

constexpr float AT_STOP = 5.421011e-20f;
__device__ __forceinline__ void attn_phase(const Ptrs& P, LAS unsigned char* lds, bf16_t* Oout) {
    int tid = threadIdx.x; asm volatile("" : "+v"(tid));
    const int lane = tid & 63, wid = __builtin_amdgcn_readfirstlane(tid >> 6), n = lane & 31, hh = lane >> 5;
    unsigned char* ws = P.ws;
    const bf16_t* KB = (const bf16_t*)(ws + OFF_KB);
    const bf16_t* VB = (const bf16_t*)(ws + OFF_VT);
    bf16_t* QO = (bf16_t*)(ws + OFF_ZQ);
    LAS unsigned char* Kl = lds + wid * 10752;
    LAS unsigned char* Vl = Kl + 4608;
    const int lrow = 4 * (lane >> 3), lchk = lane & 7;
    LAS unsigned char* kst = Kl + lrow * 144 + lchk * 16;
    LAS unsigned char* vst = Vl + lrow * 192 + lchk * 16;
    const LAS unsigned char* kfr = Kl + n * 144 + 16 * hh;
    const unsigned vtr = (unsigned)(size_t)Vl + (unsigned)((4 * hh + ((lane & 15) >> 2)) * 192 + 32 * ((lane >> 4) & 1) + 8 * (lane & 3));
    const int vcu = (gridDim.x % 8 == 0) ? (blockIdx.x % 8) * (gridDim.x / 8) + blockIdx.x / 8 : blockIdx.x;
    const int gw = vcu * 8 + wid, NGW = gridDim.x * 8;
    constexpr int NREAL = NB * NHEAD * 128;
    for (int u = gw; u < NREAL; u += NGW) {
        constexpr bool metaq = false;
        const int qt = metaq ? -1 : (u & 127), h = metaq ? (u - NREAL) : ((u >> 7) & 15), b = metaq ? 0 : (u >> 11);
        const int qrow0 = metaq ? MR : b * SEQ + 32 * qt;
        auto issue = [&](u32x4& k0, u32x4& k1, u32x4& k2, u32x4& k3, u32x4& v0, u32x4& v1, u32x4& v2, u32x4& v3, const int kt_) __attribute__((always_inline)) {
            const int krow0 = kt_ >= 0 ? b * SEQ + 32 * kt_ : MR;
            const size_t off = (size_t)(krow0 + lrow + 2) * DM + h * 64 + lchk * 8;
            const bf16_t* kp = KB + off; const bf16_t* vp = VB + off;
            asm volatile("global_load_dwordx4 %0, %8, off offset:-4096\n\t"
                         "global_load_dwordx4 %1, %8, off offset:-2048\n\t"
                         "global_load_dwordx4 %2, %8, off\n\t"
                         "global_load_dwordx4 %3, %8, off offset:2048\n\t"
                         "global_load_dwordx4 %4, %9, off offset:-4096\n\t"
                         "global_load_dwordx4 %5, %9, off offset:-2048\n\t"
                         "global_load_dwordx4 %6, %9, off\n\t"
                         "global_load_dwordx4 %7, %9, off offset:2048"
                         : "=&v"(k0), "=&v"(k1), "=&v"(k2), "=&v"(k3), "=&v"(v0), "=&v"(v1), "=&v"(v2), "=&v"(v3)
                         : "v"(kp), "v"(vp) : "memory");
        };
        u32x4 ak0, ak1, ak2, ak3, av0, av1, av2, av3;
#define AT_PREV(k) ((k) > 0 ? (k) - 1 : -1)
        int kt = qt;
        issue(ak0, ak1, ak2, ak3, av0, av1, av2, av3, kt);
        bf16x8 qf[4];
#pragma unroll
        for (int s = 0; s < 4; ++s) qf[s] = *(const bf16x8*)(QO + (size_t)(qrow0 + n) * DM + h * 64 + 16 * s + 8 * hh);
        asm volatile("" :: "v"(qf[0]), "v"(qf[1]), "v"(qf[2]), "v"(qf[3]));
        f32x16 o0, o1;
#pragma unroll
        for (int i = 0; i < 16; ++i) { o0[i] = 0.f; o1[i] = 0.f; }
        float Rl = 1.f;
        const int metalim = metaq ? (n < 16 ? n : 16) : 16;
        auto stage = [&](const u32x4& k0, const u32x4& k1, const u32x4& k2, const u32x4& k3, const u32x4& v0, const u32x4& v1, const u32x4& v2, const u32x4& v3) __attribute__((always_inline)) {
            *(LAS u32x4*)(kst) = k0; *(LAS u32x4*)(kst + 144) = k1; *(LAS u32x4*)(kst + 288) = k2; *(LAS u32x4*)(kst + 432) = k3;
            *(LAS u32x4*)(vst) = v0; *(LAS u32x4*)(vst + 192) = v1; *(LAS u32x4*)(vst + 384) = v2; *(LAS u32x4*)(vst + 576) = v3;
        };
        auto compute = [&](const int kt_, auto MT) __attribute__((always_inline)) -> bool {
            constexpr bool MASKED = decltype(MT)::value;
            f32x16 z;
#pragma unroll
            for (int i = 0; i < 16; ++i) z[i] = 0.f;
#pragma unroll
            for (int s = 0; s < 4; ++s) z = MFMA32(*(const LAS bf16x8*)(kfr + 32 * s), qf[s], z);
            const int lim = kt_ < 0 ? metalim : n;
            f32x2_t be[8], om[8];
#pragma unroll
            for (int p = 0; p < 8; ++p) {
                f32x2_t e; e.x = __builtin_amdgcn_exp2f(z[2 * p]); e.y = __builtin_amdgcn_exp2f(z[2 * p + 1]);
                const f32x2_t d = e + 1.0f;
                f32x2_t bt; bt.x = frcp(d.x); bt.y = frcp(d.y);
                f32x2_t o1m = 1.0f - bt;
                if (MASKED) {
                    const int j0 = ((2 * p) & 3) + 8 * ((2 * p) >> 2) + 4 * hh;
                    if (!(j0 < lim)) { bt.x = 0.f; o1m.x = 1.f; }
                    if (!(j0 + 1 < lim)) { bt.y = 0.f; o1m.y = 1.f; }
                }
                be[p] = bt; om[p] = o1m;
            }
            float qp[4], th[4];
#pragma unroll
            for (int a = 0; a < 4; ++a) { const f32x2_t t = om[2 * a] * om[2 * a + 1]; qp[a] = t.x * t.y; th[a] = __shfl_xor(qp[a], 32); }
            float G[8];
#pragma unroll
            for (int a = 0; a < 4; ++a) { G[2 * a] = hh ? th[a] : qp[a]; G[2 * a + 1] = hh ? qp[a] : th[a]; }
            const float sf7 = 1.f, sf6 = G[7], sf5 = sf6 * G[6], sf4 = sf5 * G[5], sf3 = sf4 * G[4], sf2 = sf3 * G[3], sf1 = sf2 * G[2], sf0 = sf1 * G[1];
            const float total = sf0 * G[0];
            const float sm0 = hh ? sf1 : sf0, sm1 = hh ? sf3 : sf2, sm2 = hh ? sf5 : sf4, sm3 = hh ? sf7 : sf6;
            f32x2_t w[8];
#define AT_W(a, SM) do { const float e3 = Rl * (SM), e2 = e3 * om[2 * (a) + 1].y, e1 = e2 * om[2 * (a) + 1].x, e0 = e1 * om[2 * (a)].y; \
                w[2 * (a)] = be[2 * (a)] * (f32x2_t){e0, e1}; w[2 * (a) + 1] = be[2 * (a) + 1] * (f32x2_t){e2, e3}; } while (0)
            AT_W(0, sm0); AT_W(1, sm1); AT_W(2, sm2); AT_W(3, sm3);
#undef AT_W
            Rl *= total;
            s16x4 t0, t1, t2, t3, t4, t5, t6, t7;
            asm volatile("ds_read_b64_tr_b16 %0, %8\n\t"
                         "ds_read_b64_tr_b16 %1, %8 offset:1536\n\t"
                         "ds_read_b64_tr_b16 %2, %8 offset:3072\n\t"
                         "ds_read_b64_tr_b16 %3, %8 offset:4608\n\t"
                         "ds_read_b64_tr_b16 %4, %8 offset:64\n\t"
                         "ds_read_b64_tr_b16 %5, %8 offset:1600\n\t"
                         "ds_read_b64_tr_b16 %6, %8 offset:3136\n\t"
                         "ds_read_b64_tr_b16 %7, %8 offset:4672\n\t"
                         "s_waitcnt lgkmcnt(0)"
                         : "=&v"(t0), "=&v"(t1), "=&v"(t2), "=&v"(t3), "=&v"(t4), "=&v"(t5), "=&v"(t6), "=&v"(t7) : "v"(vtr) : "memory");
#define AT_CAT(a, b) __builtin_shufflevector(a, b, 0, 1, 2, 3, 4, 5, 6, 7)
            {
                u32x4 pw; pw.x = cvtpk(w[0].x, w[0].y); pw.y = cvtpk(w[1].x, w[1].y); pw.z = cvtpk(w[2].x, w[2].y); pw.w = cvtpk(w[3].x, w[3].y);
                const bf16x8 pf = __builtin_bit_cast(bf16x8, pw);
                o0 = MFMA32(AT_CAT(t0, t1), pf, o0); o1 = MFMA32(AT_CAT(t4, t5), pf, o1);
            }
            {
                u32x4 pw; pw.x = cvtpk(w[4].x, w[4].y); pw.y = cvtpk(w[5].x, w[5].y); pw.z = cvtpk(w[6].x, w[6].y); pw.w = cvtpk(w[7].x, w[7].y);
                const bf16x8 pf = __builtin_bit_cast(bf16x8, pw);
                o0 = MFMA32(AT_CAT(t2, t3), pf, o0); o1 = MFMA32(AT_CAT(t6, t7), pf, o1);
            }
#undef AT_CAT
            return kt_ < 0 || __all(Rl < AT_STOP);
        };
#define AT_COMPUTE(kt_) (((kt_) < 0 || (kt_) == qt) ? compute((kt_), std::true_type{}) : compute((kt_), std::false_type{}))
#define AT_WAIT(N, k0, k1, k2, k3, v0, v1, v2, v3) asm volatile("s_waitcnt vmcnt(" #N ")" : "+v"(k0), "+v"(k1), "+v"(k2), "+v"(k3), "+v"(v0), "+v"(v1), "+v"(v2), "+v"(v3) :: "memory")
        for (;;) {
            AT_WAIT(0, ak0, ak1, ak2, ak3, av0, av1, av2, av3);
            stage(ak0, ak1, ak2, ak3, av0, av1, av2, av3);
            issue(ak0, ak1, ak2, ak3, av0, av1, av2, av3, AT_PREV(kt));
            if (AT_COMPUTE(kt)) break;
            kt = AT_PREV(kt);
        }
#undef AT_PREV
#undef AT_COMPUTE
        AT_WAIT(0, ak0, ak1, ak2, ak3, av0, av1, av2, av3);
#undef AT_WAIT
        if (!metaq || n < 16) {
            bf16_t* op = Oout + (size_t)(qrow0 + n) * DM + h * 64 + 4 * hh;
#pragma unroll
            for (int a = 0; a < 4; ++a) {
                u32x2 w0; w0.x = cvtpk(o0[4 * a], o0[4 * a + 1]); w0.y = cvtpk(o0[4 * a + 2], o0[4 * a + 3]);
                u32x2 w1; w1.x = cvtpk(o1[4 * a], o1[4 * a + 1]); w1.y = cvtpk(o1[4 * a + 2], o1[4 * a + 3]);
                *(u32x2*)(op + 8 * a) = w0; *(u32x2*)(op + 32 + 8 * a) = w1;
            }
        }
    }
}

__device__ __forceinline__ void final_phase(const Ptrs& P) {
    int tid = threadIdx.x; asm volatile("" : "+v"(tid));
    const int lane = tid & 63, wid = tid >> 6;
    const bf16_t* XB = (const bf16_t*)(P.ws + OFF_XB);
    const u64* ss3 = (const u64*)(P.ws + OFF_SS) + 3 * MP;
    const float* gain = P.in[19];
    f32x4 gv[4];
#pragma unroll
    for (int j = 0; j < 4; ++j) gv[j] = *(const f32x4*)(gain + 4 * lane + 256 * j);
    const int gw = blockIdx.x * 8 + wid, NGW = gridDim.x * 8;
    for (int row = gw; row < MR; row += NGW) {
        const float rs = rstd_of(ss3[row]);
#pragma unroll
        for (int j = 0; j < 4; ++j) { const u32x2 hb = __builtin_nontemporal_load((const u32x2*)(XB + (size_t)row * DM + 4 * lane + 256 * j));
            const f32x4 v = {__uint_as_float(hb.x << 16), __uint_as_float(hb.x & 0xffff0000u), __uint_as_float(hb.y << 16), __uint_as_float(hb.y & 0xffff0000u)};
            __builtin_nontemporal_store(v * rs * gv[j], (f32x4*)(P.out + (size_t)row * DM + 4 * lane + 256 * j)); }
    }
}

#ifndef REP_P0
#define REP_P0 1
#endif
#ifndef REP_S5
#define REP_S5 1
#endif
#ifndef REP_ATT
#define REP_ATT 1
#endif
#ifndef REP_SYNC
#define REP_SYNC 0
#endif
#ifndef REP_FI
#define REP_FI 1
#endif
#ifndef REP_FI_CHEAP
#define REP_FI_CHEAP 0
#endif
#ifndef REP_FIN
#define REP_FIN 1
#endif
constexpr int LDS_BYTES = 131072 + 256;
__global__ void __launch_bounds__(512, 2) s5yoco_fwd(Ptrs P) {
    extern __shared__ __attribute__((aligned(16))) unsigned char lds_raw[];
    LAS unsigned char* lds = (LAS unsigned char*)lds_raw;
    cg::grid_group grid = cg::this_grid();
    unsigned char* ws = P.ws;
    u64* ss = (u64*)(ws + OFF_SS);
    bf16_t* XB = (bf16_t*)(ws + OFF_XB); float* H = (float*)(ws + OFF_H); bf16_t* ZQ = (bf16_t*)(ws + OFF_ZQ); bf16_t* ACT = (bf16_t*)(ws + OFF_ACT);
    const int G = gridDim.x, c = blockIdx.x;
    StaticOrder S;
    volatile LAS unsigned* bst = (volatile LAS unsigned*)(lds + 131072);
    if (threadIdx.x < 2) bst[threadIdx.x] = 0u;
    __syncthreads();
    const XcdBarrier gbar = xcd_barrier_post((unsigned*)(ws + OFF_BAR), bst);
    if (ws == nullptr) grid.sync();
#define GSYNC() xcd_barrier(gbar)

#if REP_P0 >= 2
    p0_prologue(P, lds);
#endif
    p0_prologue(P, lds);
    GSYNC();
    for (int rep = 0; rep < REP_S5; ++rep) s5_phase(P, lds);
    GSYNC();
    bf16_t* KBp = (bf16_t*)(ws + OFF_KB); bf16_t* VTp = (bf16_t*)(ws + OFF_VT);
    {
        S.init(MR, 2048, G, c);
        EpiGLU E{(const float*)(ws + OFF_INV0), XB, ss};
        pg8::gemm_phase<EpiGLU, StaticOrder, true, true>(lds, Gemm{ZQ, (const bf16_t*)(ws + W_GLU), MR, 2048, 1024}, S, E);
        meta_gemm<0, true, 1024>(lds, ZQ + (size_t)MR * DM, (const bf16_t*)(ws + W_GLU), 64, P.in[1], H, XB, nullptr, nullptr, nullptr, ss, nullptr);
    }
    GSYNC();
    {
        S.init(MR, 5632, G, c);
#if REP_FI_CHEAP
        { EpiSwiGLU<true> Ec{ss, ACT}; pg8::gemm_phase<EpiSwiGLU<true>, StaticOrder, true, true>(lds, Gemm{XB, (const bf16_t*)(ws + W_FI0), MR, 5632, 1024}, S, Ec); }
#endif
        EpiSwiGLU<false> E{ss, ACT};
#if REP_FI >= 2
        pg8::gemm_phase<EpiSwiGLU<false>, StaticOrder, true, true>(lds, Gemm{XB, (const bf16_t*)(ws + W_FI0), MR, 5632, 1024}, S, E);
#endif
        pg8::gemm_phase<EpiSwiGLU<false>, StaticOrder, true, true>(lds, Gemm{XB, (const bf16_t*)(ws + W_FI0), MR, 5632, 1024}, S, E);
        meta_gemm<1, false, 1024>(lds, XB + (size_t)MR * DM, (const bf16_t*)(ws + W_FI0), 176, nullptr, nullptr, nullptr, ACT, nullptr, nullptr, nullptr, ss);
    }
    GSYNC();
    {
        S.init(MR, 1024, G, c);
        EpiResid<true> E{XB, ss + MP};
        pg8::gemm_phase<EpiResid<true>, StaticOrder, true, true>(lds, Gemm{ACT, (const bf16_t*)(ws + W_FO0), MR, 1024, DFF}, S, E);
        meta_gemm<2, true, DFF>(lds, ACT + (size_t)MR * DFF, (const bf16_t*)(ws + W_FO0), 64, nullptr, H, XB, nullptr, nullptr, nullptr, ss + MP, nullptr);
    }
    GSYNC();
    {
        S.init(MR, 3072, G, c);
        EpiKQ E{ss + MP, ZQ};
        pg8::gemm_phase<EpiKQ, StaticOrder, true, true>(lds, Gemm{XB, (const bf16_t*)(ws + W_KQ), MR, 3072, 1024}, S, E);
        meta_gemm<3, false, 1024>(lds, XB + (size_t)MR * DM, (const bf16_t*)(ws + W_KQ), 192, nullptr, nullptr, nullptr, KBp, ZQ, VTp, nullptr, ss + MP);
    }
    GSYNC();
    for (int rep = 1; rep < REP_ATT; ++rep) attn_phase(P, lds, (bf16_t*)(ws + OFF_H));
    attn_phase(P, lds, ZQ);
    GSYNC();
    {
        S.init(MR, 1024, G, c);
        EpiResid<true> E{XB, ss + 2 * MP};
        pg8::gemm_phase<EpiResid<true>, StaticOrder, true, true>(lds, Gemm{ZQ, (const bf16_t*)(ws + W_O), MR, 1024, 1024}, S, E);
    }
    GSYNC();
    {
        S.init(MR, 5632, G, c);
        EpiSwiGLU<false> E{ss + 2 * MP, ACT};
        pg8::gemm_phase<EpiSwiGLU<false>, StaticOrder, true, true>(lds, Gemm{XB, (const bf16_t*)(ws + W_FI1), MR, 5632, 1024}, S, E);
    }
    GSYNC();
    {
        S.init(MR, 1024, G, c);
        EpiResid<false> E{XB, ss + 3 * MP};
        pg8::gemm_phase<EpiResid<false>, StaticOrder, true, true>(lds, Gemm{ACT, (const bf16_t*)(ws + W_FO1), MR, 1024, DFF}, S, E);
    }
    GSYNC();
    for (int rep = 0; rep < REP_SYNC; ++rep) GSYNC();
    for (int rep = 0; rep < REP_FIN; ++rep) final_phase(P);
}

extern "C" void kernel_launch(void* const* d_in, const int* in_sizes, int n_in, void* d_out, int out_size, void* d_ws, size_t ws_size, hipStream_t stream) {
    static int grid = 0;
    if (grid == 0) {
        if (n_in != 20 || ws_size < WS_END) { fprintf(stderr, "kernel_launch: unexpected problem (n_in %d, ws %zu < %zu)\n", n_in, ws_size, (size_t)WS_END); grid = -1; return; }
        int dev = 0, cus = 0, per_cu = 0;
        hipGetDevice(&dev);
        hipDeviceGetAttribute(&cus, hipDeviceAttributeMultiprocessorCount, dev);
        if (hipFuncSetAttribute((const void*)s5yoco_fwd, hipFuncAttributeMaxDynamicSharedMemorySize, LDS_BYTES) != hipSuccess) { fprintf(stderr, "kernel_launch: hipFuncSetAttribute failed\n"); grid = -1; return; }
        if (hipOccupancyMaxActiveBlocksPerMultiprocessor(&per_cu, (const void*)s5yoco_fwd, 512, LDS_BYTES) != hipSuccess || per_cu < 1) { fprintf(stderr, "kernel_launch: occupancy query says %d\n", per_cu); per_cu = 1; }
        (void)hipGetLastError();
        grid = cus;
    }
    if (grid < 0) return;
    if (hipMemsetAsync((char*)d_ws + OFF_BAR, 0, 16384, stream) != hipSuccess) { fprintf(stderr, "kernel_launch: memset failed\n"); return; }
    Ptrs p{};
    for (int i = 0; i < 20; ++i) p.in[i] = (const float*)d_in[i];
    p.out = (float*)d_out; p.ws = (unsigned char*)d_ws;
    void* args[] = {&p};
    hipError_t e = hipLaunchCooperativeKernel((const void*)s5yoco_fwd, dim3(grid), dim3(512), args, LDS_BYTES, stream);
    if (e != hipSuccess) fprintf(stderr, "cooperative launch failed: %s (grid %d)\n", hipGetErrorString(e), grid);
}
```

```cpp
#include <hip/hip_runtime.h>
#include <hip/hip_cooperative_groups.h>
#include <cstdio>
#include <cstdint>
#include <type_traits>
namespace cg = cooperative_groups;
namespace pg8 {
#define PG8_LAS __attribute__((address_space(3)))
typedef unsigned short bf16_t;
typedef short bf16x8 __attribute__((ext_vector_type(8)));
typedef float f32x4 __attribute__((ext_vector_type(4)));
typedef unsigned u32x4 __attribute__((ext_vector_type(4)));
constexpr int BM = 256, BK = 64, HALF = 128, HTB = HALF * BK * 2  , STAGE_BYTES = 8 * HTB, NXCD = 8, WGM = 8;

__host__ __device__ __forceinline__ int lds_byte(int r, int c) { const int st = (r >> 4) * 2 + (c >> 5), rr = r & 15, cc = c & 31, ob = rr * 64 + cc * 2; return st * 1024 + (ob ^ (((ob >> 9) & 1) << 5)); }
__host__ __device__ __forceinline__ void stage_rc(int b, int& R, int& C) { const int st = b / 1024, sb = b % 1024, swz = sb ^ (((sb >> 9) & 1) << 5); R = (st >> 1) * 16 + swz / 64; C = (st & 1) * 32 + (swz % 64) / 2; }
__host__ __device__ __forceinline__ int perm32(int rho) { const int n = rho >> 4, i = rho & 15; return 8 * (i >> 2) + 4 * n + (i & 3); }

struct Unit { int pm, pn; };
struct Gemm { const bf16_t* A; const bf16_t* Bt; int M, N, K; };

struct StaticOrder {
    int nM, nN, nwg, G, c;
    __host__ __device__ void init(int M, int N, int G_, int c_) { nM = M / BM; nN = N / BM; nwg = nM * nN; G = G_; c = c_; }
    __host__ __device__ bool next(int i, Unit& u) const {
        const long L = (long)i * G + c; if (L >= nwg) return false;
        int wgid = (int)L; { const int q = nwg / NXCD, r = nwg % NXCD, xcd = wgid % NXCD, off = wgid / NXCD; wgid = (xcd < r ? xcd * (q + 1) : r * (q + 1) + (xcd - r) * q) + off; }
        const int nig = WGM * nN, gid = wgid / nig, fm = gid * WGM, gsz = (nM - fm) < WGM ? (nM - fm) : WGM;
        u.pm = fm + ((wgid % nig) % gsz); u.pn = (wgid % nig) / gsz; return true;
    }
    __device__ __forceinline__ void a_ready(const Unit&) const {}
    __device__ __forceinline__ void done(const Unit&) const {}
};
typedef float f32x2 __attribute__((ext_vector_type(2)));

template <class Epi, class Sched, bool ALIGN_EPI = false, bool SP2 = false>
__device__ __forceinline__ void gemm_phase(PG8_LAS unsigned char* lds, const Gemm g, const Sched& S, const Epi& E) {
    const int tid = threadIdx.x, wid = __builtin_amdgcn_readfirstlane(tid >> 6), lane = tid & 63, wr = wid >> 2, wc = wid & 3, fr = lane & 15, fq = lane >> 4;
    const int K = g.K, nt = K / BK;
    unsigned voffA[2], voffB[2];
#pragma unroll
    for (int i = 0; i < 2; ++i) { int R, C; stage_rc(tid * 16 + i * 8192, R, C); const int Rb = Epi::PERM ? ((R & ~31) + perm32(R & 31)) : R;
        voffA[i] = (unsigned)(R * K + C) * 2u; voffB[i] = (unsigned)(Rb * K + C) * 2u; }
    const size_t kstep = (size_t)(BK * 2);
    const size_t hstep = (size_t)HALF * K * 2;
    const size_t tstep = 2 * hstep;
    const unsigned ldsw = (unsigned)wid * 1024u;
    const int aoff = lds_byte(wr * 64 + fr, fq * 8), boff = lds_byte(wc * 32 + fr, fq * 8);
#define PG8_SA(b, h) (((b) * 2 + (h)) * HTB)
#define PG8_SB(b, h) ((4 + (b) * 2 + (h)) * HTB)
#define PG8_STAGE(bufoff, gbase, voff) do { _Pragma("unroll") for (int _i = 0; _i < 2; ++_i) \
        __builtin_amdgcn_global_load_lds((const unsigned*)((const char*)(gbase) + (voff)[_i]), (PG8_LAS unsigned*)(lds + (bufoff) + ldsw + _i * 8192), 16, 0, 0); } while (0)
#define PG8_LDA(dst, b, h) do { _Pragma("unroll") for (int m = 0; m < 4; ++m) _Pragma("unroll") for (int k = 0; k < 2; ++k) dst[m][k] = *(const PG8_LAS bf16x8*)(lds + PG8_SA(b, h) + aoff + m * 2048 + k * 1024); } while (0)
#define PG8_LDB(dst, b, h) do { _Pragma("unroll") for (int n = 0; n < 2; ++n) _Pragma("unroll") for (int k = 0; k < 2; ++k) dst[n][k] = *(const PG8_LAS bf16x8*)(lds + PG8_SB(b, h) + boff + n * 2048 + k * 1024); } while (0)
#define PG8_MMA(ai, bj, At, Bt) do { __builtin_amdgcn_s_setprio(1); _Pragma("unroll") for (int m = 0; m < 4; ++m) _Pragma("unroll") for (int n = 0; n < 2; ++n) _Pragma("unroll") for (int k = 0; k < 2; ++k) \
        acc[ai][bj][m][n] = __builtin_amdgcn_mfma_f32_16x16x32_bf16(Bt[n][k], At[m][k], acc[ai][bj][m][n], 0, 0, 0); __builtin_amdgcn_s_setprio(0); } while (0)
#define PG8_WAIT_V(n) asm volatile("s_waitcnt vmcnt(" #n ")" ::: "memory")
#define PG8_WAIT_L(n) asm volatile("s_waitcnt lgkmcnt(" #n ")" ::: "memory")
#define PG8_BAR __builtin_amdgcn_s_barrier()
#define PG8_SCHED __builtin_amdgcn_sched_barrier(0)
    Unit cur, nxt; int ui = 0;
    if (!S.next(0, cur)) return;
    f32x4 acc[2][2][4][2];
#pragma unroll
    for (int a = 0; a < 2; ++a)
#pragma unroll
        for (int b = 0; b < 2; ++b)
#pragma unroll
            for (int m = 0; m < 4; ++m)
#pragma unroll
                for (int n = 0; n < 2; ++n) acc[a][b][m][n] = (f32x4){0.f, 0.f, 0.f, 0.f};
    bf16x8 At[4][2], B0[2][2], B1[2][2];
    const char* cA = (const char*)g.A + (size_t)cur.pm * tstep; const char* cB = (const char*)g.Bt + (size_t)cur.pn * tstep;
    S.a_ready(cur);
    if constexpr (SP2) {
        PG8_STAGE(PG8_SB(0, 0), cB, voffB); PG8_STAGE(PG8_SB(0, 1), cB + hstep, voffB); PG8_STAGE(PG8_SA(0, 0), cA, voffA); PG8_STAGE(PG8_SA(0, 1), cA + hstep, voffA);
        if (wr == 1) PG8_BAR;
        PG8_WAIT_V(2); PG8_BAR;
        PG8_STAGE(PG8_SB(1, 0), cB + kstep, voffB); PG8_STAGE(PG8_SA(1, 0), cA + kstep, voffA); PG8_STAGE(PG8_SB(1, 1), cB + hstep + kstep, voffB);
        PG8_WAIT_V(6); PG8_BAR;
    } else {
        PG8_STAGE(PG8_SB(0, 0), cB, voffB); PG8_STAGE(PG8_SA(0, 0), cA, voffA); PG8_STAGE(PG8_SB(0, 1), cB + hstep, voffB); PG8_STAGE(PG8_SA(0, 1), cA + hstep, voffA);
        if (wr == 1) PG8_BAR;
        PG8_WAIT_V(4); PG8_BAR;
        PG8_STAGE(PG8_SB(1, 0), cB + kstep, voffB); PG8_STAGE(PG8_SA(1, 0), cA + kstep, voffA); PG8_STAGE(PG8_SB(1, 1), cB + hstep + kstep, voffB);
        PG8_WAIT_V(6); PG8_BAR;
    }
    for (;;) {
        const bool has_next = S.next(ui + 1, nxt);
        const char* nA = has_next ? (const char*)g.A + (size_t)nxt.pm * tstep : cA; const char* nB = has_next ? (const char*)g.Bt + (size_t)nxt.pn * tstep : cB;
        for (int t = 0; t < nt; t += 2) {
            const bool last = (t == nt - 2);
            const char* a1 = cA + (size_t)(t + 1) * kstep;
            const char* a2 = last ? nA : cA + (size_t)(t + 2) * kstep; const char* b2 = last ? nB : cB + (size_t)(t + 2) * kstep;
            const char* a3 = a2 + kstep; const char* b3 = b2 + kstep;
            if (last && has_next) S.a_ready(nxt);
            if constexpr (SP2) {
            PG8_LDB(B0, 0, 0); PG8_LDB(B1, 0, 1); PG8_SCHED; PG8_LDA(At, 0, 0); PG8_STAGE(PG8_SA(1, 1), a1 + hstep, voffA);
            PG8_WAIT_V(8); PG8_WAIT_L(0); PG8_BAR; PG8_MMA(0, 0, At, B0); PG8_MMA(0, 1, At, B1); PG8_BAR; PG8_SCHED;
            PG8_LDA(At, 0, 1); PG8_STAGE(PG8_SB(0, 0), b2, voffB); PG8_STAGE(PG8_SB(0, 1), b2 + hstep, voffB); PG8_STAGE(PG8_SA(0, 0), a2, voffA);
            PG8_WAIT_V(8); PG8_WAIT_L(0); PG8_BAR; PG8_MMA(1, 0, At, B0); PG8_MMA(1, 1, At, B1); PG8_BAR; PG8_SCHED;
            PG8_LDB(B0, 1, 0); PG8_LDB(B1, 1, 1); PG8_SCHED; PG8_LDA(At, 1, 0); PG8_STAGE(PG8_SA(0, 1), a2 + hstep, voffA);
            PG8_WAIT_V(8); PG8_WAIT_L(0); PG8_BAR; PG8_MMA(0, 0, At, B0); PG8_MMA(0, 1, At, B1); PG8_BAR; PG8_SCHED;
            PG8_LDA(At, 1, 1); PG8_STAGE(PG8_SB(1, 0), b3, voffB); PG8_STAGE(PG8_SB(1, 1), b3 + hstep, voffB); PG8_STAGE(PG8_SA(1, 0), a3, voffA);
            PG8_WAIT_V(8); PG8_WAIT_L(0); PG8_BAR; PG8_MMA(1, 0, At, B0); PG8_MMA(1, 1, At, B1); PG8_BAR; PG8_SCHED;
            } else {
            PG8_LDB(B0, 0, 0); PG8_SCHED; PG8_LDA(At, 0, 0); PG8_STAGE(PG8_SA(1, 1), a1 + hstep, voffA);
            PG8_WAIT_L(8); PG8_BAR; PG8_WAIT_L(0); PG8_MMA(0, 0, At, B0); PG8_BAR; PG8_SCHED;
            PG8_LDB(B1, 0, 1); PG8_STAGE(PG8_SB(0, 0), b2, voffB);
            PG8_BAR; PG8_WAIT_L(0); PG8_MMA(0, 1, At, B1); PG8_BAR;
            PG8_LDA(At, 0, 1); PG8_STAGE(PG8_SA(0, 0), a2, voffA);
            PG8_BAR; PG8_WAIT_L(0); PG8_MMA(1, 0, At, B0); PG8_BAR; PG8_SCHED;
            PG8_STAGE(PG8_SB(0, 1), b2 + hstep, voffB);
            PG8_WAIT_V(6); PG8_BAR; PG8_MMA(1, 1, At, B1); PG8_BAR;
            PG8_LDB(B0, 1, 0); PG8_SCHED; PG8_LDA(At, 1, 0); PG8_STAGE(PG8_SA(0, 1), a2 + hstep, voffA);
            PG8_WAIT_L(8); PG8_BAR; PG8_WAIT_L(0); PG8_MMA(0, 0, At, B0); PG8_BAR; PG8_SCHED;
            PG8_LDB(B1, 1, 1); PG8_STAGE(PG8_SB(1, 0), b3, voffB);
            PG8_BAR; PG8_WAIT_L(0); PG8_MMA(0, 1, At, B1); PG8_BAR;
            PG8_LDA(At, 1, 1); PG8_STAGE(PG8_SA(1, 0), a3, voffA);
            PG8_BAR; PG8_WAIT_L(0); PG8_MMA(1, 0, At, B0); PG8_BAR; PG8_SCHED;
            PG8_STAGE(PG8_SB(1, 1), b3 + hstep, voffB);
            PG8_WAIT_V(6); PG8_BAR; PG8_MMA(1, 1, At, B1); PG8_BAR;
            }
        }
        if constexpr (ALIGN_EPI) { if (wr == 0) PG8_BAR; }
        if constexpr (!Epi::AFTER_DRAIN) { E(acc, cur, wr, wc, fr, fq); S.done(cur); }
        if (!has_next) break;
#pragma unroll
        for (int a = 0; a < 2; ++a)
#pragma unroll
            for (int b = 0; b < 2; ++b)
#pragma unroll
                for (int m = 0; m < 4; ++m)
#pragma unroll
                    for (int n = 0; n < 2; ++n) acc[a][b][m][n] = (f32x4){0.f, 0.f, 0.f, 0.f};
        cur = nxt; cA = nA; cB = nB; ++ui;
        if constexpr (ALIGN_EPI) { if (wr == 1) PG8_BAR; }
    }
    PG8_WAIT_V(0);
    if constexpr (!ALIGN_EPI) { if (wr == 0) PG8_BAR; }
    PG8_BAR;
    if constexpr (Epi::AFTER_DRAIN) { E.fused(acc, cur, wr, wc, fr, fq, lds, wid, lane); S.done(cur); }
#undef PG8_SA
#undef PG8_SB
#undef PG8_STAGE
#undef PG8_LDA
#undef PG8_LDB
#undef PG8_MMA
#undef PG8_WAIT_V
#undef PG8_WAIT_L
#undef PG8_BAR
#undef PG8_SCHED
}
}

using pg8::bf16_t; using pg8::bf16x8; using pg8::f32x4; using pg8::Unit; using pg8::Gemm; using pg8::StaticOrder;
#define LAS __attribute__((address_space(3)))
typedef float f32x16 __attribute__((ext_vector_type(16)));
typedef short s16x4 __attribute__((ext_vector_type(4)));
typedef unsigned u32x2 __attribute__((ext_vector_type(2)));
typedef unsigned u32x4 __attribute__((ext_vector_type(4)));
typedef float f32x2_t __attribute__((ext_vector_type(2)));
typedef __bf16 bf16x2_t __attribute__((ext_vector_type(2)));
typedef unsigned long long u64;

constexpr int NB = 8, SEQ = 4096, NMETA = 16, DM = 1024, DFF = 2816, NHEAD = 16;
constexpr int MR = NB * SEQ;
constexpr int MROWS = MR + NMETA;
constexpr int MP = 33024;
constexpr float QSCALE = -0.125f * 1.4426950408889634f;
constexpr float SS_SCALE = 1048576.0f;

constexpr size_t OFF_SS = 0;
constexpr size_t OFF_BAR = 0x108000;
constexpr size_t OFF_S5 = 0x110000;
constexpr size_t S5_ABAR = OFF_S5;
constexpr size_t S5_BB = OFF_S5 + 0x8000;
constexpr size_t S5_CB = S5_BB + 0x40000;
constexpr size_t S5_DG = S5_CB + 0x40000;
constexpr size_t OFF_INV0 = 0x1A0000;
constexpr size_t OFF_W = 0x210000;
constexpr size_t W_GLU = OFF_W;
constexpr size_t W_FI0 = W_GLU + 2048ull * 1024 * 2;
constexpr size_t W_FI1 = W_FI0 + 5632ull * 1024 * 2;
constexpr size_t W_FO0 = W_FI1 + 5632ull * 1024 * 2;
constexpr size_t W_FO1 = W_FO0 + 1024ull * 2816 * 2;
constexpr size_t W_KQ = W_FO1 + 1024ull * 2816 * 2;
constexpr size_t W_V = W_KQ + 2048ull * 1024 * 2;
constexpr size_t W_O = W_V + 1024ull * 1024 * 2;
constexpr size_t OFF_XB = W_O + 1024ull * 1024 * 2;
constexpr size_t OFF_H = OFF_XB + (size_t)MP * 1024 * 2;
constexpr size_t OFF_W1 = OFF_H;
constexpr size_t OFF_ZQ = OFF_H + (size_t)MP * 1024 * 4;
constexpr size_t OFF_KB = OFF_ZQ + (size_t)MP * 1024 * 2;
constexpr size_t OFF_VT = OFF_KB + (size_t)MP * 1024 * 2;
constexpr size_t OFF_ACT = OFF_ZQ;
constexpr size_t WS_END = OFF_VT + (size_t)MP * 1024 * 2;
static_assert((size_t)MP * DFF * 2 <= WS_END - OFF_ACT, "ACT overlay fits");
static_assert(S5_DG + 4096 <= OFF_W, "s5 params fit");
static_assert(OFF_KB == OFF_ZQ + (size_t)MP * 1024 * 2 && OFF_VT == OFF_ZQ + 2 * (size_t)MP * 1024 * 2, "Q | K | V adjacent");

__device__ __forceinline__ unsigned cvtpk(float lo, float hi) { f32x2_t v = {lo, hi}; bf16x2_t b = __builtin_convertvector(v, bf16x2_t); return __builtin_bit_cast(unsigned, b); }
__device__ __forceinline__ float frcp(float x) { return __builtin_amdgcn_rcpf(x); }
__device__ __forceinline__ float rstd_of(u64 v) { return rsqrtf((float)v * (1.0f / (SS_SCALE * 1024.0f)) + 1e-6f); }
__device__ __forceinline__ void ss_add(u64* p, float s) { __hip_atomic_fetch_add(p, (u64)(s * SS_SCALE), __ATOMIC_RELAXED, __HIP_MEMORY_SCOPE_AGENT); }
__device__ __forceinline__ float bf2f(unsigned short b) { return __uint_as_float((unsigned)b << 16); }


struct EpiGLU {
    static constexpr bool PERM = true, AFTER_DRAIN = false;
    const float* inv0; bf16_t* XB; u64* ss;
    __device__ __forceinline__ void operator()(const f32x4 (&acc)[2][2][4][2], const Unit& u, int wr, int wc, int fr, int fq) const {
        const int col0 = u.pn * 128 + wc * 32 + 8 * fq;
        const int row0 = u.pm * 256 + wr * 64 + fr;
        const size_t rbase = (size_t)row0 * DM + col0;
#pragma unroll
        for (int ai = 0; ai < 2; ++ai) {
            u32x4 hv[4]; float iv[4];
#pragma unroll
            for (int m = 0; m < 4; ++m) { hv[m] = *(const u32x4*)(XB + rbase + (size_t)(ai * 128 + m * 16) * DM); iv[m] = inv0[row0 + ai * 128 + m * 16]; }
            float s[4];
#pragma unroll
            for (int m = 0; m < 4; ++m) {
                const u32x4 hb = hv[m];
                f32x4 h0 = {__uint_as_float(hb.x << 16), __uint_as_float(hb.x & 0xffff0000u), __uint_as_float(hb.y << 16), __uint_as_float(hb.y & 0xffff0000u)};
                f32x4 h1 = {__uint_as_float(hb.z << 16), __uint_as_float(hb.z & 0xffff0000u), __uint_as_float(hb.w << 16), __uint_as_float(hb.w & 0xffff0000u)};
                h0 *= iv[m]; h1 *= iv[m];
                const f32x4 v0 = acc[ai][0][m][0], v1 = acc[ai][0][m][1], g0 = acc[ai][1][m][0], g1 = acc[ai][1][m][1];
#pragma unroll
                for (int j = 0; j < 4; ++j) { h0[j] += v0[j] * frcp(1.f + __expf(-g0[j])); h1[j] += v1[j] * frcp(1.f + __expf(-g1[j])); }
                const size_t off = rbase + (size_t)(ai * 128 + m * 16) * DM;
                u32x4 w; w.x = cvtpk(h0[0], h0[1]); w.y = cvtpk(h0[2], h0[3]); w.z = cvtpk(h1[0], h1[1]); w.w = cvtpk(h1[2], h1[3]);
                *(u32x4*)(XB + off) = w;
                s[m] = (h0[0] * h0[0] + h0[1] * h0[1]) + (h0[2] * h0[2] + h0[3] * h0[3]) + (h1[0] * h1[0] + h1[1] * h1[1]) + (h1[2] * h1[2] + h1[3] * h1[3]);
            }
#pragma unroll
            for (int m = 0; m < 4; ++m) { s[m] += __shfl_xor(s[m], 16); s[m] += __shfl_xor(s[m], 32); }
            const float mine = fq == 0 ? s[0] : (fq == 1 ? s[1] : (fq == 2 ? s[2] : s[3]));
            ss_add(ss + (u.pm * 256 + ai * 128 + wr * 64 + fq * 16 + fr), mine);
        }
    }
};

template <bool CHEAP = false> struct EpiSwiGLU {
    static constexpr bool PERM = true, AFTER_DRAIN = false;
    const u64* ss; bf16_t* ACT;
    __device__ __forceinline__ void operator()(const f32x4 (&acc)[2][2][4][2], const Unit& u, int wr, int wc, int fr, int fq) const {
        const int col0 = u.pn * 128 + wc * 32 + 8 * fq;
        const int row0 = u.pm * 256 + wr * 64 + fr;
        u64 sv[2][4];
#pragma unroll
        for (int ai = 0; ai < 2; ++ai)
#pragma unroll
            for (int m = 0; m < 4; ++m) sv[ai][m] = ss[row0 + ai * 128 + m * 16];
#pragma unroll
        for (int ai = 0; ai < 2; ++ai)
#pragma unroll
            for (int m = 0; m < 4; ++m) {
                const int row = row0 + ai * 128 + m * 16;
                const float rs = rstd_of(sv[ai][m]);
                const float c1 = rs * -1.4426950408889634f, rs2 = rs * rs;
                unsigned ow[4];
#pragma unroll
                for (int n = 0; n < 2; ++n)
#pragma unroll
                    for (int jp = 0; jp < 2; ++jp) {
                        const f32x2_t ag = {acc[ai][0][m][n][2 * jp], acc[ai][0][m][n][2 * jp + 1]}, au = {acc[ai][1][m][n][2 * jp], acc[ai][1][m][n][2 * jp + 1]};
                        f32x2_t ov;
                        if (CHEAP) ov = ag * au;
                        else { const f32x2_t t = ag * c1; f32x2_t e; e.x = __builtin_amdgcn_exp2f(t.x); e.y = __builtin_amdgcn_exp2f(t.y);
                            const f32x2_t d = e + 1.0f; f32x2_t r; r.x = frcp(d.x); r.y = frcp(d.y);
                            ov = (ag * au) * (r * rs2); }
                        ow[2 * n + jp] = cvtpk(ov.x, ov.y);
                    }
                u32x4 w; w.x = ow[0]; w.y = ow[1]; w.z = ow[2]; w.w = ow[3];
                *(u32x4*)(ACT + (size_t)row * DFF + col0) = w;
            }
    }
};

template <bool WRITE_XB> struct EpiResid {
    static constexpr bool PERM = true, AFTER_DRAIN = false;
    bf16_t* XB; u64* ss;
    __device__ __forceinline__ void operator()(const f32x4 (&acc)[2][2][4][2], const Unit& u, int wr, int wc, int fr, int fq) const {
        const int col0 = u.pn * 256 + wc * 32 + 8 * fq;
        const size_t rbase = (size_t)(u.pm * 256 + wr * 64 + fr) * DM + col0;
#pragma unroll
        for (int ai = 0; ai < 2; ++ai) {
            u32x4 hv[4][2];
#pragma unroll
            for (int m = 0; m < 4; ++m)
#pragma unroll
                for (int bj = 0; bj < 2; ++bj) hv[m][bj] = *(const u32x4*)(XB + rbase + (size_t)(ai * 128 + m * 16) * DM + bj * 128);
            float s[4];
#pragma unroll
            for (int m = 0; m < 4; ++m) {
                float sq = 0.f;
#pragma unroll
                for (int bj = 0; bj < 2; ++bj) {
                    const size_t off = rbase + (size_t)(ai * 128 + m * 16) * DM + bj * 128;
                    const u32x4 hb = hv[m][bj];
                    f32x4 h0 = {__uint_as_float(hb.x << 16), __uint_as_float(hb.x & 0xffff0000u), __uint_as_float(hb.y << 16), __uint_as_float(hb.y & 0xffff0000u)};
                    f32x4 h1 = {__uint_as_float(hb.z << 16), __uint_as_float(hb.z & 0xffff0000u), __uint_as_float(hb.w << 16), __uint_as_float(hb.w & 0xffff0000u)};
                    h0 += acc[ai][bj][m][0]; h1 += acc[ai][bj][m][1];
                    u32x4 w; w.x = cvtpk(h0[0], h0[1]); w.y = cvtpk(h0[2], h0[3]); w.z = cvtpk(h1[0], h1[1]); w.w = cvtpk(h1[2], h1[3]);
                    *(u32x4*)(XB + off) = w;
                    sq += (h0[0] * h0[0] + h0[1] * h0[1]) + (h0[2] * h0[2] + h0[3] * h0[3]) + (h1[0] * h1[0] + h1[1] * h1[1]) + (h1[2] * h1[2] + h1[3] * h1[3]);
                }
                s[m] = sq;
            }
#pragma unroll
            for (int m = 0; m < 4; ++m) { s[m] += __shfl_xor(s[m], 16); s[m] += __shfl_xor(s[m], 32); }
            const float mine = fq == 0 ? s[0] : (fq == 1 ? s[1] : (fq == 2 ? s[2] : s[3]));
            ss_add(ss + (u.pm * 256 + ai * 128 + wr * 64 + fq * 16 + fr), mine);
        }
    }
};

struct EpiKQ {
    static constexpr bool PERM = true, AFTER_DRAIN = false;
    const u64* ss; bf16_t* QB;
    __device__ __forceinline__ void operator()(const f32x4 (&acc)[2][2][4][2], const Unit& u, int wr, int wc, int fr, int fq) const {
        const int t3 = u.pn >> 2; const bool isq = t3 == 1;
        const int sel = t3 == 2 ? 2 : 1 - t3;
        bf16_t* base = QB + (size_t)sel * ((size_t)MP * DM); const float sc = isq ? QSCALE : 1.0f;
        const int col0 = (u.pn & 3) * 256 + wc * 32 + 8 * fq;
        const int row0 = u.pm * 256 + wr * 64 + fr;
        u64 sv[2][4];
#pragma unroll
        for (int ai = 0; ai < 2; ++ai)
#pragma unroll
            for (int m = 0; m < 4; ++m) sv[ai][m] = ss[row0 + ai * 128 + m * 16];
#pragma unroll
        for (int ai = 0; ai < 2; ++ai)
#pragma unroll
            for (int m = 0; m < 4; ++m) {
                const int row = row0 + ai * 128 + m * 16;
                const float rs = rstd_of(sv[ai][m]) * sc;
#pragma unroll
                for (int bj = 0; bj < 2; ++bj) { const f32x4 v0 = acc[ai][bj][m][0] * rs, v1 = acc[ai][bj][m][1] * rs;
                    u32x4 w; w.x = cvtpk(v0[0], v0[1]); w.y = cvtpk(v0[2], v0[3]); w.z = cvtpk(v1[0], v1[1]); w.w = cvtpk(v1[2], v1[3]);
                    *(u32x4*)(base + (size_t)row * DM + col0 + bj * 128) = w; }
            }
    }
};

struct EpiVt {
    static constexpr bool PERM = true, AFTER_DRAIN = false;
    const u64* ss; bf16_t* VT;
    __device__ __forceinline__ void operator()(const f32x4 (&acc)[2][2][4][2], const Unit& u, int wr, int wc, int fr, int fq) const {
        const int col0 = u.pn * 256 + wc * 32 + 8 * fq;
#pragma unroll
        for (int bj = 0; bj < 2; ++bj) {
            float rs[8];
#pragma unroll
            for (int j = 0; j < 8; ++j) rs[j] = rstd_of(ss[col0 + bj * 128 + j]);
#pragma unroll
            for (int ai = 0; ai < 2; ++ai)
#pragma unroll
                for (int m = 0; m < 4; ++m) {
                    const int ch = u.pm * 256 + ai * 128 + wr * 64 + m * 16 + fr;
                    const f32x4 v0 = acc[ai][bj][m][0], v1 = acc[ai][bj][m][1];
                    u32x4 w; w.x = cvtpk(v0[0] * rs[0], v0[1] * rs[1]); w.y = cvtpk(v0[2] * rs[2], v0[3] * rs[3]); w.z = cvtpk(v1[0] * rs[4], v1[1] * rs[5]); w.w = cvtpk(v1[2] * rs[6], v1[3] * rs[7]);
                    *(u32x4*)(VT + (size_t)ch * MP + col0 + bj * 128) = w;
                }
        }
    }
};

template <int MODE, bool WXB, int K>
__device__ __forceinline__ void meta_gemm(LAS unsigned char* lds, const bf16_t* A, const bf16_t* Bt, int nitems, const float* meta, float* H, bf16_t* XB, bf16_t* O1, bf16_t* O2, bf16_t* O3, u64* ss_out, const u64* ss_in) {
    constexpr bool GATED = (MODE == 0 || MODE == 1);
    int tid = threadIdx.x; asm volatile("" : "+v"(tid));
    const int lane = tid & 63, wid = __builtin_amdgcn_readfirstlane(tid >> 6);
    LAS f32x4* red = (LAS f32x4*)lds;
    for (int it = blockIdx.x; it < nitems; it += gridDim.x) {
        const int c0 = it * 16;
        const int brow0 = GATED ? 256 * (c0 >> 7) + (c0 & 127) : c0;
        const int kw = K >> 3, k0 = wid * kw;
        f32x4 acc0 = {0.f, 0.f, 0.f, 0.f}, acc1 = {0.f, 0.f, 0.f, 0.f};
        const bf16_t* ap = A + (size_t)(lane & 15) * K + k0 + 8 * (lane >> 4);
        const bf16_t* bp = Bt + (size_t)(brow0 + (lane & 15)) * K + k0 + 8 * (lane >> 4);
        constexpr int NKS = K / 8 / 32;
        bf16x8 av[NKS], bv0[NKS], bv1[GATED ? NKS : 1];
#pragma unroll
        for (int i = 0; i < NKS; ++i) { av[i] = *(const bf16x8*)(ap + 32 * i); bv0[i] = *(const bf16x8*)(bp + 32 * i); if (GATED) bv1[i] = *(const bf16x8*)(bp + (size_t)128 * K + 32 * i); }
#pragma unroll
        for (int i = 0; i < NKS; ++i) {
            acc0 = __builtin_amdgcn_mfma_f32_16x16x32_bf16(av[i], bv0[i], acc0, 0, 0, 0);
            if (GATED) acc1 = __builtin_amdgcn_mfma_f32_16x16x32_bf16(av[i], bv1[i], acc1, 0, 0, 0);
        }
        red[wid * 64 + lane] = acc0; if (GATED) red[512 + wid * 64 + lane] = acc1;
        __syncthreads();
        if (wid == 0) {
            f32x4 s0 = red[lane], s1 = {0.f, 0.f, 0.f, 0.f};
#pragma unroll
            for (int w = 1; w < 8; ++w) s0 += red[w * 64 + lane];
            if (GATED) { s1 = red[512 + lane];
#pragma unroll
                for (int w = 1; w < 8; ++w) s1 += red[512 + w * 64 + lane]; }
            const int c = c0 + (lane & 15);
#pragma unroll
            for (int j = 0; j < 4; ++j) {
                const int r = 4 * (lane >> 4) + j;
                if (MODE == 0 || MODE == 2) {
                    float hn;
                    if (MODE == 0) hn = meta[r * DM + c] + s0[j] * frcp(1.f + __expf(-s1[j]));
                    else hn = bf2f(XB[(size_t)(MR + r) * DM + c]) + s0[j];
                    XB[(size_t)(MR + r) * DM + c] = (bf16_t)(cvtpk(hn, 0.f) & 0xffffu);
                    float sq = hn * hn;
                    sq += __shfl_xor(sq, 1); sq += __shfl_xor(sq, 2); sq += __shfl_xor(sq, 4); sq += __shfl_xor(sq, 8);
                    if ((lane & 15) == 0) ss_add(ss_out + MR + r, sq);
                } else {
                    const float rs = rstd_of(ss_in[MR + r]);
                    if (MODE == 1) { const float g = s0[j] * rs, uu = s1[j] * rs; O1[(size_t)(MR + r) * DFF + c] = (bf16_t)(cvtpk(g * uu * frcp(1.f + __expf(-g)), 0.f) & 0xffffu); }
                    if (MODE == 3) { if (c < 1024) O1[(size_t)(MR + r) * DM + c] = (bf16_t)(cvtpk(s0[j] * rs, 0.f) & 0xffffu);
                        else if (c < 2048) O2[(size_t)(MR + r) * DM + c - 1024] = (bf16_t)(cvtpk(s0[j] * rs * QSCALE, 0.f) & 0xffffu);
                        else { O3[(size_t)(MR + r) * DM + c - 2048] = (bf16_t)(cvtpk(s0[j] * rs, 0.f) & 0xffffu); O3[(size_t)(MR + 16 + r) * DM + c - 2048] = 0; } }
                    if (MODE == 4) { O1[(size_t)c * MP + MR + r] = (bf16_t)(cvtpk(s0[j] * rs, 0.f) & 0xffffu); O1[(size_t)c * MP + MR + 16 + r] = 0; }
                }
            }
        }
        __syncthreads();
    }
}

__device__ __forceinline__ void transpose_item(const float* src, int ldn, const float* gain, bf16_t* dst, int K, int n0d, int c0s, int k0, int lane) {
    const float* sp = src + (size_t)k0 * ldn + c0s + lane;
    float v[32];
#pragma unroll
    for (int k = 0; k < 32; ++k) v[k] = sp[(size_t)k * ldn];
    if (gain) {
#pragma unroll
        for (int k = 0; k < 32; ++k) v[k] *= gain[k0 + k];
    }
    bf16_t* dp = dst + (size_t)(n0d + lane) * K + k0;
#pragma unroll
    for (int q = 0; q < 4; ++q) { u32x4 w; w.x = cvtpk(v[8 * q], v[8 * q + 1]); w.y = cvtpk(v[8 * q + 2], v[8 * q + 3]); w.z = cvtpk(v[8 * q + 4], v[8 * q + 5]); w.w = cvtpk(v[8 * q + 6], v[8 * q + 7]);
        *(u32x4*)(dp + 8 * q) = w; }
}

struct Ptrs {
    const float* in[20]; float* out; unsigned char* ws;
};

__device__ __forceinline__ void p0_prologue(const Ptrs& P, LAS unsigned char* lds) {
    int tid = threadIdx.x; asm volatile("" : "+v"(tid));
    const int lane = tid & 63, wid = tid >> 6;
    unsigned char* ws = P.ws;
    const int gw = blockIdx.x * 8 + wid, NGW = gridDim.x * 8;
    constexpr int I_GLU = 32 * 32, I_FI = 32 * 88, I_FO = 88 * 16, I_KQ = 32 * 32, I_V = 32 * 16, I_O = 32 * 16;
    constexpr int NITEMS = I_GLU + 2 * I_FI + 2 * I_FO + I_KQ + I_V + I_O;
    struct TItem { const float* sp; const float* gp; bf16_t* dp; int ldn; };
    auto decode = [&](const int it) __attribute__((always_inline)) -> TItem {
        int r = it; const float* src; const float* gain; bf16_t* dst; int ldn, K, n0d, c0s, k0;
        if (r < I_GLU) { const int kb = r & 31, nb = r >> 5, n0 = nb * 64; src = P.in[12]; ldn = 2048; gain = nullptr; dst = (bf16_t*)(ws + W_GLU); K = 1024; n0d = n0; c0s = ((n0 >> 7) & 1) * 1024 + (n0 >> 8) * 128 + (n0 & 127); k0 = kb * 32; }
        else if ((r -= I_GLU) < 2 * I_FI) { const int l = r / I_FI; r -= l * I_FI; const int kb = r & 31, nb = r >> 5, n0 = nb * 64; src = P.in[17] + (size_t)l * 1024 * 5632; ldn = 5632; gain = P.in[3] + l * 1024;
            dst = (bf16_t*)(ws + W_FI0) + (size_t)l * 5632 * 1024; K = 1024; n0d = n0; c0s = ((n0 >> 7) & 1) * DFF + (n0 >> 8) * 128 + (n0 & 127); k0 = kb * 32; }
        else if ((r -= 2 * I_FI) < 2 * I_FO) { const int l = r / I_FO; r -= l * I_FO; const int kb = r % 88, nb = r / 88; src = P.in[18] + (size_t)l * 2816 * 1024; ldn = 1024; gain = nullptr;
            dst = (bf16_t*)(ws + W_FO0) + (size_t)l * 1024 * 2816; K = 2816; n0d = nb * 64; c0s = nb * 64; k0 = kb * 32; }
        else if ((r -= 2 * I_FO) < I_KQ) { const int kb = r & 31, nb = r >> 5, n0 = nb * 64; dst = (bf16_t*)(ws + W_KQ); K = 1024; n0d = n0; k0 = kb * 32;
            if (n0 < 1024) { src = P.in[14]; ldn = 2048; gain = P.in[13]; c0s = n0; } else { src = P.in[15]; ldn = 1024; gain = P.in[2] + 1024; c0s = n0 - 1024; } }
        else if ((r -= I_KQ) < I_V) { const int kb = r & 31, nb = r >> 5; src = P.in[14]; ldn = 2048; gain = P.in[13]; dst = (bf16_t*)(ws + W_V); K = 1024; n0d = nb * 64; c0s = 1024 + nb * 64; k0 = kb * 32; }
        else { r -= I_V; const int kb = r & 31, nb = r >> 5; src = P.in[16]; ldn = 1024; gain = nullptr; dst = (bf16_t*)(ws + W_O); K = 1024; n0d = nb * 64; c0s = nb * 64; k0 = kb * 32; }
        TItem t; t.sp = src + (size_t)k0 * ldn + c0s + lane; t.gp = gain ? gain + k0 : nullptr; t.dp = dst + (size_t)(n0d + lane) * K + k0; t.ldn = ldn; return t;
    };
    auto finish = [&](const TItem& t, float (&v)[32]) __attribute__((always_inline)) {
        if (t.gp) {
#pragma unroll
            for (int k = 0; k < 32; ++k) v[k] *= t.gp[k];
        }
#pragma unroll
        for (int q = 0; q < 4; ++q) { u32x4 w; w.x = cvtpk(v[8 * q], v[8 * q + 1]); w.y = cvtpk(v[8 * q + 2], v[8 * q + 3]); w.z = cvtpk(v[8 * q + 4], v[8 * q + 5]); w.w = cvtpk(v[8 * q + 6], v[8 * q + 7]);
            *(u32x4*)(t.dp + 8 * q) = w; }
    };
    bf16_t* XB = (bf16_t*)(ws + OFF_XB);
    for (int row = gw; row < MROWS; row += 2 * NGW) {
        const int row2 = row + NGW; const bool has2 = row2 < MROWS;
        const float* src = row < MR ? P.in[0] + (size_t)row * DM : P.in[1] + (size_t)(row - MR) * DM;
        const float* src2 = has2 ? (row2 < MR ? P.in[0] + (size_t)row2 * DM : P.in[1] + (size_t)(row2 - MR) * DM) : src;
        f32x4 v[4], v2[4]; float s = 0.f, s2 = 0.f;
#pragma unroll
        for (int j = 0; j < 4; ++j) { v[j] = __builtin_nontemporal_load((const f32x4*)(src + 4 * lane + 256 * j)); v2[j] = __builtin_nontemporal_load((const f32x4*)(src2 + 4 * lane + 256 * j)); }
#pragma unroll
        for (int j = 0; j < 4; ++j) { s += (v[j][0] * v[j][0] + v[j][1] * v[j][1]) + (v[j][2] * v[j][2] + v[j][3] * v[j][3]); s2 += (v2[j][0] * v2[j][0] + v2[j][1] * v2[j][1]) + (v2[j][2] * v2[j][2] + v2[j][3] * v2[j][3]); }
#pragma unroll
        for (int o = 1; o < 64; o <<= 1) { s += __shfl_xor(s, o); s2 += __shfl_xor(s2, o); }
        const float ms = s * (1.0f / 1024.0f) + 1e-6f, ms2 = s2 * (1.0f / 1024.0f) + 1e-6f;
        const float rs = rsqrtf(ms), rs2 = rsqrtf(ms2);
        if (lane == 0) { ((float*)(ws + OFF_INV0))[row] = sqrtf(ms); if (has2) ((float*)(ws + OFF_INV0))[row2] = sqrtf(ms2); }
#pragma unroll
        for (int j = 0; j < 4; ++j) { u32x2 w; w.x = cvtpk(v[j][0] * rs, v[j][1] * rs); w.y = cvtpk(v[j][2] * rs, v[j][3] * rs); *(u32x2*)(XB + (size_t)row * DM + 4 * lane + 256 * j) = w; }
        if (has2) {
#pragma unroll
            for (int j = 0; j < 4; ++j) { u32x2 w; w.x = cvtpk(v2[j][0] * rs2, v2[j][1] * rs2); w.y = cvtpk(v2[j][2] * rs2, v2[j][3] * rs2); *(u32x2*)(XB + (size_t)row2 * DM + 4 * lane + 256 * j) = w; }
        }
    }
    for (int it = gw; it < NITEMS; it += 2 * NGW) {
        const bool hb = it + NGW < NITEMS;
        const TItem a = decode(it), b = decode(hb ? it + NGW : it);
        float va[32], vb[32];
#pragma unroll
        for (int k = 0; k < 32; ++k) { va[k] = __builtin_nontemporal_load(a.sp + (size_t)k * a.ldn); vb[k] = __builtin_nontemporal_load(b.sp + (size_t)k * b.ldn); }
        finish(a, va);
        if (hb) finish(b, vb);
    }
    const int gt = blockIdx.x * 512 + tid, NGT = gridDim.x * 512;
    u64* ss = (u64*)(ws + OFF_SS);
    for (int i = gt; i < 4 * MP; i += NGT) ss[i] = 0ull;
    const float* gain0 = P.in[2];
    for (int ii = gt; ii < 64 * 64 * 8; ii += NGT) {
        const int i = ii >> 3, c = 2 * (ii & 7);
        const int g = i >> 6;
        const double dt = exp((double)P.in[6][g]);
        const double are = (double)P.in[4][i], aim = (double)P.in[5][i];
        const double mag = exp(dt * are), ang = dt * aim;
        const double kq = rint(ang * 0.15915494309189535), rr = ang - kq * 6.283185307179586;
        const double q = rr * 0.25, q2 = q * q;
        const double sn = q * (1.0 - q2 / 6.0 * (1.0 - q2 / 20.0 * (1.0 - q2 / 42.0 * (1.0 - q2 / 72.0 * (1.0 - q2 / 110.0 * (1.0 - q2 / 156.0 * (1.0 - q2 / 210.0)))))));
        const double cs = 1.0 - q2 / 2.0 * (1.0 - q2 / 12.0 * (1.0 - q2 / 30.0 * (1.0 - q2 / 56.0 * (1.0 - q2 / 90.0 * (1.0 - q2 / 132.0 * (1.0 - q2 / 182.0 * (1.0 - q2 / 240.0)))))));
        const double s2 = 2.0 * sn * cs, c2 = 1.0 - 2.0 * sn * sn;
        const double s4 = 2.0 * s2 * c2, c4 = 1.0 - 2.0 * s2 * s2;
        const double abr = mag * c4, abi = mag * s4;
        if (c == 0) { float* ab = (float*)(ws + S5_ABAR); ab[2 * i] = (float)abr; ab[2 * i + 1] = (float)abi; }
        const double den = are * are + aim * aim;
        const double cr = ((abr - 1.0) * are + abi * aim) / den, ci = (abi * are - (abr - 1.0) * aim) / den;
        bf16_t* bb = (bf16_t*)(ws + S5_BB);
        const int p = i & 63;
        const double g0 = gain0[g * 16 + c], g1 = gain0[g * 16 + c + 1];
        const double br0 = P.in[7][(size_t)i * 16 + c], bi0 = P.in[8][(size_t)i * 16 + c], br1 = P.in[7][(size_t)i * 16 + c + 1], bi1 = P.in[8][(size_t)i * 16 + c + 1];
        *(unsigned*)(bb + ((size_t)(g * 2 + 0) * 64 + p) * 16 + c) = cvtpk((float)((cr * br0 - ci * bi0) * g0), (float)((cr * br1 - ci * bi1) * g1));
        *(unsigned*)(bb + ((size_t)(g * 2 + 1) * 64 + p) * 16 + c) = cvtpk((float)((cr * bi0 + ci * br0) * g0), (float)((cr * bi1 + ci * br1) * g1));
    }
    for (int i = gt; i < 64 * 64 * 16; i += NGT) {
        const int gp = i >> 4, t = i & 15, g = gp >> 6, p = gp & 63, sh = p >> 5, nn = p & 31;
        const double dt = exp((double)P.in[6][g]);
        const double are = (double)P.in[4][gp], aim = (double)P.in[5][gp];
        const double mag = exp(dt * are), ang = dt * aim;
        const double kq = rint(ang * 0.15915494309189535), rr = ang - kq * 6.283185307179586;
        const double q = rr * 0.25, q2 = q * q;
        const double sn = q * (1.0 - q2 / 6.0 * (1.0 - q2 / 20.0 * (1.0 - q2 / 42.0 * (1.0 - q2 / 72.0 * (1.0 - q2 / 110.0 * (1.0 - q2 / 156.0 * (1.0 - q2 / 210.0)))))));
        const double cs = 1.0 - q2 / 2.0 * (1.0 - q2 / 12.0 * (1.0 - q2 / 30.0 * (1.0 - q2 / 56.0 * (1.0 - q2 / 90.0 * (1.0 - q2 / 132.0 * (1.0 - q2 / 182.0 * (1.0 - q2 / 240.0)))))));
        const double s2 = 2.0 * sn * cs, c2 = 1.0 - 2.0 * sn * sn;
        const double s4 = 2.0 * s2 * c2, c4 = 1.0 - 2.0 * s2 * s2;
        const double abr = mag * c4, abi = mag * s4;
        const double den = are * are + aim * aim;
        const double cr = ((abr - 1.0) * are + abi * aim) / den, ci = (abi * are - (abr - 1.0) * aim) / den;
        double pwr = 1.0, pwi = 0.0, br_ = abr, bi_ = abi; const int e = 15 - t;
#pragma unroll
        for (int bit = 0; bit < 4; ++bit) {
            if ((e >> bit) & 1) { const double nr = pwr * br_ - pwi * bi_, ni = pwr * bi_ + pwi * br_; pwr = nr; pwi = ni; }
            const double sr = br_ * br_ - bi_ * bi_, si = 2.0 * br_ * bi_; br_ = sr; bi_ = si;
        }
        const double fr = pwr * cr - pwi * ci, fi = pwr * ci + pwi * cr;
        bf16_t* w1 = (bf16_t*)(ws + OFF_W1);
#pragma unroll
        for (int h8 = 0; h8 < 2; ++h8) {
            unsigned wre[4], wim[4];
#pragma unroll
            for (int jp = 0; jp < 4; ++jp) {
                const int c = 8 * h8 + 2 * jp;
                const double g0 = gain0[g * 16 + c], g1 = gain0[g * 16 + c + 1];
                const double br0 = P.in[7][(size_t)gp * 16 + c], bi0 = P.in[8][(size_t)gp * 16 + c], br1 = P.in[7][(size_t)gp * 16 + c + 1], bi1 = P.in[8][(size_t)gp * 16 + c + 1];
                wre[jp] = cvtpk((float)((fr * br0 - fi * bi0) * g0), (float)((fr * br1 - fi * bi1) * g1));
                wim[jp] = cvtpk((float)((fr * bi0 + fi * br0) * g0), (float)((fr * bi1 + fi * br1) * g1));
            }
            u32x4 vre; vre.x = wre[0]; vre.y = wre[1]; vre.z = wre[2]; vre.w = wre[3];
            u32x4 vim; vim.x = wim[0]; vim.y = wim[1]; vim.z = wim[2]; vim.w = wim[3];
            *(u32x4*)(w1 + ((((size_t)(g * 16 + t) * 2 + 0) * 2 + sh) * 64 + nn + 32 * h8) * 8) = vre;
            *(u32x4*)(w1 + ((((size_t)(g * 16 + t) * 2 + 1) * 2 + sh) * 64 + nn + 32 * h8) * 8) = vim;
        }
    }
    for (int i = gt; i < 64 * 16 * 64 / 2; i += NGT) {
        const int e = 2 * i, g = e >> 10, cp = e & 1023;
        bf16_t* cb = (bf16_t*)(ws + S5_CB);
        *(unsigned*)(cb + (size_t)(g * 2 + 0) * 1024 + cp) = cvtpk(P.in[9][e], P.in[9][e + 1]);
        *(unsigned*)(cb + (size_t)(g * 2 + 1) * 1024 + cp) = cvtpk(-P.in[10][e], -P.in[10][e + 1]);
    }
    for (int i = gt; i < 1024; i += NGT) ((float*)(ws + S5_DG))[i] = P.in[11][i] * gain0[i];
}

#define MFMA32(a, b, c) __builtin_amdgcn_mfma_f32_32x32x16_bf16((a), (b), (c), 0, 0, 0)
__device__ __forceinline__ float gelu_tanh(float y) {
    const float t = 1.5957691216057308f * (y + 0.044715f * y * y * y);
    return y * frcp(1.f + __expf(-t));
}
__device__ __forceinline__ void s5_phase(const Ptrs& P, LAS unsigned char* lds) {
    int tid = threadIdx.x; asm volatile("" : "+v"(tid));
    const int lane = tid & 63, wid = __builtin_amdgcn_readfirstlane(tid >> 6), n = lane & 31, hh = lane >> 5;
    unsigned char* ws = P.ws;
    const bf16_t* XB = (const bf16_t*)(ws + OFF_XB);
    bf16_t* Z = (bf16_t*)(ws + OFF_ZQ);
    LAS unsigned char* wl = lds + wid * 9216;
    LAS unsigned char* uimg = wl + 8192;
    LAS f32x4* Ex = (LAS f32x4*)(lds + 8 * 9216);
    const int bs = (n >> 2) & 1, tk = (n & 3) + 4 * (n >> 3);
    for (int unit = blockIdx.x; unit < 256; unit += gridDim.x) {
        const int bp = unit >> 6, g = ((unit & 7) << 3) | ((unit >> 3) & 7);
        float ar[2], ai[2];
#pragma unroll
        for (int sh = 0; sh < 2; ++sh) { const float* ab = (const float*)(ws + S5_ABAR) + 2 * (g * 64 + 32 * sh + n); ar[sh] = ab[0]; ai[sh] = ab[1]; }
        bf16x8 Bop[2][2];
#pragma unroll
        for (int ri = 0; ri < 2; ++ri)
#pragma unroll
            for (int sh = 0; sh < 2; ++sh) {
                Bop[ri][sh] = *(const bf16x8*)((const bf16_t*)(ws + S5_BB) + ((size_t)(g * 2 + ri) * 64 + 32 * sh + n) * 16 + 8 * hh);
            }
#pragma unroll
        for (int ri = 0; ri < 2; ++ri)
#pragma unroll
            for (int sh = 0; sh < 2; ++sh) asm volatile("" :: "v"(Bop[ri][sh]));
        asm volatile("" :: "v"(ar[0]), "v"(ar[1]), "v"(ai[0]), "v"(ai[1]));
        const int c_beg = 32 * wid + (wid > 0 ? 1 : 0), c_end = c_beg + 32 + (wid == 0 ? 1 : 0);
        const size_t arow_real = (size_t)((2 * bp + bs) * SEQ + tk), arow_meta = (size_t)(MR + tk);
        const int acol = g * 16 + 8 * hh;
        f32x16 zero16;
#pragma unroll
        for (int i = 0; i < 16; ++i) zero16[i] = 0.f;
        float xr[2] = {0.f, 0.f}, xi[2] = {0.f, 0.f};
#define S5_LOADA(c) (*(const bf16x8*)(XB + ((c) == 0 ? arow_meta : arow_real + (size_t)16 * ((c) - 1)) * DM + acol))
        float p16r[2], p16i[2];
#pragma unroll
        for (int sh = 0; sh < 2; ++sh) {
            float cr = ar[sh], ci = ai[sh];
#pragma unroll
            for (int k = 0; k < 4; ++k) { const float t = cr * cr - ci * ci; ci = 2.f * cr * ci; cr = t; }
            p16r[sh] = cr; p16i[sh] = ci;
        }
        {
            if (wid == 0) {
                const bf16x8 a_cur = S5_LOADA(0);
                f32x16 bu[2][2];
#pragma unroll
                for (int ri = 0; ri < 2; ++ri)
#pragma unroll
                    for (int sh = 0; sh < 2; ++sh) bu[ri][sh] = MFMA32(a_cur, Bop[ri][sh], zero16);
#pragma unroll
                for (int r = 0; r < 16; ++r)
#pragma unroll
                    for (int sh = 0; sh < 2; ++sh) {
                        const float nr = ar[sh] * xr[sh] - ai[sh] * xi[sh] + bu[0][sh][r];
                        const float ni = ar[sh] * xi[sh] + ai[sh] * xr[sh] + bu[1][sh][r];
                        xr[sh] = nr; xi[sh] = ni;
                    }
            }
            const int c1 = wid == 0 ? 1 : c_beg;
            const bf16_t* W1g = (const bf16_t*)(ws + OFF_W1) + (size_t)g * (16 * 4 * 64 * 8) + lane * 8;
            for (int blk = 0; blk < 2; ++blk) {
                const bf16_t* ab = XB + ((size_t)((2 * bp + bs) * SEQ) + (size_t)16 * (c1 - 1 + 16 * blk + tk)) * DM + acol;
                f32x16 E00 = zero16, E01 = zero16, E10 = zero16, E11 = zero16;
#pragma unroll 4
                for (int t = 0; t < 16; ++t) {
                    const bf16x8 a = *(const bf16x8*)(ab + (size_t)t * DM);
                    const bf16_t* wp = W1g + (size_t)t * (4 * 64 * 8);
                    const bf16x8 b00 = *(const bf16x8*)(wp), b01 = *(const bf16x8*)(wp + 512), b10 = *(const bf16x8*)(wp + 1024), b11 = *(const bf16x8*)(wp + 1536);
                    E00 = MFMA32(a, b00, E00); E01 = MFMA32(a, b01, E01); E10 = MFMA32(a, b10, E10); E11 = MFMA32(a, b11, E11);
                }
#pragma unroll
                for (int r = 0; r < 16; ++r) {
                    { const float nr = p16r[0] * xr[0] - p16i[0] * xi[0] + E00[r], ni = p16r[0] * xi[0] + p16i[0] * xr[0] + E10[r]; xr[0] = nr; xi[0] = ni; }
                    { const float nr = p16r[1] * xr[1] - p16i[1] * xi[1] + E01[r], ni = p16r[1] * xi[1] + p16i[1] * xr[1] + E11[r]; xr[1] = nr; xi[1] = ni; }
                }
            }
        }
        Ex[wid * 64 + lane] = (f32x4){xr[0], xi[0], xr[1], xi[1]};
        __syncthreads();
        {
            float pr[2], pi[2];
#pragma unroll
            for (int sh = 0; sh < 2; ++sh) {
                float cr = p16r[sh], ci = p16i[sh];
#pragma unroll
                for (int k = 0; k < 5; ++k) { const float t = cr * cr - ci * ci; ci = 2.f * cr * ci; cr = t; }
                pr[sh] = cr; pi[sh] = ci;
            }
            xr[0] = xr[1] = xi[0] = xi[1] = 0.f;
            for (int v = 0; v < wid; ++v) {
                const f32x4 e = Ex[v * 64 + lane];
#pragma unroll
                for (int sh = 0; sh < 2; ++sh) {
                    float qr = pr[sh], qi = pi[sh];
                    if (v == 0) { const float t = qr * p16r[sh] - qi * p16i[sh]; qi = qr * p16i[sh] + qi * p16r[sh]; qr = t; }
                    const float nr = qr * xr[sh] - qi * xi[sh] + (sh == 0 ? e[0] : e[2]);
                    const float ni = qr * xi[sh] + qi * xr[sh] + (sh == 0 ? e[1] : e[3]);
                    xr[sh] = nr; xi[sh] = ni;
                }
            }
        }
        {
            bf16x8 Cop[2][2][2];
#pragma unroll
            for (int ri = 0; ri < 2; ++ri)
#pragma unroll
                for (int sh = 0; sh < 2; ++sh) {
#pragma unroll
                    for (int s = 0; s < 2; ++s) { bf16x8 cv = {0, 0, 0, 0, 0, 0, 0, 0};
                        if (n < 16) cv = *(const bf16x8*)((const bf16_t*)(ws + S5_CB) + ((size_t)(g * 2 + ri) * 16 + n) * 64 + 32 * sh + 16 * s + 8 * hh);
                        Cop[ri][sh][s] = cv; }
                    asm volatile("" :: "v"(Cop[ri][sh][0]), "v"(Cop[ri][sh][1]));
                }
            const int xsw = (n >> 1) & 7;
            const int trq = (lane & 15) >> 2, trc = 4 * ((lane >> 4) & 1) + (lane & 3);
            const unsigned tr_lo = (unsigned)(size_t)wl + (unsigned)((8 * hh + trq) * 64 + 8 * (trc ^ ((4 * hh + (trq >> 1)) & 7)));
            const unsigned tr_hi = (unsigned)(size_t)wl + (unsigned)((8 * hh + trq + 4) * 64 + 8 * (trc ^ ((4 * hh + (trq >> 1) + 2) & 7)));
            const float* Dg = (const float*)(ws + S5_DG) + g * 16 + 4 * hh;
            const f32x4 d_lo = *(const f32x4*)Dg, d_hi = *(const f32x4*)(Dg + 8);
            asm volatile("" :: "v"(d_lo), "v"(d_hi));
            const int cl = c_end - 1;
            auto body2 = [&](const bf16x8 a_cur, const int c) __attribute__((always_inline)) {
                *(LAS bf16x8*)(uimg + n * 32 + hh * 16) = a_cur;
                f32x16 bu[2][2];
#pragma unroll
                for (int ri = 0; ri < 2; ++ri)
#pragma unroll
                    for (int sh = 0; sh < 2; ++sh) bu[ri][sh] = MFMA32(a_cur, Bop[ri][sh], zero16);
#pragma unroll
                for (int r = 0; r < 16; ++r)
#pragma unroll
                    for (int sh = 0; sh < 2; ++sh) {
                        const float nr = ar[sh] * xr[sh] - ai[sh] * xi[sh] + bu[0][sh][r];
                        const float ni = ar[sh] * xi[sh] + ai[sh] * xr[sh] + bu[1][sh][r];
                        xr[sh] = nr; xi[sh] = ni; bu[0][sh][r] = nr; bu[1][sh][r] = ni;
                    }
#pragma unroll
                for (int ri = 0; ri < 2; ++ri)
#pragma unroll
                    for (int sh = 0; sh < 2; ++sh)
#pragma unroll
                        for (int q4 = 0; q4 < 4; ++q4) { u32x2 w; w.x = cvtpk(bu[ri][sh][4 * q4], bu[ri][sh][4 * q4 + 1]); w.y = cvtpk(bu[ri][sh][4 * q4 + 2], bu[ri][sh][4 * q4 + 3]);
                            *(LAS u32x2*)(wl + (ri * 2 + sh) * 2048 + n * 64 + 8 * ((2 * q4 + hh) ^ xsw)) = w; }
                s16x4 t0, t1, t2, t3, t4, t5, t6, t7, t8, t9, t10, t11, t12, t13, t14, t15;
#define S5_TRL(o, off) "ds_read_b64_tr_b16 %" #o ", %16 offset:" #off "\n\t"
#define S5_TRH(o, off) "ds_read_b64_tr_b16 %" #o ", %17 offset:" #off "\n\t"
                asm volatile("s_waitcnt lgkmcnt(0)\n\t"
                             S5_TRL(0, 0) S5_TRH(1, 0) S5_TRL(2, 1024) S5_TRH(3, 1024) S5_TRL(4, 2048) S5_TRH(5, 2048) S5_TRL(6, 3072) S5_TRH(7, 3072)
                             S5_TRL(8, 4096) S5_TRH(9, 4096) S5_TRL(10, 5120) S5_TRH(11, 5120) S5_TRL(12, 6144) S5_TRH(13, 6144) S5_TRL(14, 7168) S5_TRH(15, 7168)
                             "s_waitcnt lgkmcnt(0)"
                             : "=&v"(t0), "=&v"(t1), "=&v"(t2), "=&v"(t3), "=&v"(t4), "=&v"(t5), "=&v"(t6), "=&v"(t7), "=&v"(t8), "=&v"(t9), "=&v"(t10), "=&v"(t11), "=&v"(t12), "=&v"(t13), "=&v"(t14), "=&v"(t15)
                             : "v"(tr_lo), "v"(tr_hi) : "memory");
#undef S5_TRL
#undef S5_TRH
#define S5_CAT(a, b) __builtin_shufflevector(a, b, 0, 1, 2, 3, 4, 5, 6, 7)
                f32x16 y0 = MFMA32(Cop[0][0][0], S5_CAT(t0, t1), zero16);   y0 = MFMA32(Cop[0][0][1], S5_CAT(t2, t3), y0);
                f32x16 y1 = MFMA32(Cop[0][1][0], S5_CAT(t4, t5), zero16);   y1 = MFMA32(Cop[0][1][1], S5_CAT(t6, t7), y1);
                f32x16 y2 = MFMA32(Cop[1][0][0], S5_CAT(t8, t9), zero16);   y2 = MFMA32(Cop[1][0][1], S5_CAT(t10, t11), y2);
                f32x16 y3 = MFMA32(Cop[1][1][0], S5_CAT(t12, t13), zero16); y3 = MFMA32(Cop[1][1][1], S5_CAT(t14, t15), y3);
#undef S5_CAT
                const u32x2 u_lo = *(const LAS u32x2*)(uimg + n * 32 + 8 * hh), u_hi = *(const LAS u32x2*)(uimg + n * 32 + 16 + 8 * hh);
                float zz[8];
#pragma unroll
                for (int i = 0; i < 8; ++i) {
                    const unsigned uw = (i < 4) ? (i < 2 ? u_lo.x : u_lo.y) : (i < 6 ? u_hi.x : u_hi.y);
                    const float uf = (i & 1) ? __uint_as_float(uw & 0xffff0000u) : __uint_as_float(uw << 16);
                    const float dd = (i < 4) ? d_lo[i & 3] : d_hi[i & 3];
                    const float y = (y0[i] + y1[i]) + (y2[i] + y3[i]) + dd * uf;
                    zz[i] = gelu_tanh(y);
                }
                if (c > 0 || (bp == 0 && bs == 0)) {
                    const size_t orow = (c == 0) ? arow_meta : arow_real + (size_t)16 * (c - 1);
                    bf16_t* zp = Z + orow * DM + g * 16 + 4 * hh;
                    u32x2 w0, w1; w0.x = cvtpk(zz[0], zz[1]); w0.y = cvtpk(zz[2], zz[3]); w1.x = cvtpk(zz[4], zz[5]); w1.y = cvtpk(zz[6], zz[7]);
                    *(u32x2*)zp = w0; *(u32x2*)(zp + 8) = w1;
                }
            };
            bf16x8 r0 = S5_LOADA(c_beg), r1 = S5_LOADA(min(c_beg + 1, cl));
            for (int c = c_beg; c < c_end; c += 2) {
                body2(r0, c); r0 = S5_LOADA(min(c + 2, cl));
                if (c + 1 < c_end) { body2(r1, c + 1); r1 = S5_LOADA(min(c + 3, cl)); }
            }
        }
        __syncthreads();
    }
#undef S5_LOADA
}

#define XB_TMO      128
#define XB_XCNT(j)  (256  + 64 * (j))
#define XB_XSUB(j)  (1280 + 64 * (j))
#define XB_XGEN(j)  (2304 + 64 * (j))
#define XB_TOP      3328
#define XB_TOPGEN   3392
#define XCD_BAR_WORDS 3456
#define XB_SPIN_CAP (1u << 18)

__device__ __forceinline__ unsigned xb_ld(unsigned* p)              { return __hip_atomic_load(p, __ATOMIC_RELAXED, __HIP_MEMORY_SCOPE_AGENT); }
__device__ __forceinline__ unsigned xb_add(unsigned* p, unsigned v) { return __hip_atomic_fetch_add(p, v, __ATOMIC_RELAXED, __HIP_MEMORY_SCOPE_AGENT); }
__device__ __forceinline__ unsigned xb_xcc_id() { return (unsigned)__builtin_amdgcn_s_getreg((3 << 11) | 20) & 0xFu; }
#define XB_SPIN(cond, bar) do { unsigned _sp = 0; while (cond) { __builtin_amdgcn_s_sleep(1); \
    if ((++_sp & 255u) == 0u) { if (xb_ld(&(bar)[XB_TMO])) break; if (_sp > XB_SPIN_CAP) { atomicAdd(&(bar)[XB_TMO], 1u); break; } } } } while (0)

struct XcdBarrier {
    unsigned* bar; unsigned x;
    volatile LAS unsigned* st;
};

__device__ __forceinline__ XcdBarrier xcd_barrier_post(unsigned* bar, volatile LAS unsigned* st) {
    XcdBarrier b; b.bar = bar; b.x = xb_xcc_id(); b.st = st;
    if (threadIdx.x == 0) (void)xb_add(&bar[XB_XCNT(b.x)], 1u);
    return b;
}
__device__ __forceinline__ void xcd_barrier_complete(unsigned* bar, unsigned x, unsigned& nloc, unsigned& nx) {
    const unsigned G = gridDim.x * gridDim.y * gridDim.z;
    unsigned sum, cnt, mine, sp = 0u;
    for (;;) {
        sum = 0u; cnt = 0u; mine = 0u;
#pragma unroll
        for (unsigned j = 0; j < 16; ++j) { const unsigned c = xb_ld(&bar[XB_XCNT(j)]); sum += c; cnt += (c > 0u) ? 1u : 0u; mine = (j == x) ? c : mine; }
        if (sum == G) break;
        __builtin_amdgcn_s_sleep(1);
        if ((++sp & 255u) == 0u) { if (xb_ld(&bar[XB_TMO])) break; if (sp > XB_SPIN_CAP) { atomicAdd(&bar[XB_TMO], 1u); break; } }
    }
    nloc = mine > 0u ? mine : 1u; nx = cnt > 0u ? cnt : 1u;
}

__device__ __forceinline__ void xcd_barrier(const XcdBarrier& b) {
    asm volatile("s_waitcnt vmcnt(0)" ::: "memory");
    __syncthreads();
    if (threadIdx.x == 0) {
        unsigned* bar = b.bar;
        __builtin_amdgcn_s_waitcnt(0);
        unsigned nloc = b.st[0], nx = b.st[1];
        if (nloc == 0u) { xcd_barrier_complete(bar, b.x, nloc, nx); b.st[0] = nloc; b.st[1] = nx; }
        const unsigned old = xb_add(&bar[XB_XSUB(b.x)], 1u);
        const unsigned gen = old / nloc;
        if (old + 1u == (gen + 1u) * nloc) {
            __builtin_amdgcn_fence(__ATOMIC_RELEASE, "agent");
            asm volatile("s_waitcnt vmcnt(0)" ::: "memory");
            const unsigned og = xb_add(&bar[XB_TOP], 1u);
            const unsigned tg = og / nx;
            if (og + 1u == (tg + 1u) * nx) xb_add(&bar[XB_TOPGEN], 1u);
            else XB_SPIN(xb_ld(&bar[XB_TOPGEN]) == tg, bar);
            __builtin_amdgcn_fence(__ATOMIC_ACQUIRE, "agent");
            xb_add(&bar[XB_XGEN(b.x)], 1u);
            asm volatile("s_waitcnt vmcnt(0)" ::: "memory");
        } else {
            XB_SPIN(xb_ld(&bar[XB_XGEN(b.x)]) == gen, bar);
            __builtin_amdgcn_fence(__ATOMIC_ACQUIRE, "agent");
            asm volatile("s_waitcnt vmcnt(0)" ::: "memory");
        }
    }
    __syncthreads();
}

constexpr float AT_STOP = 5.421011e-20f;
__device__ __forceinline__ void attn_phase(const Ptrs& P, LAS unsigned char* lds, bf16_t* Oout) {
    int tid = threadIdx.x; asm volatile("" : "+v"(tid));
    const int lane = tid & 63, wid = __builtin_amdgcn_readfirstlane(tid >> 6), n = lane & 31, hh = lane >> 5;
    unsigned char* ws = P.ws;
    const bf16_t* KB = (const bf16_t*)(ws + OFF_KB);
    const bf16_t* VB = (const bf16_t*)(ws + OFF_VT);
    bf16_t* QO = (bf16_t*)(ws + OFF_ZQ);
    LAS unsigned char* Kl = lds + wid * 10752;
    LAS unsigned char* Vl = Kl + 4608;
    const int lrow = 4 * (lane >> 3), lchk = lane & 7;
    LAS unsigned char* kst = Kl + lrow * 144 + lchk * 16;
    LAS unsigned char* vst = Vl + lrow * 192 + lchk * 16;
    const LAS unsigned char* kfr = Kl + n * 144 + 16 * hh;
    const unsigned vtr = (unsigned)(size_t)Vl + (unsigned)((4 * hh + ((lane & 15) >> 2)) * 192 + 32 * ((lane >> 4) & 1) + 8 * (lane & 3));
    const int vcu = (gridDim.x % 8 == 0) ? (blockIdx.x % 8) * (gridDim.x / 8) + blockIdx.x / 8 : blockIdx.x;
    const int gw = vcu * 8 + wid, NGW = gridDim.x * 8;
    constexpr int NREAL = NB * NHEAD * 128;
    for (int u = gw; u < NREAL; u += NGW) {
        constexpr bool metaq = false;
        const int qt = metaq ? -1 : (u & 127), h = metaq ? (u - NREAL) : ((u >> 7) & 15), b = metaq ? 0 : (u >> 11);
        const int qrow0 = metaq ? MR : b * SEQ + 32 * qt;
        auto issue = [&](u32x4& k0, u32x4& k1, u32x4& k2, u32x4& k3, u32x4& v0, u32x4& v1, u32x4& v2, u32x4& v3, const int kt_) __attribute__((always_inline)) {
            const int krow0 = kt_ >= 0 ? b * SEQ + 32 * kt_ : MR;
            const size_t off = (size_t)(krow0 + lrow + 2) * DM + h * 64 + lchk * 8;
            const bf16_t* kp = KB + off; const bf16_t* vp = VB + off;
            asm volatile("global_load_dwordx4 %0, %8, off offset:-4096\n\t"
                         "global_load_dwordx4 %1, %8, off offset:-2048\n\t"
                         "global_load_dwordx4 %2, %8, off\n\t"
                         "global_load_dwordx4 %3, %8, off offset:2048\n\t"
                         "global_load_dwordx4 %4, %9, off offset:-4096\n\t"
                         "global_load_dwordx4 %5, %9, off offset:-2048\n\t"
                         "global_load_dwordx4 %6, %9, off\n\t"
                         "global_load_dwordx4 %7, %9, off offset:2048"
                         : "=&v"(k0), "=&v"(k1), "=&v"(k2), "=&v"(k3), "=&v"(v0), "=&v"(v1), "=&v"(v2), "=&v"(v3)
                         : "v"(kp), "v"(vp) : "memory");
        };
        u32x4 ak0, ak1, ak2, ak3, av0, av1, av2, av3;
#define AT_PREV(k) ((k) > 0 ? (k) - 1 : -1)
        int kt = qt;
        issue(ak0, ak1, ak2, ak3, av0, av1, av2, av3, kt);
        bf16x8 qf[4];
#pragma unroll
        for (int s = 0; s < 4; ++s) qf[s] = *(const bf16x8*)(QO + (size_t)(qrow0 + n) * DM + h * 64 + 16 * s + 8 * hh);
        asm volatile("" :: "v"(qf[0]), "v"(qf[1]), "v"(qf[2]), "v"(qf[3]));
        f32x16 o0, o1;
#pragma unroll
        for (int i = 0; i < 16; ++i) { o0[i] = 0.f; o1[i] = 0.f; }
        float Rl = 1.f;
        const int metalim = metaq ? (n < 16 ? n : 16) : 16;
        auto stage = [&](const u32x4& k0, const u32x4& k1, const u32x4& k2, const u32x4& k3, const u32x4& v0, const u32x4& v1, const u32x4& v2, const u32x4& v3) __attribute__((always_inline)) {
            *(LAS u32x4*)(kst) = k0; *(LAS u32x4*)(kst + 144) = k1; *(LAS u32x4*)(kst + 288) = k2; *(LAS u32x4*)(kst + 432) = k3;
            *(LAS u32x4*)(vst) = v0; *(LAS u32x4*)(vst + 192) = v1; *(LAS u32x4*)(vst + 384) = v2; *(LAS u32x4*)(vst + 576) = v3;
        };
        auto compute = [&](const int kt_, auto MT) __attribute__((always_inline)) -> bool {
            constexpr bool MASKED = decltype(MT)::value;
            f32x16 z;
#pragma unroll
            for (int i = 0; i < 16; ++i) z[i] = 0.f;
#pragma unroll
            for (int s = 0; s < 4; ++s) z = MFMA32(*(const LAS bf16x8*)(kfr + 32 * s), qf[s], z);
            const int lim = kt_ < 0 ? metalim : n;
            f32x2_t be[8], om[8];
#pragma unroll
            for (int p = 0; p < 8; ++p) {
                f32x2_t e; e.x = __builtin_amdgcn_exp2f(z[2 * p]); e.y = __builtin_amdgcn_exp2f(z[2 * p + 1]);
                const f32x2_t d = e + 1.0f;
                f32x2_t bt; bt.x = frcp(d.x); bt.y = frcp(d.y);
                f32x2_t o1m = 1.0f - bt;
                if (MASKED) {
                    const int j0 = ((2 * p) & 3) + 8 * ((2 * p) >> 2) + 4 * hh;
                    if (!(j0 < lim)) { bt.x = 0.f; o1m.x = 1.f; }
                    if (!(j0 + 1 < lim)) { bt.y = 0.f; o1m.y = 1.f; }
                }
                be[p] = bt; om[p] = o1m;
            }
            float qp[4], th[4];
#pragma unroll
            for (int a = 0; a < 4; ++a) { const f32x2_t t = om[2 * a] * om[2 * a + 1]; qp[a] = t.x * t.y; th[a] = __shfl_xor(qp[a], 32); }
            float G[8];
#pragma unroll
            for (int a = 0; a < 4; ++a) { G[2 * a] = hh ? th[a] : qp[a]; G[2 * a + 1] = hh ? qp[a] : th[a]; }
            const float sf7 = 1.f, sf6 = G[7], sf5 = sf6 * G[6], sf4 = sf5 * G[5], sf3 = sf4 * G[4], sf2 = sf3 * G[3], sf1 = sf2 * G[2], sf0 = sf1 * G[1];
            const float total = sf0 * G[0];
            const float sm0 = hh ? sf1 : sf0, sm1 = hh ? sf3 : sf2, sm2 = hh ? sf5 : sf4, sm3 = hh ? sf7 : sf6;
            f32x2_t w[8];
#define AT_W(a, SM) do { const float e3 = Rl * (SM), e2 = e3 * om[2 * (a) + 1].y, e1 = e2 * om[2 * (a) + 1].x, e0 = e1 * om[2 * (a)].y; \
                w[2 * (a)] = be[2 * (a)] * (f32x2_t){e0, e1}; w[2 * (a) + 1] = be[2 * (a) + 1] * (f32x2_t){e2, e3}; } while (0)
            AT_W(0, sm0); AT_W(1, sm1); AT_W(2, sm2); AT_W(3, sm3);
#undef AT_W
            Rl *= total;
            s16x4 t0, t1, t2, t3, t4, t5, t6, t7;
            asm volatile("ds_read_b64_tr_b16 %0, %8\n\t"
                         "ds_read_b64_tr_b16 %1, %8 offset:1536\n\t"
                         "ds_read_b64_tr_b16 %2, %8 offset:3072\n\t"
                         "ds_read_b64_tr_b16 %3, %8 offset:4608\n\t"
                         "ds_read_b64_tr_b16 %4, %8 offset:64\n\t"
                         "ds_read_b64_tr_b16 %5, %8 offset:1600\n\t"
                         "ds_read_b64_tr_b16 %6, %8 offset:3136\n\t"
                         "ds_read_b64_tr_b16 %7, %8 offset:4672\n\t"
                         "s_waitcnt lgkmcnt(0)"
                         : "=&v"(t0), "=&v"(t1), "=&v"(t2), "=&v"(t3), "=&v"(t4), "=&v"(t5), "=&v"(t6), "=&v"(t7) : "v"(vtr) : "memory");
#define AT_CAT(a, b) __builtin_shufflevector(a, b, 0, 1, 2, 3, 4, 5, 6, 7)
            {
                u32x4 pw; pw.x = cvtpk(w[0].x, w[0].y); pw.y = cvtpk(w[1].x, w[1].y); pw.z = cvtpk(w[2].x, w[2].y); pw.w = cvtpk(w[3].x, w[3].y);
                const bf16x8 pf = __builtin_bit_cast(bf16x8, pw);
                o0 = MFMA32(AT_CAT(t0, t1), pf, o0); o1 = MFMA32(AT_CAT(t4, t5), pf, o1);
            }
            {
                u32x4 pw; pw.x = cvtpk(w[4].x, w[4].y); pw.y = cvtpk(w[5].x, w[5].y); pw.z = cvtpk(w[6].x, w[6].y); pw.w = cvtpk(w[7].x, w[7].y);
                const bf16x8 pf = __builtin_bit_cast(bf16x8, pw);
                o0 = MFMA32(AT_CAT(t2, t3), pf, o0); o1 = MFMA32(AT_CAT(t6, t7), pf, o1);
            }
#undef AT_CAT
            return kt_ < 0 || __all(Rl < AT_STOP);
        };
#define AT_COMPUTE(kt_) (((kt_) < 0 || (kt_) == qt) ? compute((kt_), std::true_type{}) : compute((kt_), std::false_type{}))
#define AT_WAIT(N, k0, k1, k2, k3, v0, v1, v2, v3) asm volatile("s_waitcnt vmcnt(" #N ")" : "+v"(k0), "+v"(k1), "+v"(k2), "+v"(k3), "+v"(v0), "+v"(v1), "+v"(v2), "+v"(v3) :: "memory")
        for (;;) {
            AT_WAIT(0, ak0, ak1, ak2, ak3, av0, av1, av2, av3);
            stage(ak0, ak1, ak2, ak3, av0, av1, av2, av3);
            issue(ak0, ak1, ak2, ak3, av0, av1, av2, av3, AT_PREV(kt));
            if (AT_COMPUTE(kt)) break;
            kt = AT_PREV(kt);
        }
#undef AT_PREV
#undef AT_COMPUTE
        AT_WAIT(0, ak0, ak1, ak2, ak3, av0, av1, av2, av3);
#undef AT_WAIT
        if (!metaq || n < 16) {
            bf16_t* op = Oout + (size_t)(qrow0 + n) * DM + h * 64 + 4 * hh;
#pragma unroll
            for (int a = 0; a < 4; ++a) {
                u32x2 w0; w0.x = cvtpk(o0[4 * a], o0[4 * a + 1]); w0.y = cvtpk(o0[4 * a + 2], o0[4 * a + 3]);
                u32x2 w1; w1.x = cvtpk(o1[4 * a], o1[4 * a + 1]); w1.y = cvtpk(o1[4 * a + 2], o1[4 * a + 3]);
                *(u32x2*)(op + 8 * a) = w0; *(u32x2*)(op + 32 + 8 * a) = w1;
            }
        }
    }
}

__device__ __forceinline__ void final_phase(const Ptrs& P) {
    int tid = threadIdx.x; asm volatile("" : "+v"(tid));
    const int lane = tid & 63, wid = tid >> 6;
    const bf16_t* XB = (const bf16_t*)(P.ws + OFF_XB);
    const u64* ss3 = (const u64*)(P.ws + OFF_SS) + 3 * MP;
    const float* gain = P.in[19];
    f32x4 gv[4];
#pragma unroll
    for (int j = 0; j < 4; ++j) gv[j] = *(const f32x4*)(gain + 4 * lane + 256 * j);
    const int gw = blockIdx.x * 8 + wid, NGW = gridDim.x * 8;
    for (int row = gw; row < MR; row += NGW) {
        const float rs = rstd_of(ss3[row]);
#pragma unroll
        for (int j = 0; j < 4; ++j) { const u32x2 hb = __builtin_nontemporal_load((const u32x2*)(XB + (size_t)row * DM + 4 * lane + 256 * j));
            const f32x4 v = {__uint_as_float(hb.x << 16), __uint_as_float(hb.x & 0xffff0000u), __uint_as_float(hb.y << 16), __uint_as_float(hb.y & 0xffff0000u)};
            __builtin_nontemporal_store(v * rs * gv[j], (f32x4*)(P.out + (size_t)row * DM + 4 * lane + 256 * j)); }
    }
}

#ifndef REP_P0
#define REP_P0 1
#endif
#ifndef REP_S5
#define REP_S5 1
#endif
#ifndef REP_ATT
#define REP_ATT 1
#endif
#ifndef REP_SYNC
#define REP_SYNC 0
#endif
#ifndef REP_FI
#define REP_FI 1
#endif
#ifndef REP_FI_CHEAP
#define REP_FI_CHEAP 0
#endif
#ifndef REP_FIN
#define REP_FIN 1
#endif
constexpr int LDS_BYTES = 131072 + 256;
__global__ void __launch_bounds__(512, 2) s5yoco_fwd(Ptrs P) {
    extern __shared__ __attribute__((aligned(16))) unsigned char lds_raw[];
    LAS unsigned char* lds = (LAS unsigned char*)lds_raw;
    cg::grid_group grid = cg::this_grid();
    unsigned char* ws = P.ws;
    u64* ss = (u64*)(ws + OFF_SS);
    bf16_t* XB = (bf16_t*)(ws + OFF_XB); float* H = (float*)(ws + OFF_H); bf16_t* ZQ = (bf16_t*)(ws + OFF_ZQ); bf16_t* ACT = (bf16_t*)(ws + OFF_ACT);
    const int G = gridDim.x, c = blockIdx.x;
    StaticOrder S;
    volatile LAS unsigned* bst = (volatile LAS unsigned*)(lds + 131072);
    if (threadIdx.x < 2) bst[threadIdx.x] = 0u;
    __syncthreads();
    const XcdBarrier gbar = xcd_barrier_post((unsigned*)(ws + OFF_BAR), bst);
    if (ws == nullptr) grid.sync();
#define GSYNC() xcd_barrier(gbar)

#if REP_P0 >= 2
    p0_prologue(P, lds);
#endif
    p0_prologue(P, lds);
    GSYNC();
    for (int rep = 0; rep < REP_S5; ++rep) s5_phase(P, lds);
    GSYNC();
    bf16_t* KBp = (bf16_t*)(ws + OFF_KB); bf16_t* VTp = (bf16_t*)(ws + OFF_VT);
    {
        S.init(MR, 2048, G, c);
        EpiGLU E{(const float*)(ws + OFF_INV0), XB, ss};
        pg8::gemm_phase<EpiGLU, StaticOrder, true, true>(lds, Gemm{ZQ, (const bf16_t*)(ws + W_GLU), MR, 2048, 1024}, S, E);
        meta_gemm<0, true, 1024>(lds, ZQ + (size_t)MR * DM, (const bf16_t*)(ws + W_GLU), 64, P.in[1], H, XB, nullptr, nullptr, nullptr, ss, nullptr);
    }
    GSYNC();
    {
        S.init(MR, 5632, G, c);
#if REP_FI_CHEAP
        { EpiSwiGLU<true> Ec{ss, ACT}; pg8::gemm_phase<EpiSwiGLU<true>, StaticOrder, true, true>(lds, Gemm{XB, (const bf16_t*)(ws + W_FI0), MR, 5632, 1024}, S, Ec); }
#endif
        EpiSwiGLU<false> E{ss, ACT};
#if REP_FI >= 2
        pg8::gemm_phase<EpiSwiGLU<false>, StaticOrder, true, true>(lds, Gemm{XB, (const bf16_t*)(ws + W_FI0), MR, 5632, 1024}, S, E);
#endif
        pg8::gemm_phase<EpiSwiGLU<false>, StaticOrder, true, true>(lds, Gemm{XB, (const bf16_t*)(ws + W_FI0), MR, 5632, 1024}, S, E);
        meta_gemm<1, false, 1024>(lds, XB + (size_t)MR * DM, (const bf16_t*)(ws + W_FI0), 176, nullptr, nullptr, nullptr, ACT, nullptr, nullptr, nullptr, ss);
    }
    GSYNC();
    {
        S.init(MR, 1024, G, c);
        EpiResid<true> E{XB, ss + MP};
        pg8::gemm_phase<EpiResid<true>, StaticOrder, true, true>(lds, Gemm{ACT, (const bf16_t*)(ws + W_FO0), MR, 1024, DFF}, S, E);
        meta_gemm<2, true, DFF>(lds, ACT + (size_t)MR * DFF, (const bf16_t*)(ws + W_FO0), 64, nullptr, H, XB, nullptr, nullptr, nullptr, ss + MP, nullptr);
    }
    GSYNC();
    {
        S.init(MR, 3072, G, c);
        EpiKQ E{ss + MP, ZQ};
        pg8::gemm_phase<EpiKQ, StaticOrder, true, true>(lds, Gemm{XB, (const bf16_t*)(ws + W_KQ), MR, 3072, 1024}, S, E);
        meta_gemm<3, false, 1024>(lds, XB + (size_t)MR * DM, (const bf16_t*)(ws + W_KQ), 192, nullptr, nullptr, nullptr, KBp, ZQ, VTp, nullptr, ss + MP);
    }
    GSYNC();
    for (int rep = 1; rep < REP_ATT; ++rep) attn_phase(P, lds, (bf16_t*)(ws + OFF_H));
    attn_phase(P, lds, ZQ);
    GSYNC();
    {
        S.init(MR, 1024, G, c);
        EpiResid<true> E{XB, ss + 2 * MP};
        pg8::gemm_phase<EpiResid<true>, StaticOrder, true, true>(lds, Gemm{ZQ, (const bf16_t*)(ws + W_O), MR, 1024, 1024}, S, E);
    }
    GSYNC();
    {
        S.init(MR, 5632, G, c);
        EpiSwiGLU<false> E{ss + 2 * MP, ACT};
        pg8::gemm_phase<EpiSwiGLU<false>, StaticOrder, true, true>(lds, Gemm{XB, (const bf16_t*)(ws + W_FI1), MR, 5632, 1024}, S, E);
    }
    GSYNC();
    {
        S.init(MR, 1024, G, c);
        EpiResid<false> E{XB, ss + 3 * MP};
        pg8::gemm_phase<EpiResid<false>, StaticOrder, true, true>(lds, Gemm{ACT, (const bf16_t*)(ws + W_FO1), MR, 1024, DFF}, S, E);
    }
    GSYNC();
    for (int rep = 0; rep < REP_SYNC; ++rep) GSYNC();
    for (int rep = 0; rep < REP_FIN; ++rep) final_phase(P);
}

extern "C" void kernel_launch(void* const* d_in, const int* in_sizes, int n_in, void* d_out, int out_size, void* d_ws, size_t ws_size, hipStream_t stream) {
    static int grid = 0;
    if (grid == 0) {
        if (n_in != 20 || ws_size < WS_END) { fprintf(stderr, "kernel_launch: unexpected problem (n_in %d, ws %zu < %zu)\n", n_in, ws_size, (size_t)WS_END); grid = -1; return; }
        int dev = 0, cus = 0, per_cu = 0;
        hipGetDevice(&dev);
        hipDeviceGetAttribute(&cus, hipDeviceAttributeMultiprocessorCount, dev);
        if (hipFuncSetAttribute((const void*)s5yoco_fwd, hipFuncAttributeMaxDynamicSharedMemorySize, LDS_BYTES) != hipSuccess) { fprintf(stderr, "kernel_launch: hipFuncSetAttribute failed\n"); grid = -1; return; }
        if (hipOccupancyMaxActiveBlocksPerMultiprocessor(&per_cu, (const void*)s5yoco_fwd, 512, LDS_BYTES) != hipSuccess || per_cu < 1) { fprintf(stderr, "kernel_launch: occupancy query says %d\n", per_cu); per_cu = 1; }
        (void)hipGetLastError();
        grid = cus;
    }
    if (grid < 0) return;
    if (hipMemsetAsync((char*)d_ws + OFF_BAR, 0, 16384, stream) != hipSuccess) { fprintf(stderr, "kernel_launch: memset failed\n"); return; }
    Ptrs p{};
    for (int i = 0; i < 20; ++i) p.in[i] = (const float*)d_in[i];
    p.out = (float*)d_out; p.ws = (unsigned char*)d_ws;
    void* args[] = {&p};
    hipError_t e = hipLaunchCooperativeKernel((const void*)s5yoco_fwd, dim3(grid), dim3(512), args, LDS_BYTES, stream);
    if (e != hipSuccess) fprintf(stderr, "cooperative launch failed: %s (grid %d)\n", hipGetErrorString(e), grid);
}
```
